# Optimizing an MI355X kernel written in HIP

```python
import jax, jax.numpy as jnp
from jax import lax
import numpy as np

D_MODEL = 1024
BATCH = 8
SEQ = 4096
DEPTH = 2

MEM_LEN = 256
EXPAND = 2
D_MIX = EXPAND * D_MODEL
GLA_HEADS = 4
GLA_HEAD_K = 128
GLA_HEAD_V = 256
GLA_KEY_WIDTH = GLA_HEADS * GLA_HEAD_K
GLA_VAL_WIDTH = GLA_HEADS * GLA_HEAD_V
GLA_LOWRANK = 16
GLA_GATE_TAU = 16.0
HGRN_HEADS = 4
HGRN_HEAD_DIM = 128
HGRN_WIDTH = HGRN_HEADS * HGRN_HEAD_DIM
LB_FLOOR = 1e-30
XATTN_HEADS = 4
XATTN_HEAD_DIM = 128
XATTN_WIDTH = XATTN_HEADS * XATTN_HEAD_DIM
SPLIT_SIZES = (GLA_KEY_WIDTH, GLA_KEY_WIDTH, GLA_VAL_WIDTH, GLA_LOWRANK,
               HGRN_WIDTH, HGRN_WIDTH, HGRN_WIDTH,
               XATTN_WIDTH,
               D_MIX)
D_IN_PROJ = 6160
CHUNK = 16
NORM_EPS = 1e-6

kernel_name = "hybrid_gla_hgrn2_memxattn_parallel_heads"


def rms_norm(x, w):
    xf = x.astype(jnp.float32)
    y = xf * lax.rsqrt(jnp.mean(xf * xf, axis=-1, keepdims=True) + NORM_EPS)
    return (y * w.astype(jnp.float32)).astype(x.dtype)


def split_heads(t, n_heads):
    b, s, w = t.shape
    return t.reshape(b, s, n_heads, w // n_heads).transpose(0, 2, 1, 3)


def merge_heads(t):
    b, h, s, d = t.shape
    return t.transpose(0, 2, 1, 3).reshape(b, s, h * d)


def chunked_gated_linear_attention(q, k, v, log_g):
    b_, h_, s_, dk = q.shape
    dv = v.shape[-1]
    n = s_ // CHUNK
    qf = q.astype(jnp.float32).reshape(b_, h_, n, CHUNK, dk)
    kf = k.astype(jnp.float32).reshape(b_, h_, n, CHUNK, dk)
    vf = v.astype(jnp.float32).reshape(b_, h_, n, CHUNK, dv)
    bcum = jnp.cumsum(log_g.astype(jnp.float32).reshape(b_, h_, n, CHUNK, dk), axis=3)
    b_last = bcum[..., CHUNK - 1:CHUNK, :]
    causal = jnp.tril(jnp.ones((CHUNK, CHUNK), dtype=bool))[:, :, None]
    diff = bcum[..., :, None, :] - bcum[..., None, :, :]
    decay = jnp.where(causal, jnp.exp(jnp.where(causal, diff, 0.0)), 0.0)
    scores = jnp.einsum('bhnid,bhnjd,bhnijd->bhnij', qf, kf, decay)
    o_intra = jnp.einsum('bhnij,bhnjv->bhniv', scores, vf)
    chunk_kv = jnp.einsum('bhncd,bhncv->bhndv', kf * jnp.exp(b_last - bcum), vf)
    chunk_decay = jnp.exp(b_last[..., 0, :])

    def step(state, inp):
        dec, kv = inp
        return dec[..., None] * state + kv, state

    init = jnp.zeros((b_, h_, dk, dv), jnp.float32)
    _, states_prev = lax.scan(step, init, (jnp.moveaxis(chunk_decay, 2, 0), jnp.moveaxis(chunk_kv, 2, 0)))
    o_inter = jnp.einsum('bhncd,nbhdv->bhncv', qf * jnp.exp(bcum), states_prev)
    return (o_intra + o_inter).reshape(b_, h_, s_, dv)


def setup_inputs(seed: int = 0) -> dict:
    key = jax.random.key(seed)
    ks = jax.random.split(key, 14)
    f32 = jnp.float32
    nrm = lambda k, shape, scale: (jax.random.normal(k, shape, f32) * scale).astype(f32)
    return {
        "x": nrm(ks[0], (BATCH, SEQ, D_MODEL), 1.0),
        "mem": nrm(ks[1], (BATCH, MEM_LEN, D_MODEL), 1.0),
        "norm_w": 1.0 + nrm(ks[2], (DEPTH, D_MODEL), 0.1),
        "w_in": nrm(ks[3], (DEPTH, D_MODEL, D_IN_PROJ), D_MODEL ** -0.5),
        "gla_w_gate_up": nrm(ks[4], (DEPTH, GLA_LOWRANK, GLA_KEY_WIDTH), GLA_LOWRANK ** -0.5),
        "gla_b_gate": nrm(ks[5], (DEPTH, GLA_KEY_WIDTH), 0.1),
        "gla_norm_w": 1.0 + nrm(ks[6], (DEPTH, GLA_HEAD_V), 0.1),
        "hgrn_lower_bounds": nrm(ks[7], (DEPTH, HGRN_WIDTH), 0.5),
        "hgrn_norm_w": 1.0 + nrm(ks[8], (DEPTH, HGRN_HEAD_DIM), 0.1),
        "mem_norm_w": 1.0 + nrm(ks[9], (DEPTH, D_MODEL), 0.1),
        "w_mem_kv": nrm(ks[10], (DEPTH, D_MODEL, 2 * XATTN_WIDTH), D_MODEL ** -0.5),
        "xattn_norm_w": 1.0 + nrm(ks[11], (DEPTH, XATTN_HEAD_DIM), 0.1),
        "w_out": nrm(ks[12], (DEPTH, D_MIX, D_MODEL), D_MIX ** -0.5),
        "final_norm_w": 1.0 + nrm(ks[13], (D_MODEL,), 0.1),
    }


def reference(x, mem, norm_w, w_in, gla_w_gate_up, gla_b_gate, gla_norm_w, hgrn_lower_bounds,
              hgrn_norm_w, mem_norm_w, w_mem_kv, xattn_norm_w, w_out, final_norm_w):
    dtype = x.dtype
    split_idx = [int(i) for i in np.cumsum(SPLIT_SIZES)[:-1]]
    lb_p = jax.nn.softmax(hgrn_lower_bounds.astype(jnp.float32), axis=0)
    lower_bounds = jnp.cumsum(lb_p, axis=0) - lb_p[0]

    for layer in range(DEPTH):
        h = rms_norm(x, norm_w[layer])
        proj = jnp.einsum('bsd,de->bse', h, w_in[layer])
        (gq, gk, gv, glr, hq, hf, hi, xq, gate) = jnp.split(proj, split_idx, axis=-1)

        glr_up = jnp.einsum('bsr,rk->bsk', glr, gla_w_gate_up[layer]) + gla_b_gate[layer]
        gla_log_a = jax.nn.log_sigmoid(glr_up.astype(jnp.float32)) / GLA_GATE_TAU
        gla_o = chunked_gated_linear_attention(
            split_heads(gq, GLA_HEADS) * (GLA_HEAD_K ** -0.5), split_heads(gk, GLA_HEADS),
            split_heads(gv, GLA_HEADS), split_heads(gla_log_a, GLA_HEADS))
        gla_o = merge_heads(rms_norm(gla_o, gla_norm_w[layer]))

        lb = lower_bounds[layer]
        zf = hf.astype(jnp.float32)
        hgrn_log_f = jnp.logaddexp(jnp.log(jnp.maximum(lb, LB_FLOOR)),
                                   jnp.log1p(-lb) + jax.nn.log_sigmoid(zf))
        hgrn_k = (1.0 - lb) * jax.nn.sigmoid(-zf)
        hgrn_o = chunked_gated_linear_attention(
            split_heads(hq, HGRN_HEADS), split_heads(hgrn_k, HGRN_HEADS),
            split_heads(hi, HGRN_HEADS), split_heads(hgrn_log_f, HGRN_HEADS))
        hgrn_o = merge_heads(rms_norm(hgrn_o, hgrn_norm_w[layer]))

        m = rms_norm(mem, mem_norm_w[layer])
        mkv = jnp.einsum('bmd,de->bme', m, w_mem_kv[layer])
        mk, mv = jnp.split(mkv, 2, axis=-1)
        s = jnp.einsum('bhsd,bhmd->bhsm', split_heads(xq, XATTN_HEADS).astype(jnp.float32),
                       split_heads(mk, XATTN_HEADS).astype(jnp.float32)) * (XATTN_HEAD_DIM ** -0.5)
        p = jax.nn.softmax(s, axis=-1)
        xo = jnp.einsum('bhsm,bhmd->bhsd', p, split_heads(mv, XATTN_HEADS).astype(jnp.float32))
        xo = merge_heads(rms_norm(xo, xattn_norm_w[layer]))

        mixed = jnp.concatenate([gla_o, hgrn_o, xo], axis=-1).astype(dtype)
        mixed = mixed * jax.nn.silu(gate)
        x = x + jnp.einsum('bse,ed->bsd', mixed, w_out[layer]).astype(dtype)

    return rms_norm(x, final_norm_w)
```

```cpp
#include <hip/hip_runtime.h>
#include <cstdio>
#include <cstdint>

#ifndef MK_PER_PHASE
#define MK_PER_PHASE 1
#endif

#define LAS __attribute__((address_space(3)))
#define GAS __attribute__((address_space(1)))
__device__ __forceinline__ int fresh_tid() { int t = threadIdx.x; asm volatile("" : "+v"(t)); return t; }

namespace pg8 {
typedef unsigned short bf16_t;
typedef short bf16x8 __attribute__((ext_vector_type(8)));
typedef float f32x4 __attribute__((ext_vector_type(4)));
typedef unsigned u32x4 __attribute__((ext_vector_type(4)));
typedef unsigned u32x2 __attribute__((ext_vector_type(2)));
constexpr int BM = 256, BK = 64, HALF = 128, HTB = HALF * BK * 2, STAGE_BYTES = 8 * HTB, NXCD = 8, WGM = 8;

__host__ __device__ __forceinline__ int lds_byte(int r, int c) { const int st = (r >> 4) * 2 + (c >> 5), rr = r & 15, cc = c & 31, ob = rr * 64 + cc * 2; return st * 1024 + (ob ^ (((ob >> 9) & 1) << 5)); }
__host__ __device__ __forceinline__ void stage_rc(int b, int& R, int& C) { const int st = b / 1024, sb = b % 1024, swz = sb ^ (((sb >> 9) & 1) << 5); R = (st >> 1) * 16 + swz / 64; C = (st & 1) * 32 + (swz % 64) / 2; }
__host__ __device__ __forceinline__ int perm32(int rho) { const int n = rho >> 4, i = rho & 15; return 8 * (i >> 2) + 4 * n + (i & 3); }

struct Unit { int pm, pn; };
struct Gemm { const bf16_t* A; const bf16_t* Bt; int M, N, K, lda, ldb; };

struct StaticOrder {
    int nM, nN, nwg, G, c;
    __host__ __device__ void init(int M, int N, int G_, int c_) { nM = M / BM; nN = N / BM; nwg = nM * nN; G = G_; c = c_; }
    __host__ __device__ bool next(int i, Unit& u) const {
        const long L = (long)i * G + c; if (L >= nwg) return false;
        int wgid = (int)L; { const int q = nwg / NXCD, r = nwg % NXCD, xcd = wgid % NXCD, off = wgid / NXCD; wgid = (xcd < r ? xcd * (q + 1) : r * (q + 1) + (xcd - r) * q) + off; }
        const int nig = WGM * nN, gid = wgid / nig, fm = gid * WGM, gsz = (nM - fm) < WGM ? (nM - fm) : WGM;
        u.pm = fm + ((wgid % nig) % gsz); u.pn = (wgid % nig) / gsz; return true;
    }
    __device__ __forceinline__ void a_ready(const Unit&) const {}
    __device__ __forceinline__ void done(const Unit&) const {}
};

template <class Epi, class Sched, bool ALIGN_EPI = false, bool SP2 = false>
__device__ __forceinline__ void gemm_phase(LAS unsigned char* lds, const Gemm g, const Sched& S, const Epi& E) {
    const int tid = fresh_tid();
    const int wid = __builtin_amdgcn_readfirstlane(tid >> 6), lane = tid & 63, wr = wid >> 2, wc = wid & 3, fr = lane & 15, fq = lane >> 4;
    const int K = g.K, nt = K / BK;
    unsigned voffA[2], voffB[2];
#pragma unroll
    for (int i = 0; i < 2; ++i) { int R, C; stage_rc(tid * 16 + i * 8192, R, C); const int Rb = Epi::PERM ? ((R & ~31) + perm32(R & 31)) : R;
        voffA[i] = (unsigned)(R * g.lda + C) * 2u; voffB[i] = (unsigned)(Rb * g.ldb + C) * 2u; }
    const size_t kstep = (size_t)(BK * 2);
    const size_t hstepA = (size_t)HALF * g.lda * 2, hstepB = (size_t)HALF * g.ldb * 2;
    const size_t tstepA = 2 * hstepA, tstepB = 2 * hstepB;
    const unsigned ldsw = (unsigned)wid * 1024u;
    const int aoff = lds_byte(wr * 64 + fr, fq * 8), boff = lds_byte(wc * 32 + fr, fq * 8);
#define PG8_SA(b, h) (((b) * 2 + (h)) * HTB)
#define PG8_SB(b, h) ((4 + (b) * 2 + (h)) * HTB)
#define PG8_STAGE(bufoff, gbase, voff) do { _Pragma("unroll") for (int _i = 0; _i < 2; ++_i) \
        __builtin_amdgcn_global_load_lds((const unsigned*)((const char*)(gbase) + (voff)[_i]), (LAS unsigned*)(lds + (bufoff) + ldsw + _i * 8192), 16, 0, 0); } while (0)
#define PG8_LDA(dst, b, h) do { _Pragma("unroll") for (int m = 0; m < 4; ++m) _Pragma("unroll") for (int k = 0; k < 2; ++k) dst[m][k] = *(const LAS bf16x8*)(lds + PG8_SA(b, h) + aoff + m * 2048 + k * 1024); } while (0)
#define PG8_LDB(dst, b, h) do { _Pragma("unroll") for (int n = 0; n < 2; ++n) _Pragma("unroll") for (int k = 0; k < 2; ++k) dst[n][k] = *(const LAS bf16x8*)(lds + PG8_SB(b, h) + boff + n * 2048 + k * 1024); } while (0)
#define PG8_MMA(ai, bj, At, Bt) do { __builtin_amdgcn_s_setprio(1); _Pragma("unroll") for (int m = 0; m < 4; ++m) _Pragma("unroll") for (int n = 0; n < 2; ++n) _Pragma("unroll") for (int k = 0; k < 2; ++k) \
        acc[ai][bj][m][n] = __builtin_amdgcn_mfma_f32_16x16x32_bf16(Bt[n][k], At[m][k], acc[ai][bj][m][n], 0, 0, 0); __builtin_amdgcn_s_setprio(0); } while (0)
#define PG8_WAIT_V(n) asm volatile("s_waitcnt vmcnt(" #n ")" ::: "memory")
#define PG8_WAIT_L(n) asm volatile("s_waitcnt lgkmcnt(" #n ")" ::: "memory")
#define PG8_BAR __builtin_amdgcn_s_barrier()
#define PG8_SCHED __builtin_amdgcn_sched_barrier(0)
    Unit cur, nxt; int ui = 0;
    if (!S.next(0, cur)) return;
    f32x4 acc[2][2][4][2];
#pragma unroll
    for (int a = 0; a < 2; ++a)
#pragma unroll
        for (int b = 0; b < 2; ++b)
#pragma unroll
            for (int m = 0; m < 4; ++m)
#pragma unroll
                for (int n = 0; n < 2; ++n) acc[a][b][m][n] = (f32x4){0.f, 0.f, 0.f, 0.f};
    bf16x8 At[4][2], B0[2][2], B1[2][2];
    const char* cA = (const char*)g.A + (size_t)cur.pm * tstepA; const char* cB = (const char*)g.Bt + (size_t)cur.pn * tstepB;
    S.a_ready(cur);
    if constexpr (SP2) {
        PG8_STAGE(PG8_SB(0, 0), cB, voffB); PG8_STAGE(PG8_SB(0, 1), cB + hstepB, voffB); PG8_STAGE(PG8_SA(0, 0), cA, voffA); PG8_STAGE(PG8_SA(0, 1), cA + hstepA, voffA);
        if (wr == 1) PG8_BAR;
        PG8_WAIT_V(2); PG8_BAR;
        PG8_STAGE(PG8_SB(1, 0), cB + kstep, voffB); PG8_STAGE(PG8_SA(1, 0), cA + kstep, voffA); PG8_STAGE(PG8_SB(1, 1), cB + hstepB + kstep, voffB);
        PG8_WAIT_V(6); PG8_BAR;
    } else {
        PG8_STAGE(PG8_SB(0, 0), cB, voffB); PG8_STAGE(PG8_SA(0, 0), cA, voffA); PG8_STAGE(PG8_SB(0, 1), cB + hstepB, voffB); PG8_STAGE(PG8_SA(0, 1), cA + hstepA, voffA);
        if (wr == 1) PG8_BAR;
        PG8_WAIT_V(4); PG8_BAR;
        PG8_STAGE(PG8_SB(1, 0), cB + kstep, voffB); PG8_STAGE(PG8_SA(1, 0), cA + kstep, voffA); PG8_STAGE(PG8_SB(1, 1), cB + hstepB + kstep, voffB);
        PG8_WAIT_V(6); PG8_BAR;
    }
    for (;;) {
        const bool has_next = S.next(ui + 1, nxt);
        const char* nA = has_next ? (const char*)g.A + (size_t)nxt.pm * tstepA : cA; const char* nB = has_next ? (const char*)g.Bt + (size_t)nxt.pn * tstepB : cB;
        for (int t = 0; t < nt; t += 2) {
            const bool last = (t == nt - 2);
            const char* a1 = cA + (size_t)(t + 1) * kstep;
            const char* a2 = last ? nA : cA + (size_t)(t + 2) * kstep; const char* b2 = last ? nB : cB + (size_t)(t + 2) * kstep;
            const char* a3 = a2 + kstep; const char* b3 = b2 + kstep;
            if (last && has_next) S.a_ready(nxt);
            if constexpr (SP2) {
            PG8_LDB(B0, 0, 0); PG8_LDB(B1, 0, 1); PG8_SCHED; PG8_LDA(At, 0, 0); PG8_STAGE(PG8_SA(1, 1), a1 + hstepA, voffA);
            PG8_WAIT_V(8); PG8_WAIT_L(0); PG8_BAR; PG8_MMA(0, 0, At, B0); PG8_MMA(0, 1, At, B1); PG8_BAR; PG8_SCHED;
            PG8_LDA(At, 0, 1); PG8_STAGE(PG8_SB(0, 0), b2, voffB); PG8_STAGE(PG8_SB(0, 1), b2 + hstepB, voffB); PG8_STAGE(PG8_SA(0, 0), a2, voffA);
            PG8_WAIT_V(8); PG8_WAIT_L(0); PG8_BAR; PG8_MMA(1, 0, At, B0); PG8_MMA(1, 1, At, B1); PG8_BAR; PG8_SCHED;
            PG8_LDB(B0, 1, 0); PG8_LDB(B1, 1, 1); PG8_SCHED; PG8_LDA(At, 1, 0); PG8_STAGE(PG8_SA(0, 1), a2 + hstepA, voffA);
            PG8_WAIT_V(8); PG8_WAIT_L(0); PG8_BAR; PG8_MMA(0, 0, At, B0); PG8_MMA(0, 1, At, B1); PG8_BAR; PG8_SCHED;
            PG8_LDA(At, 1, 1); PG8_STAGE(PG8_SB(1, 0), b3, voffB); PG8_STAGE(PG8_SB(1, 1), b3 + hstepB, voffB); PG8_STAGE(PG8_SA(1, 0), a3, voffA);
            PG8_WAIT_V(8); PG8_WAIT_L(0); PG8_BAR; PG8_MMA(1, 0, At, B0); PG8_MMA(1, 1, At, B1); PG8_BAR; PG8_SCHED;
            } else {
            PG8_LDB(B0, 0, 0); PG8_SCHED; PG8_LDA(At, 0, 0); PG8_STAGE(PG8_SA(1, 1), a1 + hstepA, voffA);
            PG8_WAIT_L(8); PG8_BAR; PG8_WAIT_L(0); PG8_MMA(0, 0, At, B0); PG8_BAR; PG8_SCHED;
            PG8_LDB(B1, 0, 1); PG8_STAGE(PG8_SB(0, 0), b2, voffB);
            PG8_BAR; PG8_WAIT_L(0); PG8_MMA(0, 1, At, B1); PG8_BAR;
            PG8_LDA(At, 0, 1); PG8_STAGE(PG8_SA(0, 0), a2, voffA);
            PG8_BAR; PG8_WAIT_L(0); PG8_MMA(1, 0, At, B0); PG8_BAR; PG8_SCHED;
            PG8_STAGE(PG8_SB(0, 1), b2 + hstepB, voffB);
            PG8_WAIT_V(6); PG8_BAR; PG8_MMA(1, 1, At, B1); PG8_BAR;
            PG8_LDB(B0, 1, 0); PG8_SCHED; PG8_LDA(At, 1, 0); PG8_STAGE(PG8_SA(0, 1), a2 + hstepA, voffA);
            PG8_WAIT_L(8); PG8_BAR; PG8_WAIT_L(0); PG8_MMA(0, 0, At, B0); PG8_BAR; PG8_SCHED;
            PG8_LDB(B1, 1, 1); PG8_STAGE(PG8_SB(1, 0), b3, voffB);
            PG8_BAR; PG8_WAIT_L(0); PG8_MMA(0, 1, At, B1); PG8_BAR;
            PG8_LDA(At, 1, 1); PG8_STAGE(PG8_SA(1, 0), a3, voffA);
            PG8_BAR; PG8_WAIT_L(0); PG8_MMA(1, 0, At, B0); PG8_BAR; PG8_SCHED;
            PG8_STAGE(PG8_SB(1, 1), b3 + hstepB, voffB);
            PG8_WAIT_V(6); PG8_BAR; PG8_MMA(1, 1, At, B1); PG8_BAR;
            }
        }
        if constexpr (ALIGN_EPI) { if (wr == 0) PG8_BAR; }
        E(acc, cur, wr, wc, fr, fq); S.done(cur);
        if (!has_next) break;
#pragma unroll
        for (int a = 0; a < 2; ++a)
#pragma unroll
            for (int b = 0; b < 2; ++b)
#pragma unroll
                for (int m = 0; m < 4; ++m)
#pragma unroll
                    for (int n = 0; n < 2; ++n) acc[a][b][m][n] = (f32x4){0.f, 0.f, 0.f, 0.f};
        cur = nxt; cA = nA; cB = nB; ++ui;
        if constexpr (ALIGN_EPI) { if (wr == 1) PG8_BAR; }
    }
    PG8_WAIT_V(0);
    if constexpr (!ALIGN_EPI) { if (wr == 0) PG8_BAR; }
    PG8_BAR;
#undef PG8_SA
#undef PG8_SB
#undef PG8_STAGE
#undef PG8_LDA
#undef PG8_LDB
#undef PG8_MMA
#undef PG8_WAIT_V
#undef PG8_WAIT_L
#undef PG8_BAR
#undef PG8_SCHED
}
}

typedef unsigned short bf16;
typedef short bf16x8 __attribute__((ext_vector_type(8)));
typedef short s16x4 __attribute__((ext_vector_type(4)));
typedef float f32x4 __attribute__((ext_vector_type(4)));
typedef float f32x2 __attribute__((ext_vector_type(2)));
typedef unsigned u32x4 __attribute__((ext_vector_type(4)));
typedef unsigned u32x2 __attribute__((ext_vector_type(2)));
typedef _Float16 f16x2 __attribute__((ext_vector_type(2)));
typedef __bf16 bf16x2_t __attribute__((ext_vector_type(2)));
typedef short v4i16_t __attribute__((ext_vector_type(4)));

constexpr int NB = 8, SEQ = 4096, T = NB * SEQ, D = 1024, DEPTH = 2, DINP = 6160, DMIX = 2048, MEML = 256, MROWS = NB * MEML;
constexpr int NP = 6656;
constexpr int LDP = 6656;
constexpr int C_GQ = 0, C_GK = 512, C_GG = 1024, C_GV = 1536, C_HQ = 2560, C_HLF = 3072, C_HI = 3584, C_XQ = 4096, C_SG = 4608;
constexpr float NORM_EPS = 1e-6f;
constexpr int NSEG = 8, SEGLEN = 512, NMC = SEGLEN / 64;
constexpr int N_MIX_UNITS = 384;
constexpr int N_XA_UNITS = 256;

constexpr size_t MiB = 1u << 20;
constexpr size_t WS_CTL = 0, CTL_ZERO_BYTES = 1 * MiB;
constexpr size_t WS_SSQ1 = 1 * MiB, WS_SSQ2 = 3 * MiB;
constexpr size_t WS_MKV = 5 * MiB;
constexpr size_t WS_W1T = 13 * MiB;
constexpr size_t WS_W2T = 27 * MiB;
constexpr size_t WS_XB = 31 * MiB;
constexpr size_t WS_SEND = WS_XB, WS_DTOT = WS_XB + 48 * MiB;
constexpr size_t WS_P = 95 * MiB;
constexpr size_t WS_END = WS_P + (size_t)T * LDP * 2;
static_assert(WS_END <= 512 * MiB, "workspace map");
constexpr size_t DO_MEMB = 0, DO_WKVT = 4 * MiB, DO_SSQ0 = 8 * MiB, DO_RSTDM = 10 * MiB;
constexpr int CW_BAR = 4096;
constexpr int CW_QUEUE = 2048;
constexpr int LDS_BYTES = 147456, MISC_OFF = LDS_BYTES - 64;

#define LDS_WAIT() asm volatile("s_waitcnt lgkmcnt(0)" ::: "memory")
#define VM_WAIT() asm volatile("s_waitcnt vmcnt(0)" ::: "memory")
#define RLX_AGENT __ATOMIC_RELAXED, __HIP_MEMORY_SCOPE_AGENT
__device__ __forceinline__ unsigned f2bf(float f) { unsigned u = __builtin_bit_cast(unsigned, f); return (u + 0x7fffu + ((u >> 16) & 1u)) >> 16; }
__device__ __forceinline__ unsigned pk2(float lo, float hi) { f32x2 v = {lo, hi}; bf16x2_t b = __builtin_convertvector(v, bf16x2_t); return __builtin_bit_cast(unsigned, b); }
__device__ __forceinline__ unsigned pkh2(float lo, float hi) { f32x2 v = {lo, hi}; f16x2 h = __builtin_convertvector(v, f16x2); return __builtin_bit_cast(unsigned, h); }
__device__ __forceinline__ float bflo(unsigned w) { return __builtin_bit_cast(float, w << 16); }
__device__ __forceinline__ float bfhi(unsigned w) { return __builtin_bit_cast(float, w & 0xffff0000u); }
__device__ __forceinline__ float fexp(float x) { return __builtin_amdgcn_exp2f(x * 1.4426950408889634f); }
__device__ __forceinline__ float flog(float x) { return __builtin_amdgcn_logf(x) * 0.6931471805599453f; }
__device__ __forceinline__ float log_sigmoid(float z) { return fminf(z, 0.f) - flog(1.f + fexp(-fabsf(z))); }
__device__ __forceinline__ s16x4 tr16(const LAS unsigned char* p) { return __builtin_bit_cast(s16x4, __builtin_amdgcn_ds_read_tr16_b64_v4i16((LAS v4i16_t*)p)); }
__device__ __forceinline__ float wave_sum(float v) {
#pragma unroll
    for (int o = 1; o < 64; o <<= 1) v += __shfl_xor(v, o);
    return v;
}

#define XB_TMO      128
#define XB_XCNT(j)  (256  + 64 * (j))
#define XB_XSUB(j)  (1280 + 64 * (j))
#define XB_XGEN(j)  (2304 + 64 * (j))
#define XB_TOP      3328
#define XB_TOPGEN   3392
#define XCD_BAR_WORDS 3456
#define XB_SPIN_CAP (1u << 20)
__device__ __forceinline__ unsigned xb_ld(unsigned* p)              { return __hip_atomic_load(p, __ATOMIC_RELAXED, __HIP_MEMORY_SCOPE_AGENT); }
__device__ __forceinline__ unsigned xb_add(unsigned* p, unsigned v) { return __hip_atomic_fetch_add(p, v, __ATOMIC_RELAXED, __HIP_MEMORY_SCOPE_AGENT); }
__device__ __forceinline__ unsigned xb_xcc_id() { return (unsigned)__builtin_amdgcn_s_getreg((3 << 11) | 20) & 0xFu; }
#define XB_SPIN(cond, bar) do { unsigned _sp = 0; while (cond) { __builtin_amdgcn_s_sleep(1); \
    if ((++_sp & 255u) == 0u) { if (xb_ld(&(bar)[XB_TMO])) break; if (_sp > XB_SPIN_CAP) { atomicAdd(&(bar)[XB_TMO], 1u); break; } } } } while (0)
struct XcdBarrier { unsigned* bar; unsigned x; volatile LAS unsigned* st; };
__device__ __forceinline__ XcdBarrier xcd_barrier_post(unsigned* bar, volatile LAS unsigned* st) {
    XcdBarrier b; b.bar = bar; b.x = xb_xcc_id(); b.st = st;
    if (threadIdx.x == 0) (void)xb_add(&bar[XB_XCNT(b.x)], 1u);
    return b;
}
__device__ __forceinline__ void xcd_barrier_complete(unsigned* bar, unsigned x, unsigned& nloc, unsigned& nx) {
    const unsigned G = gridDim.x * gridDim.y * gridDim.z;
    unsigned sum, cnt, mine, sp = 0u;
    for (;;) {
        sum = 0u; cnt = 0u; mine = 0u;
#pragma unroll
        for (unsigned j = 0; j < 16; ++j) { const unsigned c = xb_ld(&bar[XB_XCNT(j)]); sum += c; cnt += (c > 0u) ? 1u : 0u; mine = (j == x) ? c : mine; }
        if (sum == G) break;
        __builtin_amdgcn_s_sleep(1);
        if ((++sp & 255u) == 0u) { if (xb_ld(&bar[XB_TMO])) break; if (sp > XB_SPIN_CAP) { atomicAdd(&bar[XB_TMO], 1u); break; } }
    }
    nloc = mine > 0u ? mine : 1u; nx = cnt > 0u ? cnt : 1u;
}
__device__ __forceinline__ void xcd_barrier(const XcdBarrier& b) {
    asm volatile("s_waitcnt vmcnt(0)" ::: "memory");
    __syncthreads();
    if (threadIdx.x == 0) {
        unsigned* bar = b.bar;
        __builtin_amdgcn_s_waitcnt(0);
        unsigned nloc = b.st[0], nx = b.st[1];
        if (nloc == 0u) { xcd_barrier_complete(bar, b.x, nloc, nx); b.st[0] = nloc; b.st[1] = nx; }
        const unsigned old = xb_add(&bar[XB_XSUB(b.x)], 1u);
        const unsigned gen = old / nloc;
        if (old + 1u == (gen + 1u) * nloc) {
            __builtin_amdgcn_fence(__ATOMIC_RELEASE, "agent");
            asm volatile("s_waitcnt vmcnt(0)" ::: "memory");
            const unsigned og = xb_add(&bar[XB_TOP], 1u);
            const unsigned tg = og / nx;
            if (og + 1u == (tg + 1u) * nx) xb_add(&bar[XB_TOPGEN], 1u);
            else XB_SPIN(xb_ld(&bar[XB_TOPGEN]) == tg, bar);
            __builtin_amdgcn_fence(__ATOMIC_ACQUIRE, "agent");
            xb_add(&bar[XB_XGEN(b.x)], 1u);
            asm volatile("s_waitcnt vmcnt(0)" ::: "memory");
        } else {
            XB_SPIN(xb_ld(&bar[XB_XGEN(b.x)]) == gen, bar);
            __builtin_amdgcn_fence(__ATOMIC_ACQUIRE, "agent");
            asm volatile("s_waitcnt vmcnt(0)" ::: "memory");
        }
    }
    __syncthreads();
}

struct Args {
    const float* x; const float* mem; const float* norm_w; const float* w_in; const float* gla_wup; const float* gla_b; const float* gla_nw; const float* hgrn_lb;
    const float* hgrn_nw; const float* mem_nw; const float* w_mkv; const float* xattn_nw; const float* w_out; const float* final_nw;
    float* out; unsigned char* ws; int ph_lo, ph_hi;
};
struct Frame {
    LAS unsigned char* lds; volatile LAS unsigned* MISC; unsigned* ctl;
    int wave, vcu, G;
};

__device__ __forceinline__ void tr_item(const float* W, int Nsrc, int srccol0, const float* kscale, float rscale, bf16* WT, int ldt, int dstrow0, int k0, LAS float* scr, int lane) {
#pragma unroll 8
    for (int i = 0; i < 32; ++i) { const int kk = 2 * i + (lane >> 5); const float ks = kscale ? kscale[k0 + kk] * rscale : rscale;
        scr[kk * 33 + (lane & 31)] = W[(size_t)(k0 + kk) * Nsrc + srccol0 + (lane & 31)] * ks; }
    LDS_WAIT(); asm volatile("" ::: "memory");
    const int c = lane & 7;
#pragma unroll
    for (int j = 0; j < 4; ++j) { const int n = (lane >> 3) + 8 * j; const LAS float* s = scr + (8 * c) * 33 + n;
        u32x4 o; o.x = pk2(s[0 * 33], s[1 * 33]); o.y = pk2(s[2 * 33], s[3 * 33]); o.z = pk2(s[4 * 33], s[5 * 33]); o.w = pk2(s[6 * 33], s[7 * 33]);
        *(u32x4*)(WT + (size_t)(dstrow0 + n) * ldt + k0 + 8 * c) = o; }
    LDS_WAIT(); asm volatile("" ::: "memory");
}
__device__ __forceinline__ void prep_w1(const Frame& F, const Args& a, int layer) {
    const int lane_ = fresh_tid() & 63;
    LAS float* scr = (LAS float*)(F.lds + F.wave * 16384);
    const int gw = F.vcu * 8 + F.wave, NGW = F.G * 8;
    const float* W = a.w_in + (size_t)layer * D * DINP; const float* nw = a.norm_w + layer * D; bf16* WT = (bf16*)(a.ws + WS_W1T);
    constexpr int NBLK = (NP - 512) / 32;
    for (int it = gw; it < NBLK * 16; it += NGW) {
        const int kb = it & 15; int nb = it >> 4; if (nb >= 32) nb += 16;
        const int n0 = nb * 32; const int src = n0 < 1024 ? n0 : (n0 < 2560 ? n0 - 512 : n0 - 496);
        const float rs = (n0 < 512 || (n0 >= 4096 && n0 < 4608)) ? 0.08838834764831845f : 1.f;
        tr_item(W, DINP, src, nw, rs, WT, D, n0, kb * 64, scr, lane_);
    }
    const float* wup = a.gla_wup + (size_t)layer * 16 * 512;
    for (int it = gw; it < 512 * 2; it += NGW) {
        const int c = it >> 1, ko = ((it & 1) * 64 + lane_) * 8;
        float up[16];
#pragma unroll
        for (int r = 0; r < 16; ++r) up[r] = wup[r * 512 + c];
        float o[8];
#pragma unroll
        for (int kk = 0; kk < 8; ++kk) { const float* wr_ = W + (size_t)(ko + kk) * DINP + 2048; float s = 0.f;
#pragma unroll
            for (int r4 = 0; r4 < 4; ++r4) { const f32x4 w4 = *(const f32x4*)(wr_ + 4 * r4); s += w4.x * up[4 * r4] + w4.y * up[4 * r4 + 1] + w4.z * up[4 * r4 + 2] + w4.w * up[4 * r4 + 3]; }
            o[kk] = s * nw[ko + kk]; }
        u32x4 w; w.x = pk2(o[0], o[1]); w.y = pk2(o[2], o[3]); w.z = pk2(o[4], o[5]); w.w = pk2(o[6], o[7]);
        *(u32x4*)(WT + (size_t)(1024 + c) * D + ko) = w;
    }
}
__device__ __forceinline__ void prep_w2(const Frame& F, const Args& a, int layer) {
    const int lane_ = fresh_tid() & 63;
    LAS float* scr = (LAS float*)(F.lds + F.wave * 16384);
    const int gw = F.vcu * 8 + F.wave, NGW = F.G * 8;
    const float* W = a.w_out + (size_t)layer * DMIX * D; bf16* WT = (bf16*)(a.ws + WS_W2T);
    for (int it = gw; it < 32 * 32; it += NGW) { const int kb = it & 31, nb = it >> 5; tr_item(W, D, nb * 32, nullptr, 1.f, WT, DMIX, nb * 32, kb * 64, scr, lane_); }
}
__device__ __forceinline__ void prep_wkv(const Frame& F, const Args& a) {
    const int lane_ = fresh_tid() & 63;
    LAS float* scr = (LAS float*)(F.lds + F.wave * 16384);
    const int gw = F.vcu * 8 + F.wave, NGW = F.G * 8;
    bf16* WT = (bf16*)((unsigned char*)a.out + DO_WKVT);
    for (int it = gw; it < 2 * 32 * 16; it += NGW) { const int layer = it >> 9, r = it & 511, kb = r & 15, nb = r >> 4;
        tr_item(a.w_mkv + (size_t)layer * D * 1024, 1024, nb * 32, a.mem_nw + layer * D, 1.f, WT, D, layer * 1024 + nb * 32, kb * 64, scr, lane_); }
}
__device__ __forceinline__ float row_to_bf16(const float* xrow, bf16* orow, int lane) {
    const f32x4* xr = (const f32x4*)xrow + lane; f32x4 v[4]; float s = 0.f;
#pragma unroll
    for (int j = 0; j < 4; ++j) { v[j] = xr[64 * j]; s += (v[j].x * v[j].x + v[j].y * v[j].y) + (v[j].z * v[j].z + v[j].w * v[j].w); }
    u32x2* o8 = (u32x2*)orow + lane;
#pragma unroll
    for (int j = 0; j < 4; ++j) { u32x2 w; w.x = pk2(v[j].x, v[j].y); w.y = pk2(v[j].z, v[j].w); o8[64 * j] = w; }
    return wave_sum(s);
}
__device__ __forceinline__ void prep_x(const Frame& F, const Args& a) {
    const int lane_ = fresh_tid() & 63;
    const int gw = F.vcu * 8 + F.wave, NGW = F.G * 8;
    bf16* xb = (bf16*)(a.ws + WS_XB); float* ssq0 = (float*)((unsigned char*)a.out + DO_SSQ0);
    for (int m = gw; m < T; m += NGW) { const float s = row_to_bf16(a.x + (size_t)m * D, xb + (size_t)m * D, lane_);
        if (lane_ < 16) ssq0[(size_t)m * 16 + lane_] = lane_ == 0 ? s : 0.f; }
    bf16* memb = (bf16*)((unsigned char*)a.out + DO_MEMB); float* rstdm = (float*)((unsigned char*)a.out + DO_RSTDM);
    for (int m = gw; m < MROWS; m += NGW) { const float s = row_to_bf16(a.mem + (size_t)m * D, memb + (size_t)m * D, lane_);
        if (lane_ == 0) rstdm[m] = 1.0f / sqrtf(s * (1.f / D) + NORM_EPS); }
}

struct EpiProj {
    static constexpr bool PERM = true;
    bf16* P; const float* ssq; const float* gbias; const float* hlb;
    int layer;
    template <int KIND>
    __device__ __forceinline__ void store_tile(const f32x4 (&acc)[2][2][4][2], bf16* rowp0, const float (&rstd)[2][4], int cbase) const {
#pragma unroll
        for (int bj = 0; bj < 2; ++bj) {
            float ca[8], cb[8];
#pragma unroll
            for (int e = 0; e < 8; ++e) { ca[e] = 0.f; cb[e] = 0.f; }
            if (KIND == 1) {
#pragma unroll
                for (int e = 0; e < 8; ++e) ca[e] = gbias[cbase + bj * 128 + e];
            }
            if (KIND == 2) {
#pragma unroll
                for (int e = 0; e < 8; ++e) { const int c = cbase + bj * 128 + e; float lb = 0.f;
                    if (layer == 1) { const float h0 = hlb[c], h1 = hlb[512 + c]; lb = 1.f / (1.f + fexp(h0 - h1)); }
                    ca[e] = logf(fmaxf(lb, 1e-30f)); cb[e] = log1pf(-lb); }
            }
#pragma unroll
            for (int ai = 0; ai < 2; ++ai)
#pragma unroll
                for (int m = 0; m < 4; ++m) { const float rs = rstd[ai][m]; float v[8];
#pragma unroll
                    for (int e = 0; e < 4; ++e) { v[e] = acc[ai][bj][m][0][e] * rs; v[4 + e] = acc[ai][bj][m][1][e] * rs; }
                    u32x4 w;
                    if (KIND == 0) { w.x = pk2(v[0], v[1]); w.y = pk2(v[2], v[3]); w.z = pk2(v[4], v[5]); w.w = pk2(v[6], v[7]); }
                    else if (KIND == 3) {
#pragma unroll
                        for (int e = 0; e < 8; ++e) v[e] = v[e] * __builtin_amdgcn_rcpf(1.f + fexp(-v[e]));
                        w.x = pk2(v[0], v[1]); w.y = pk2(v[2], v[3]); w.z = pk2(v[4], v[5]); w.w = pk2(v[6], v[7]); }
                    else if (KIND == 1) {
#pragma unroll
                        for (int e = 0; e < 8; ++e) v[e] = log_sigmoid(v[e] + ca[e]) * 0.0625f;
                        w.x = pkh2(v[0], v[1]); w.y = pkh2(v[2], v[3]); w.z = pkh2(v[4], v[5]); w.w = pkh2(v[6], v[7]); }
                    else {
#pragma unroll
                        for (int e = 0; e < 8; ++e) { const float aa = ca[e], bb = cb[e] + log_sigmoid(v[e]); const float mx = fmaxf(aa, bb); v[e] = mx + flog(1.f + fexp(-fabsf(aa - bb))); }
                        w.x = pkh2(v[0], v[1]); w.y = pkh2(v[2], v[3]); w.z = pkh2(v[4], v[5]); w.w = pkh2(v[6], v[7]); }
                    *(u32x4*)(rowp0 + (size_t)(ai * 128 + m * 16) * LDP + bj * 128) = w; }
        }
    }
    __device__ __forceinline__ void operator()(const f32x4 (&acc)[2][2][4][2], const pg8::Unit& u, int wr, int wc, int fr, int fq) const {
        const int pn = u.pn; int kind, dcol, cb0 = 0;
        if (pn < 2) { kind = 0; dcol = C_GQ + 256 * pn; } else if (pn < 4) { kind = 0; dcol = C_GK + 256 * (pn - 2); } else if (pn < 6) { kind = 1; dcol = C_GG + 256 * (pn - 4); cb0 = 256 * (pn - 4); }
        else if (pn < 10) { kind = 0; dcol = C_GV + 256 * (pn - 6); } else if (pn < 12) { kind = 0; dcol = C_HQ + 256 * (pn - 10); } else if (pn < 14) { kind = 2; dcol = C_HLF + 256 * (pn - 12); cb0 = 256 * (pn - 12); }
        else if (pn < 16) { kind = 0; dcol = C_HI + 256 * (pn - 14); } else if (pn < 18) { kind = 0; dcol = C_XQ + 256 * (pn - 16); } else { kind = 3; dcol = C_SG + 256 * (pn - 18); }
        const int row0 = u.pm * 256 + wr * 64 + fr;
        float rstd[2][4];
#pragma unroll
        for (int ai = 0; ai < 2; ++ai)
#pragma unroll
            for (int m = 0; m < 4; ++m) { const f32x4 s4 = *(const f32x4*)(ssq + (size_t)(row0 + ai * 128 + m * 16) * 16 + 4 * fq);
                float s = (s4.x + s4.y) + (s4.z + s4.w); s += __shfl_xor(s, 16); s += __shfl_xor(s, 32);
                rstd[ai][m] = 1.0f / sqrtf(s * (1.f / D) + NORM_EPS); }
        const int cw = wc * 32 + 8 * fq;
        bf16* rowp0 = P + (size_t)row0 * LDP + dcol + cw;
        if (kind == 0) store_tile<0>(acc, rowp0, rstd, 0);
        else if (kind == 3) store_tile<3>(acc, rowp0, rstd, 0);
        else if (kind == 1) store_tile<1>(acc, rowp0, rstd, cb0 + cw);
        else store_tile<2>(acc, rowp0, rstd, cb0 + cw);
    }
};
struct EpiMem {
    static constexpr bool PERM = true;
    bf16* O; const float* rstdm;
    __device__ __forceinline__ void operator()(const f32x4 (&acc)[2][2][4][2], const pg8::Unit& u, int wr, int wc, int fr, int fq) const {
        const int row0 = u.pm * 256 + wr * 64 + fr, col0 = u.pn * 256 + wc * 32 + 8 * fq;
#pragma unroll
        for (int ai = 0; ai < 2; ++ai)
#pragma unroll
            for (int m = 0; m < 4; ++m) { const int row = row0 + ai * 128 + m * 16; const float rs = rstdm[row]; bf16* rowp = O + (size_t)row * 2048 + col0;
#pragma unroll
                for (int bj = 0; bj < 2; ++bj) { const f32x4 v0 = acc[ai][bj][m][0] * rs, v1 = acc[ai][bj][m][1] * rs; u32x4 w;
                    w.x = pk2(v0[0], v0[1]); w.y = pk2(v0[2], v0[3]); w.z = pk2(v1[0], v1[1]); w.w = pk2(v1[2], v1[3]); *(u32x4*)(rowp + bj * 128) = w; } }
    }
};
struct EpiRes {
    static constexpr bool PERM = false;
    const float* resid; float* out; bf16* xb; float* ssq;
    __device__ __forceinline__ void operator()(const f32x4 (&acc)[2][2][4][2], const pg8::Unit& u, int wr, int wc, int fr, int fq) const {
        const int row0 = u.pm * 256 + wr * 64 + fr, col0 = u.pn * 256 + wc * 32 + 4 * fq;
#pragma unroll
        for (int ai = 0; ai < 2; ++ai)
#pragma unroll
            for (int m = 0; m < 4; ++m) { const int row = row0 + ai * 128 + m * 16; const size_t off = (size_t)row * D + col0; float ss = 0.f;
#pragma unroll
                for (int bj = 0; bj < 2; ++bj)
#pragma unroll
                    for (int n = 0; n < 2; ++n) { const f32x4 r4 = *(const f32x4*)(resid + off + bj * 128 + n * 16); const f32x4 o = r4 + acc[ai][bj][m][n];
                        *(f32x4*)(out + off + bj * 128 + n * 16) = o; u32x2 w; w.x = pk2(o[0], o[1]); w.y = pk2(o[2], o[3]); *(u32x2*)(xb + off + bj * 128 + n * 16) = w;
                        ss += (o[0] * o[0] + o[1] * o[1]) + (o[2] * o[2] + o[3] * o[3]); }
                ss += __shfl_xor(ss, 16); ss += __shfl_xor(ss, 32);
                if (fq == 0) ssq[(size_t)row * 16 + u.pn * 4 + wc] = ss; }
    }
};

namespace mx {
constexpr int RSB = 272;
constexpr int TILE_BYTES = 64 * RSB;
constexpr int OFF_Q = 0, OFF_K = TILE_BYTES, OFF_K2 = 2 * TILE_BYTES, OFF_V = 3 * TILE_BYTES, OFF_DC = 4 * TILE_BYTES, OFF_END = OFF_DC + 2048;
constexpr int HALF_BYTES = OFF_END;
constexpr int OFF_SSX = 2 * HALF_BYTES;
constexpr int OS_STRIDE = 132;
static_assert(64 * OS_STRIDE * 4 <= 2 * TILE_BYTES && OFF_SSX + 512 <= MISC_OFF, "mixer LDS map");

struct Half {
    int kind;
    int t0;
    int qcol, kcol, gcol, vcol, ocol;
    const float* nw;
    int hu;
    int seg;
};
__device__ __forceinline__ Half make_half(int u, int half, int layer, const Args& a) {
    Half h;
    if (u < 256) { const int b = u >> 5, hd = (u >> 3) & 3, seg = u & 7; h.kind = 0; h.seg = seg; h.t0 = b * SEQ + seg * SEGLEN;
        h.qcol = C_GQ + hd * 128; h.kcol = C_GK + hd * 128; h.gcol = C_GG + hd * 128; h.vcol = C_GV + hd * 256 + half * 128; h.ocol = C_SG + hd * 256 + half * 128; h.nw = a.gla_nw + layer * 256 + half * 128; }
    else { const int v = u - 256, b = v >> 4, hp = (v >> 3) & 1, seg = v & 7, hd = 2 * hp + half; h.kind = 1; h.seg = seg; h.t0 = b * SEQ + seg * SEGLEN;
        h.qcol = C_HQ + hd * 128; h.kcol = 0; h.gcol = C_HLF + hd * 128; h.vcol = C_HI + hd * 128; h.ocol = C_SG + 1024 + hd * 128; h.nw = a.hgrn_nw + layer * 128; }
    h.hu = u * 2 + half;
    return h;
}

template <int PASS>
__device__ __forceinline__ void mix_unit(const Frame& F, const Args& a, int u, int layer) {
    const int tid = fresh_tid();
    const int lane = tid & 63, half = F.wave >> 2, hw = F.wave & 3, tih = tid & 255;
    const int li = lane & 15, g4 = lane >> 4, q_ = li >> 2, p_ = li & 3;
    const Half H = make_half(u, half, layer, a);
    LAS unsigned char* L = F.lds + half * HALF_BYTES;
    const bf16* P = (const bf16*)(a.ws + WS_P);
    float* SEND = (float*)(a.ws + WS_SEND); float* DTOT = (float*)(a.ws + WS_DTOT);
    f32x4 S[8][2];
#pragma unroll
    for (int dt = 0; dt < 8; ++dt) { S[dt][0] = (f32x4){0.f, 0.f, 0.f, 0.f}; S[dt][1] = (f32x4){0.f, 0.f, 0.f, 0.f}; }
    if (PASS == 1) {
        for (int s = 0; s < H.seg; ++s) { const int hu2 = H.hu - 2 * (H.seg - s); const float* sp = SEND + (size_t)hu2 * 16384 + (size_t)(hw * 16) * 256 + lane * 4; const float* dp = DTOT + (size_t)hu2 * 128 + 4 * g4;
#pragma unroll
            for (int dt = 0; dt < 8; ++dt) { const f32x4 dv = *(const f32x4*)(dp + 16 * dt);
#pragma unroll
                for (int vt = 0; vt < 2; ++vt) { const f32x4 sv = *(const f32x4*)(sp + (dt * 2 + vt) * 256); S[dt][vt] = S[dt][vt] * dv + sv; } } }
    }
    float lt0 = 0.f, lt1 = 0.f;
    for (int mc = 0; mc < NMC; ++mc) {
        const int tb = H.t0 + mc * 64;
        {
            const bf16* rowp = P + (size_t)(tb + 16 * hw) * LDP + 2 * lane;
            unsigned gw_[16], kw_[16], qw_[16];
#pragma unroll
            for (int j = 0; j < 16; ++j) { gw_[j] = *(const unsigned*)(rowp + (size_t)j * LDP + H.gcol);
                if (H.kind == 0) kw_[j] = *(const unsigned*)(rowp + (size_t)j * LDP + H.kcol); else kw_[j] = 0u;
                if (PASS == 1) qw_[j] = *(const unsigned*)(rowp + (size_t)j * LDP + H.qcol); else qw_[j] = 0u; }
            u32x4 vv[4];
#pragma unroll
            for (int i = 0; i < 4; ++i) { const int p = tih + 256 * i, r = p >> 4, c8 = p & 15; vv[i] = *(const u32x4*)(P + (size_t)(tb + r) * LDP + H.vcol + 8 * c8); }
#pragma unroll
            for (int i = 0; i < 4; ++i) { const int p = tih + 256 * i, r = p >> 4, c8 = p & 15; *(LAS u32x4*)(L + OFF_V + r * RSB + c8 * 16) = vv[i]; }
            float g0[16], g1[16], k0[16], k1[16];
#pragma unroll
            for (int j = 0; j < 16; ++j) { const f16x2 gh = __builtin_bit_cast(f16x2, gw_[j]); g0[j] = (float)gh.x; g1[j] = (float)gh.y;
                if (H.kind == 0) { k0[j] = bflo(kw_[j]); k1[j] = bfhi(kw_[j]); } else { k0[j] = 1.f - fexp(g0[j]); k1[j] = 1.f - fexp(g1[j]); } }
            if (PASS == 1) {
                float r0 = 0.f, r1 = 0.f;
#pragma unroll
                for (int j = 0; j < 16; ++j) { r0 += g0[j]; r1 += g1[j];
                    const float q0 = bflo(qw_[j]) * fexp(r0), q1 = bfhi(qw_[j]) * fexp(r1);
                    const float kh0 = k0[j] * fexp(fminf(-r0, 80.f)), kh1 = k1[j] * fexp(fminf(-r1, 80.f));
                    *(LAS unsigned*)(L + OFF_Q + (16 * hw + j) * RSB + lane * 4) = pk2(q0, q1);
                    *(LAS unsigned*)(L + OFF_K + (16 * hw + j) * RSB + lane * 4) = pk2(kh0, kh1); }
            }
            float s0 = 0.f, s1 = 0.f;
#pragma unroll
            for (int j = 15; j >= 0; --j) { *(LAS unsigned*)(L + OFF_K2 + (16 * hw + j) * RSB + lane * 4) = pk2(k0[j] * fexp(s0), k1[j] * fexp(s1)); s0 += g0[j]; s1 += g1[j]; }
            f32x2 dd; dd.x = fexp(s0); dd.y = fexp(s1);
            *(LAS f32x2*)(L + OFF_DC + hw * 512 + lane * 8) = dd;
            lt0 += s0; lt1 += s1;
        }
        LDS_WAIT(); __syncthreads();
        f32x4 oc[4][2];
#pragma unroll
        for (int c = 0; c < 4; ++c) {
            const int rb = 16 * c;
            bf16x8 vb[2];
#pragma unroll
            for (int vt = 0; vt < 2; ++vt) { const s16x4 t4 = tr16(L + OFF_V + (rb + 4 * g4 + q_) * RSB + (32 * hw + 16 * vt + 4 * p_) * 2); vb[vt] = (bf16x8){t4[0], t4[1], t4[2], t4[3], 0, 0, 0, 0}; }
            if (PASS == 1) {
                f32x4 at = (f32x4){0.f, 0.f, 0.f, 0.f};
#pragma unroll
                for (int ks = 0; ks < 4; ++ks) { const bf16x8 ka = *(const LAS bf16x8*)(L + OFF_K + (rb + li) * RSB + (32 * ks + 8 * g4) * 2); const bf16x8 qb = *(const LAS bf16x8*)(L + OFF_Q + (rb + li) * RSB + (32 * ks + 8 * g4) * 2);
                    at = __builtin_amdgcn_mfma_f32_16x16x32_bf16(ka, qb, at, 0, 0, 0); }
#pragma unroll
                for (int r = 0; r < 4; ++r) at[r] = (4 * g4 + r <= li) ? at[r] : 0.f;
                const unsigned pa0 = pk2(at[0], at[1]), pa1 = pk2(at[2], at[3]);
                const bf16x8 pa = __builtin_bit_cast(bf16x8, (u32x4){pa0, pa1, 0u, 0u});
                f32x4 o0 = __builtin_amdgcn_mfma_f32_16x16x32_bf16(pa, vb[0], (f32x4){0.f, 0.f, 0.f, 0.f}, 0, 0, 0);
                f32x4 o1 = __builtin_amdgcn_mfma_f32_16x16x32_bf16(pa, vb[1], (f32x4){0.f, 0.f, 0.f, 0.f}, 0, 0, 0);
#pragma unroll
                for (int ks = 0; ks < 4; ++ks) {
                    const u32x2 qa0 = *(const LAS u32x2*)(L + OFF_Q + (rb + li) * RSB + (32 * ks + 4 * g4) * 2), qa1 = *(const LAS u32x2*)(L + OFF_Q + (rb + li) * RSB + (32 * ks + 16 + 4 * g4) * 2);
                    const bf16x8 qa = __builtin_bit_cast(bf16x8, (u32x4){qa0.x, qa0.y, qa1.x, qa1.y});
                    const bf16x8 sb0 = __builtin_bit_cast(bf16x8, (u32x4){pk2(S[2 * ks][0][0], S[2 * ks][0][1]), pk2(S[2 * ks][0][2], S[2 * ks][0][3]), pk2(S[2 * ks + 1][0][0], S[2 * ks + 1][0][1]), pk2(S[2 * ks + 1][0][2], S[2 * ks + 1][0][3])});
                    const bf16x8 sb1 = __builtin_bit_cast(bf16x8, (u32x4){pk2(S[2 * ks][1][0], S[2 * ks][1][1]), pk2(S[2 * ks][1][2], S[2 * ks][1][3]), pk2(S[2 * ks + 1][1][0], S[2 * ks + 1][1][1]), pk2(S[2 * ks + 1][1][2], S[2 * ks + 1][1][3])});
                    o0 = __builtin_amdgcn_mfma_f32_16x16x32_bf16(qa, sb0, o0, 0, 0, 0);
                    o1 = __builtin_amdgcn_mfma_f32_16x16x32_bf16(qa, sb1, o1, 0, 0, 0); }
                oc[c][0] = o0; oc[c][1] = o1;
            }
#pragma unroll
            for (int dt = 0; dt < 8; ++dt) { const s16x4 t4 = tr16(L + OFF_K2 + (rb + 4 * g4 + q_) * RSB + (16 * dt + 4 * p_) * 2); const bf16x8 ka = (bf16x8){t4[0], t4[1], t4[2], t4[3], 0, 0, 0, 0};
                const f32x4 dv = *(const LAS f32x4*)(L + OFF_DC + c * 512 + (16 * dt + 4 * g4) * 4);
                S[dt][0] = __builtin_amdgcn_mfma_f32_16x16x32_bf16(ka, vb[0], S[dt][0] * dv, 0, 0, 0);
                S[dt][1] = __builtin_amdgcn_mfma_f32_16x16x32_bf16(ka, vb[1], S[dt][1] * dv, 0, 0, 0); }
        }
        LDS_WAIT(); __syncthreads();
        if (PASS == 1) {
            LAS float* Os = (LAS float*)(L + OFF_Q);
#pragma unroll
            for (int c = 0; c < 4; ++c)
#pragma unroll
                for (int vt = 0; vt < 2; ++vt)
#pragma unroll
                    for (int r = 0; r < 4; ++r) Os[(16 * c + 4 * g4 + r) * OS_STRIDE + 32 * hw + 16 * vt + li] = oc[c][vt][r];
            const int i = tih >> 2, vq = tih & 3;
            bf16* orow = (bf16*)P + (size_t)(tb + i) * LDP + H.ocol + 32 * vq;
            u32x4 gt[4];
#pragma unroll
            for (int k = 0; k < 4; ++k) gt[k] = *(const u32x4*)(orow + 8 * k);
            LDS_WAIT(); __syncthreads();
            f32x4 ov[8]; float ss = 0.f;
#pragma unroll
            for (int k = 0; k < 8; ++k) { ov[k] = *(const LAS f32x4*)(Os + i * OS_STRIDE + 32 * vq + 4 * k); ss += (ov[k].x * ov[k].x + ov[k].y * ov[k].y) + (ov[k].z * ov[k].z + ov[k].w * ov[k].w); }
            ss += __shfl_xor(ss, 1); ss += __shfl_xor(ss, 2);
            float tot = ss, nd = 128.f;
            if (H.kind == 0) {
                LAS float* SX = (LAS float*)(F.lds + OFF_SSX);
                if (vq == 0) SX[half * 64 + i] = ss;
                LDS_WAIT(); __syncthreads();
                tot = SX[i] + SX[64 + i]; nd = 256.f;
            }
            const float rstd = 1.0f / sqrtf(tot / nd + NORM_EPS);
#pragma unroll
            for (int k = 0; k < 4; ++k) { const f32x4 w0 = *(const f32x4*)(H.nw + 32 * vq + 8 * k), w1 = *(const f32x4*)(H.nw + 32 * vq + 8 * k + 4); const f32x4 a0 = ov[2 * k], a1 = ov[2 * k + 1]; const u32x4 gg = gt[k];
                u32x4 w; w.x = pk2(a0.x * rstd * w0.x * bflo(gg.x), a0.y * rstd * w0.y * bfhi(gg.x)); w.y = pk2(a0.z * rstd * w0.z * bflo(gg.y), a0.w * rstd * w0.w * bfhi(gg.y));
                w.z = pk2(a1.x * rstd * w1.x * bflo(gg.z), a1.y * rstd * w1.y * bfhi(gg.z)); w.w = pk2(a1.z * rstd * w1.z * bflo(gg.w), a1.w * rstd * w1.w * bfhi(gg.w));
                *(u32x4*)(orow + 8 * k) = w; }
            LDS_WAIT(); __syncthreads();
        }
    }
    if (PASS == 0) {
        float* sp = SEND + (size_t)H.hu * 16384 + (size_t)(hw * 16) * 256 + lane * 4;
#pragma unroll
        for (int dt = 0; dt < 8; ++dt)
#pragma unroll
            for (int vt = 0; vt < 2; ++vt) *(f32x4*)(sp + (dt * 2 + vt) * 256) = S[dt][vt];
        LAS float* LT = (LAS float*)(L + OFF_DC);
        f32x2 lt; lt.x = lt0; lt.y = lt1; *(LAS f32x2*)(L + OFF_DC + hw * 512 + lane * 8) = lt;
        LDS_WAIT(); __syncthreads();
        if (tih < 128) DTOT[(size_t)H.hu * 128 + tih] = fexp(LT[tih] + LT[128 + tih] + LT[256 + tih] + LT[384 + tih]);
        LDS_WAIT(); __syncthreads();
    }
}
}

namespace xa {
constexpr int RSB = 272;
constexpr int OFF_KX = 0, OFF_VX = 256 * RSB;
static_assert(2 * 256 * RSB <= MISC_OFF, "xattn LDS map");
__device__ __forceinline__ void xa_unit(const Frame& F, const Args& a, int x, int layer) {
    const int tid = fresh_tid();
    const int lane = tid & 63, wid = F.wave, li = lane & 15, g4 = lane >> 4, q_ = li >> 2, p_ = li & 3;
    const int b = x >> 5, h = (x >> 3) & 3, tr = x & 7, t0 = b * SEQ + tr * 512 + wid * 64;
    LAS unsigned char* L = F.lds;
    bf16* P = (bf16*)(a.ws + WS_P); const bf16* MKV = (const bf16*)(a.ws + WS_MKV);
    const float* nw = a.xattn_nw + layer * 128;
#pragma unroll
    for (int i = 0; i < 8; ++i) { const int p = tid + 512 * i, r = p >> 4, c8 = p & 15; const bf16* src = MKV + (size_t)(b * MEML + r) * 2048 + layer * 1024 + h * 128 + 8 * c8;
        const u32x4 kk = *(const u32x4*)src, vv = *(const u32x4*)(src + 512);
        *(LAS u32x4*)(L + OFF_KX + r * RSB + c8 * 16) = kk; *(LAS u32x4*)(L + OFF_VX + r * RSB + c8 * 16) = vv; }
    LDS_WAIT(); __syncthreads();
    for (int it = 0; it < 4; ++it) {
        const int tb = t0 + 16 * it;
        unsigned kxo = OFF_KX, vxo = OFF_VX; asm volatile("" : "+v"(kxo), "+v"(vxo));
        bf16x8 qb[4];
#pragma unroll
        for (int ks = 0; ks < 4; ++ks) qb[ks] = *(const bf16x8*)(P + (size_t)(tb + li) * LDP + C_XQ + h * 128 + 32 * ks + 8 * g4);
        f32x4 s[16];
#pragma unroll
        for (int mt = 0; mt < 16; ++mt) { s[mt] = (f32x4){0.f, 0.f, 0.f, 0.f};
#pragma unroll
            for (int ks = 0; ks < 4; ++ks) { const bf16x8 ka = *(const LAS bf16x8*)(L + kxo + (16 * mt + li) * RSB + (32 * ks + 8 * g4) * 2); s[mt] = __builtin_amdgcn_mfma_f32_16x16x32_bf16(ka, qb[ks], s[mt], 0, 0, 0); } }
        float mxv = s[0][0];
#pragma unroll
        for (int mt = 0; mt < 16; ++mt)
#pragma unroll
            for (int r = 0; r < 4; ++r) mxv = fmaxf(mxv, s[mt][r]);
        mxv = fmaxf(mxv, __shfl_xor(mxv, 16)); mxv = fmaxf(mxv, __shfl_xor(mxv, 32));
        float lsum = 0.f;
#pragma unroll
        for (int mt = 0; mt < 16; ++mt)
#pragma unroll
            for (int r = 0; r < 4; ++r) { s[mt][r] = fexp(s[mt][r] - mxv); lsum += s[mt][r]; }
        lsum += __shfl_xor(lsum, 16); lsum += __shfl_xor(lsum, 32);
        f32x4 o[8];
#pragma unroll
        for (int vt = 0; vt < 8; ++vt) o[vt] = (f32x4){0.f, 0.f, 0.f, 0.f};
#pragma unroll
        for (int k2 = 0; k2 < 8; ++k2) {
            const bf16x8 pa = __builtin_bit_cast(bf16x8, (u32x4){pk2(s[2 * k2][0], s[2 * k2][1]), pk2(s[2 * k2][2], s[2 * k2][3]), pk2(s[2 * k2 + 1][0], s[2 * k2 + 1][1]), pk2(s[2 * k2 + 1][2], s[2 * k2 + 1][3])});
#pragma unroll
            for (int vt = 0; vt < 8; ++vt) { const s16x4 t0_ = tr16(L + vxo + (32 * k2 + 4 * g4 + q_) * RSB + (16 * vt + 4 * p_) * 2), t1_ = tr16(L + vxo + (32 * k2 + 16 + 4 * g4 + q_) * RSB + (16 * vt + 4 * p_) * 2);
                const bf16x8 vb = (bf16x8){t0_[0], t0_[1], t0_[2], t0_[3], t1_[0], t1_[1], t1_[2], t1_[3]};
                o[vt] = __builtin_amdgcn_mfma_f32_16x16x32_bf16(pa, vb, o[vt], 0, 0, 0); } }
        float ssq[4];
#pragma unroll
        for (int r = 0; r < 4; ++r) { const float linv = 1.0f / __shfl(lsum, 4 * g4 + r); float ss = 0.f;
#pragma unroll
            for (int vt = 0; vt < 8; ++vt) { o[vt][r] *= linv; ss += o[vt][r] * o[vt][r]; }
            ss += __shfl_xor(ss, 1); ss += __shfl_xor(ss, 2); ss += __shfl_xor(ss, 4); ss += __shfl_xor(ss, 8); ssq[r] = ss; }
#pragma unroll
        for (int r = 0; r < 4; ++r) { const float rstd = 1.0f / sqrtf(ssq[r] * (1.f / 128.f) + NORM_EPS); bf16* orow = P + (size_t)(tb + 4 * g4 + r) * LDP + C_SG + 1536 + h * 128 + li;
#pragma unroll
            for (int vt = 0; vt < 8; ++vt) { const float gate = __builtin_bit_cast(float, (unsigned)orow[16 * vt] << 16); orow[16 * vt] = (bf16)f2bf(o[vt][r] * rstd * nw[16 * vt + li] * gate); } }
    }
    LDS_WAIT(); __syncthreads();
}
}

__device__ __forceinline__ int next_item(const Frame& F, unsigned* head) {
    if (threadIdx.x == 0) F.MISC[4] = __hip_atomic_fetch_add(head, 1u, RLX_AGENT);
    __syncthreads();
    const int it = (int)F.MISC[4];
    __syncthreads();
    return it;
}

constexpr int N_PHASES = 10;
__global__ void __launch_bounds__(512, 2) mega(Args args) {
    extern __shared__ __attribute__((aligned(16))) unsigned char lds_raw[];
    Frame F;
    F.lds = (LAS unsigned char*)lds_raw; F.MISC = (volatile LAS unsigned*)(F.lds + MISC_OFF);
    F.wave = __builtin_amdgcn_readfirstlane(threadIdx.x >> 6);
    F.G = gridDim.x; { const int bx = blockIdx.x; F.vcu = (F.G % 8 == 0) ? (bx % 8) * (F.G / 8) + bx / 8 : bx; }
    F.ctl = (unsigned*)(args.ws + WS_CTL);
    if (threadIdx.x < 16) F.MISC[threadIdx.x] = 0u;
    __syncthreads();
    XcdBarrier bar; bar.bar = F.ctl + CW_BAR; bar.x = 0; bar.st = nullptr;
    if (!MK_PER_PHASE) bar = xcd_barrier_post(F.ctl + CW_BAR, F.MISC + 8);
    const int lo = args.ph_lo, hi = args.ph_hi;
#define IN(k) (lo <= (k) && (k) < hi)
#define SEAM(k) do { if (IN(k) && IN((k) + 1)) xcd_barrier(bar); } while (0)
    bf16* P = (bf16*)(args.ws + WS_P);
    bf16* XB = (bf16*)(args.ws + WS_XB);

    if (IN(0)) { prep_w1(F, args, 0); prep_w2(F, args, 0); prep_wkv(F, args); prep_x(F, args); }
    SEAM(0);
    for (int layer = 0; layer < DEPTH; ++layer) {
        const int pb = 1 + 4 * layer;
        if (IN(pb)) {
            if (layer == 0) {
                pg8::Gemm g{(const bf16*)((unsigned char*)args.out + DO_MEMB), (const bf16*)((unsigned char*)args.out + DO_WKVT), MROWS, 2048, D, D, D};
                pg8::StaticOrder S; S.init(MROWS, 2048, F.G, (int)blockIdx.x);
                EpiMem E{(bf16*)(args.ws + WS_MKV), (const float*)((unsigned char*)args.out + DO_RSTDM)};
                pg8::gemm_phase<EpiMem, pg8::StaticOrder, true, true>(F.lds, g, S, E);
            }
            pg8::Gemm g{XB, (const bf16*)(args.ws + WS_W1T), T, NP, D, D, D};
            pg8::StaticOrder S; S.init(T, NP, F.G, (int)blockIdx.x);
            EpiProj E{P, layer == 0 ? (const float*)((unsigned char*)args.out + DO_SSQ0) : (const float*)(args.ws + WS_SSQ1), args.gla_b + layer * 512, args.hgrn_lb, layer};
            pg8::gemm_phase<EpiProj, pg8::StaticOrder, true, true>(F.lds, g, S, E);
        }
        SEAM(pb);
        if (IN(pb + 1)) {
            if (layer == 0) prep_w1(F, args, 1); else prep_w2(F, args, 1);
            __syncthreads();
            unsigned* head = F.ctl + CW_QUEUE + 64 * (2 * layer);
            for (;;) { const int it = next_item(F, head); if (it >= N_MIX_UNITS + N_XA_UNITS) break;
                if (it < N_MIX_UNITS) mx::mix_unit<0>(F, args, it, layer); else xa::xa_unit(F, args, it - N_MIX_UNITS, layer); }
        }
        SEAM(pb + 1);
        if (IN(pb + 2)) {
            unsigned* head = F.ctl + CW_QUEUE + 64 * (2 * layer + 1);
            for (;;) { const int it = next_item(F, head); if (it >= N_MIX_UNITS) break; mx::mix_unit<1>(F, args, it, layer); }
        }
        SEAM(pb + 2);
        if (IN(pb + 3)) {
            pg8::Gemm g{P + C_SG, (const bf16*)(args.ws + WS_W2T), T, D, DMIX, LDP, DMIX};
            pg8::StaticOrder S; S.init(T, D, F.G, (int)blockIdx.x);
            EpiRes E{layer == 0 ? args.x : (const float*)args.out, args.out, XB, (float*)(args.ws + (layer == 0 ? WS_SSQ1 : WS_SSQ2))};
            pg8::gemm_phase<EpiRes, pg8::StaticOrder, true, true>(F.lds, g, S, E);
        }
        SEAM(pb + 3);
    }
    if (IN(9)) {
        const int lane_ = fresh_tid() & 63;
        const int gw = F.vcu * 8 + F.wave, NGW = F.G * 8; const float* ssq = (const float*)(args.ws + WS_SSQ2);
        f32x4 fw[4];
#pragma unroll
        for (int j = 0; j < 4; ++j) fw[j] = *((const f32x4*)args.final_nw + lane_ + 64 * j);
        for (int m = gw; m < T; m += NGW) { float s = lane_ < 16 ? ssq[(size_t)m * 16 + lane_] : 0.f; s = wave_sum(s); const float rstd = 1.0f / sqrtf(s * (1.f / D) + NORM_EPS);
            f32x4* xr = (f32x4*)(args.out + (size_t)m * D) + lane_;
#pragma unroll
            for (int j = 0; j < 4; ++j) { const f32x4 v = xr[64 * j]; xr[64 * j] = v * rstd * fw[j]; } }
    }
#undef IN
#undef SEAM
}

extern "C" void kernel_launch(void* const* d_in, const int* in_sizes, int n_in, void* d_out, int out_size, void* d_ws, size_t ws_size, hipStream_t stream) {
    static int grid = 0;
    if (grid == 0) {
        if (n_in != 14 || in_sizes[0] != T * D || out_size != T * D || ws_size < WS_END) { fprintf(stderr, "kernel_launch: unexpected shapes (n_in %d, in0 %d, out %d, ws %zu)\n", n_in, n_in > 0 ? in_sizes[0] : -1, out_size, ws_size); grid = -1; return; }
        int dev = 0, cus = 0, per_cu = 0;
        if (hipGetDevice(&dev) != hipSuccess || hipDeviceGetAttribute(&cus, hipDeviceAttributeMultiprocessorCount, dev) != hipSuccess) { grid = -1; return; }
        if (hipFuncSetAttribute((const void*)mega, hipFuncAttributeMaxDynamicSharedMemorySize, LDS_BYTES) != hipSuccess) { fprintf(stderr, "kernel_launch: hipFuncSetAttribute failed\n"); grid = -1; return; }
        if (hipOccupancyMaxActiveBlocksPerMultiprocessor(&per_cu, (const void*)mega, 512, LDS_BYTES) != hipSuccess || per_cu < 1) { fprintf(stderr, "kernel_launch: occupancy query says %d blocks per CU\n", per_cu); grid = -1; (void)hipGetLastError(); return; }
        grid = cus;
    }
    if (grid < 0) return;
    (void)hipMemsetAsync((char*)d_ws + WS_CTL, 0, CTL_ZERO_BYTES, stream);
    Args a{};
    a.x = (const float*)d_in[0]; a.mem = (const float*)d_in[1]; a.norm_w = (const float*)d_in[2]; a.w_in = (const float*)d_in[3]; a.gla_wup = (const float*)d_in[4]; a.gla_b = (const float*)d_in[5];
    a.gla_nw = (const float*)d_in[6]; a.hgrn_lb = (const float*)d_in[7]; a.hgrn_nw = (const float*)d_in[8]; a.mem_nw = (const float*)d_in[9]; a.w_mkv = (const float*)d_in[10]; a.xattn_nw = (const float*)d_in[11];
    a.w_out = (const float*)d_in[12]; a.final_nw = (const float*)d_in[13]; a.out = (float*)d_out; a.ws = (unsigned char*)d_ws;
#if MK_PER_PHASE
    for (int p = 0; p < N_PHASES; ++p) { a.ph_lo = p; a.ph_hi = p + 1; hipLaunchKernelGGL(mega, dim3(grid), dim3(512), LDS_BYTES, stream, a); }
#else
    a.ph_lo = 0; a.ph_hi = N_PHASES;
    void* kargs[] = {&a};
    hipError_t e = hipLaunchCooperativeKernel((const void*)mega, dim3(grid), dim3(512), kargs, LDS_BYTES, stream);
    if (e != hipSuccess) fprintf(stderr, "kernel_launch: cooperative launch failed: %s (grid %d)\n", hipGetErrorString(e), grid);
#endif
}
```

```cpp
#include <hip/hip_runtime.h>
#include <cstdio>
#include <cstdint>

#ifndef MK_PER_PHASE
#define MK_PER_PHASE 0
#endif

#define LAS __attribute__((address_space(3)))
#define GAS __attribute__((address_space(1)))
__device__ __forceinline__ int fresh_tid() { int t = threadIdx.x; asm volatile("" : "+v"(t)); return t; }

namespace pg8 {
typedef unsigned short bf16_t;
typedef short bf16x8 __attribute__((ext_vector_type(8)));
typedef float f32x4 __attribute__((ext_vector_type(4)));
typedef unsigned u32x4 __attribute__((ext_vector_type(4)));
typedef unsigned u32x2 __attribute__((ext_vector_type(2)));
constexpr int BM = 256, BK = 64, HALF = 128, HTB = HALF * BK * 2, STAGE_BYTES = 8 * HTB, NXCD = 8, WGM = 8;

__host__ __device__ __forceinline__ int lds_byte(int r, int c) { const int st = (r >> 4) * 2 + (c >> 5), rr = r & 15, cc = c & 31, ob = rr * 64 + cc * 2; return st * 1024 + (ob ^ (((ob >> 9) & 1) << 5)); }
__host__ __device__ __forceinline__ void stage_rc(int b, int& R, int& C) { const int st = b / 1024, sb = b % 1024, swz = sb ^ (((sb >> 9) & 1) << 5); R = (st >> 1) * 16 + swz / 64; C = (st & 1) * 32 + (swz % 64) / 2; }
__host__ __device__ __forceinline__ int perm32(int rho) { const int n = rho >> 4, i = rho & 15; return 8 * (i >> 2) + 4 * n + (i & 3); }

struct Unit { int pm, pn; };
struct Gemm { const bf16_t* A; const bf16_t* Bt; int M, N, K, lda, ldb; };

struct StaticOrder {
    int nM, nN, nwg, G, c;
    __host__ __device__ void init(int M, int N, int G_, int c_) { nM = M / BM; nN = N / BM; nwg = nM * nN; G = G_; c = c_; }
    __host__ __device__ bool next(int i, Unit& u) const {
        const long L = (long)i * G + c; if (L >= nwg) return false;
        int wgid = (int)L; { const int q = nwg / NXCD, r = nwg % NXCD, xcd = wgid % NXCD, off = wgid / NXCD; wgid = (xcd < r ? xcd * (q + 1) : r * (q + 1) + (xcd - r) * q) + off; }
        const int nig = WGM * nN, gid = wgid / nig, fm = gid * WGM, gsz = (nM - fm) < WGM ? (nM - fm) : WGM;
        u.pm = fm + ((wgid % nig) % gsz); u.pn = (wgid % nig) / gsz; return true;
    }
    __device__ __forceinline__ void a_ready(const Unit&) const {}
    __device__ __forceinline__ void done(const Unit&) const {}
};

template <class Epi, class Sched, bool ALIGN_EPI = false, bool SP2 = false>
__device__ __forceinline__ void gemm_phase(LAS unsigned char* lds, const Gemm g, const Sched& S, const Epi& E) {
    const int tid = fresh_tid();
    const int wid = __builtin_amdgcn_readfirstlane(tid >> 6), lane = tid & 63, wr = wid >> 2, wc = wid & 3, fr = lane & 15, fq = lane >> 4;
    const int K = g.K, nt = K / BK;
    unsigned voffA[2], voffB[2];
#pragma unroll
    for (int i = 0; i < 2; ++i) { int R, C; stage_rc(tid * 16 + i * 8192, R, C); const int Rb = Epi::PERM ? ((R & ~31) + perm32(R & 31)) : R;
        voffA[i] = (unsigned)(R * g.lda + C) * 2u; voffB[i] = (unsigned)(Rb * g.ldb + C) * 2u; }
    const size_t kstep = (size_t)(BK * 2);
    const size_t hstepA = (size_t)HALF * g.lda * 2, hstepB = (size_t)HALF * g.ldb * 2;
    const size_t tstepA = 2 * hstepA, tstepB = 2 * hstepB;
    const unsigned ldsw = (unsigned)wid * 1024u;
    const int aoff = lds_byte(wr * 64 + fr, fq * 8), boff = lds_byte(wc * 32 + fr, fq * 8);
#define PG8_SA(b, h) (((b) * 2 + (h)) * HTB)
#define PG8_SB(b, h) ((4 + (b) * 2 + (h)) * HTB)
#define PG8_STAGE(bufoff, gbase, voff) do { _Pragma("unroll") for (int _i = 0; _i < 2; ++_i) \
        __builtin_amdgcn_global_load_lds((const unsigned*)((const char*)(gbase) + (voff)[_i]), (LAS unsigned*)(lds + (bufoff) + ldsw + _i * 8192), 16, 0, 0); } while (0)
#define PG8_LDA(dst, b, h) do { _Pragma("unroll") for (int m = 0; m < 4; ++m) _Pragma("unroll") for (int k = 0; k < 2; ++k) dst[m][k] = *(const LAS bf16x8*)(lds + PG8_SA(b, h) + aoff + m * 2048 + k * 1024); } while (0)
#define PG8_LDB(dst, b, h) do { _Pragma("unroll") for (int n = 0; n < 2; ++n) _Pragma("unroll") for (int k = 0; k < 2; ++k) dst[n][k] = *(const LAS bf16x8*)(lds + PG8_SB(b, h) + boff + n * 2048 + k * 1024); } while (0)
#define PG8_MMA(ai, bj, At, Bt) do { __builtin_amdgcn_s_setprio(1); _Pragma("unroll") for (int m = 0; m < 4; ++m) _Pragma("unroll") for (int n = 0; n < 2; ++n) _Pragma("unroll") for (int k = 0; k < 2; ++k) \
        acc[ai][bj][m][n] = __builtin_amdgcn_mfma_f32_16x16x32_bf16(Bt[n][k], At[m][k], acc[ai][bj][m][n], 0, 0, 0); __builtin_amdgcn_s_setprio(0); } while (0)
#define PG8_WAIT_V(n) asm volatile("s_waitcnt vmcnt(" #n ")" ::: "memory")
#define PG8_WAIT_L(n) asm volatile("s_waitcnt lgkmcnt(" #n ")" ::: "memory")
#define PG8_BAR __builtin_amdgcn_s_barrier()
#define PG8_SCHED __builtin_amdgcn_sched_barrier(0)
    Unit cur, nxt; int ui = 0;
    if (!S.next(0, cur)) return;
    f32x4 acc[2][2][4][2];
#pragma unroll
    for (int a = 0; a < 2; ++a)
#pragma unroll
        for (int b = 0; b < 2; ++b)
#pragma unroll
            for (int m = 0; m < 4; ++m)
#pragma unroll
                for (int n = 0; n < 2; ++n) acc[a][b][m][n] = (f32x4){0.f, 0.f, 0.f, 0.f};
    bf16x8 At[4][2], B0[2][2], B1[2][2];
    const char* cA = (const char*)g.A + (size_t)cur.pm * tstepA; const char* cB = (const char*)g.Bt + (size_t)cur.pn * tstepB;
    S.a_ready(cur);
    if constexpr (SP2) {
        PG8_STAGE(PG8_SB(0, 0), cB, voffB); PG8_STAGE(PG8_SB(0, 1), cB + hstepB, voffB); PG8_STAGE(PG8_SA(0, 0), cA, voffA); PG8_STAGE(PG8_SA(0, 1), cA + hstepA, voffA);
        if (wr == 1) PG8_BAR;
        PG8_WAIT_V(2); PG8_BAR;
        PG8_STAGE(PG8_SB(1, 0), cB + kstep, voffB); PG8_STAGE(PG8_SA(1, 0), cA + kstep, voffA); PG8_STAGE(PG8_SB(1, 1), cB + hstepB + kstep, voffB);
        PG8_WAIT_V(6); PG8_BAR;
    } else {
        PG8_STAGE(PG8_SB(0, 0), cB, voffB); PG8_STAGE(PG8_SA(0, 0), cA, voffA); PG8_STAGE(PG8_SB(0, 1), cB + hstepB, voffB); PG8_STAGE(PG8_SA(0, 1), cA + hstepA, voffA);
        if (wr == 1) PG8_BAR;
        PG8_WAIT_V(4); PG8_BAR;
        PG8_STAGE(PG8_SB(1, 0), cB + kstep, voffB); PG8_STAGE(PG8_SA(1, 0), cA + kstep, voffA); PG8_STAGE(PG8_SB(1, 1), cB + hstepB + kstep, voffB);
        PG8_WAIT_V(6); PG8_BAR;
    }
    for (;;) {
        const bool has_next = S.next(ui + 1, nxt);
        const char* nA = has_next ? (const char*)g.A + (size_t)nxt.pm * tstepA : cA; const char* nB = has_next ? (const char*)g.Bt + (size_t)nxt.pn * tstepB : cB;
        for (int t = 0; t < nt; t += 2) {
            const bool last = (t == nt - 2);
            const char* a1 = cA + (size_t)(t + 1) * kstep;
            const char* a2 = last ? nA : cA + (size_t)(t + 2) * kstep; const char* b2 = last ? nB : cB + (size_t)(t + 2) * kstep;
            const char* a3 = a2 + kstep; const char* b3 = b2 + kstep;
            if (last && has_next) S.a_ready(nxt);
            if constexpr (SP2) {
            PG8_LDB(B0, 0, 0); PG8_LDB(B1, 0, 1); PG8_SCHED; PG8_LDA(At, 0, 0); PG8_STAGE(PG8_SA(1, 1), a1 + hstepA, voffA);
            PG8_WAIT_V(8); PG8_WAIT_L(0); PG8_BAR; PG8_MMA(0, 0, At, B0); PG8_MMA(0, 1, At, B1); PG8_BAR; PG8_SCHED;
            PG8_LDA(At, 0, 1); PG8_STAGE(PG8_SB(0, 0), b2, voffB); PG8_STAGE(PG8_SB(0, 1), b2 + hstepB, voffB); PG8_STAGE(PG8_SA(0, 0), a2, voffA);
            PG8_WAIT_V(8); PG8_WAIT_L(0); PG8_BAR; PG8_MMA(1, 0, At, B0); PG8_MMA(1, 1, At, B1); PG8_BAR; PG8_SCHED;
            PG8_LDB(B0, 1, 0); PG8_LDB(B1, 1, 1); PG8_SCHED; PG8_LDA(At, 1, 0); PG8_STAGE(PG8_SA(0, 1), a2 + hstepA, voffA);
            PG8_WAIT_V(8); PG8_WAIT_L(0); PG8_BAR; PG8_MMA(0, 0, At, B0); PG8_MMA(0, 1, At, B1); PG8_BAR; PG8_SCHED;
            PG8_LDA(At, 1, 1); PG8_STAGE(PG8_SB(1, 0), b3, voffB); PG8_STAGE(PG8_SB(1, 1), b3 + hstepB, voffB); PG8_STAGE(PG8_SA(1, 0), a3, voffA);
            PG8_WAIT_V(8); PG8_WAIT_L(0); PG8_BAR; PG8_MMA(1, 0, At, B0); PG8_MMA(1, 1, At, B1); PG8_BAR; PG8_SCHED;
            } else {
            PG8_LDB(B0, 0, 0); PG8_SCHED; PG8_LDA(At, 0, 0); PG8_STAGE(PG8_SA(1, 1), a1 + hstepA, voffA);
            PG8_WAIT_L(8); PG8_BAR; PG8_WAIT_L(0); PG8_MMA(0, 0, At, B0); PG8_BAR; PG8_SCHED;
            PG8_LDB(B1, 0, 1); PG8_STAGE(PG8_SB(0, 0), b2, voffB);
            PG8_BAR; PG8_WAIT_L(0); PG8_MMA(0, 1, At, B1); PG8_BAR;
            PG8_LDA(At, 0, 1); PG8_STAGE(PG8_SA(0, 0), a2, voffA);
            PG8_BAR; PG8_WAIT_L(0); PG8_MMA(1, 0, At, B0); PG8_BAR; PG8_SCHED;
            PG8_STAGE(PG8_SB(0, 1), b2 + hstepB, voffB);
            PG8_WAIT_V(6); PG8_BAR; PG8_MMA(1, 1, At, B1); PG8_BAR;
            PG8_LDB(B0, 1, 0); PG8_SCHED; PG8_LDA(At, 1, 0); PG8_STAGE(PG8_SA(0, 1), a2 + hstepA, voffA);
            PG8_WAIT_L(8); PG8_BAR; PG8_WAIT_L(0); PG8_MMA(0, 0, At, B0); PG8_BAR; PG8_SCHED;
            PG8_LDB(B1, 1, 1); PG8_STAGE(PG8_SB(1, 0), b3, voffB);
            PG8_BAR; PG8_WAIT_L(0); PG8_MMA(0, 1, At, B1); PG8_BAR;
            PG8_LDA(At, 1, 1); PG8_STAGE(PG8_SA(1, 0), a3, voffA);
            PG8_BAR; PG8_WAIT_L(0); PG8_MMA(1, 0, At, B0); PG8_BAR; PG8_SCHED;
            PG8_STAGE(PG8_SB(1, 1), b3 + hstepB, voffB);
            PG8_WAIT_V(6); PG8_BAR; PG8_MMA(1, 1, At, B1); PG8_BAR;
            }
        }
        if constexpr (ALIGN_EPI) { if (wr == 0) PG8_BAR; }
        E(acc, cur, wr, wc, fr, fq); S.done(cur);
        if (!has_next) break;
#pragma unroll
        for (int a = 0; a < 2; ++a)
#pragma unroll
            for (int b = 0; b < 2; ++b)
#pragma unroll
                for (int m = 0; m < 4; ++m)
#pragma unroll
                    for (int n = 0; n < 2; ++n) acc[a][b][m][n] = (f32x4){0.f, 0.f, 0.f, 0.f};
        cur = nxt; cA = nA; cB = nB; ++ui;
        if constexpr (ALIGN_EPI) { if (wr == 1) PG8_BAR; }
    }
    PG8_WAIT_V(0);
    if constexpr (!ALIGN_EPI) { if (wr == 0) PG8_BAR; }
    PG8_BAR;
#undef PG8_SA
#undef PG8_SB
#undef PG8_STAGE
#undef PG8_LDA
#undef PG8_LDB
#undef PG8_MMA
#undef PG8_WAIT_V
#undef PG8_WAIT_L
#undef PG8_BAR
#undef PG8_SCHED
}
}

typedef unsigned short bf16;
typedef short bf16x8 __attribute__((ext_vector_type(8)));
typedef short s16x4 __attribute__((ext_vector_type(4)));
typedef float f32x4 __attribute__((ext_vector_type(4)));
typedef float f32x2 __attribute__((ext_vector_type(2)));
typedef unsigned u32x4 __attribute__((ext_vector_type(4)));
typedef unsigned u32x2 __attribute__((ext_vector_type(2)));
typedef _Float16 f16x2 __attribute__((ext_vector_type(2)));
typedef __bf16 bf16x2_t __attribute__((ext_vector_type(2)));
typedef short v4i16_t __attribute__((ext_vector_type(4)));

constexpr int NB = 8, SEQ = 4096, T = NB * SEQ, D = 1024, DEPTH = 2, DINP = 6160, DMIX = 2048, MEML = 256, MROWS = NB * MEML;
constexpr int NP = 6656;
constexpr int LDP = 6656;
constexpr int C_GQ = 0, C_GK = 512, C_GG = 1024, C_GV = 1536, C_HQ = 2560, C_HLF = 3072, C_HI = 3584, C_XQ = 4096, C_SG = 4608;
constexpr float NORM_EPS = 1e-6f;
constexpr int NSEG = 8, SEGLEN = 512, NMC = SEGLEN / 64;
constexpr int N_MIX_UNITS = 384;
constexpr int N_XA_UNITS = 256;

constexpr size_t MiB = 1u << 20;
constexpr size_t WS_CTL = 0, CTL_ZERO_BYTES = 1 * MiB;
constexpr size_t WS_SSQ1 = 1 * MiB, WS_SSQ2 = 3 * MiB;
constexpr size_t WS_MKV = 5 * MiB;
constexpr size_t WS_W1T = 13 * MiB;
constexpr size_t WS_W2T = 27 * MiB;
constexpr size_t WS_XB = 31 * MiB;
constexpr size_t WS_SEND = WS_XB, WS_DTOT = WS_XB + 48 * MiB;
constexpr size_t WS_P = 95 * MiB;
constexpr size_t WS_END = WS_P + (size_t)T * LDP * 2;
static_assert(WS_END <= 512 * MiB, "workspace map");
constexpr size_t DO_MEMB = 0, DO_WKVT = 4 * MiB, DO_SSQ0 = 8 * MiB, DO_RSTDM = 10 * MiB;
constexpr int CW_BAR = 4096;
constexpr int CW_QUEUE = 2048;
constexpr int LDS_BYTES = 147456, MISC_OFF = LDS_BYTES - 64;

#define LDS_WAIT() asm volatile("s_waitcnt lgkmcnt(0)" ::: "memory")
#define VM_WAIT() asm volatile("s_waitcnt vmcnt(0)" ::: "memory")
#define RLX_AGENT __ATOMIC_RELAXED, __HIP_MEMORY_SCOPE_AGENT
__device__ __forceinline__ unsigned f2bf(float f) { unsigned u = __builtin_bit_cast(unsigned, f); return (u + 0x7fffu + ((u >> 16) & 1u)) >> 16; }
__device__ __forceinline__ unsigned pk2(float lo, float hi) { f32x2 v = {lo, hi}; bf16x2_t b = __builtin_convertvector(v, bf16x2_t); return __builtin_bit_cast(unsigned, b); }
__device__ __forceinline__ unsigned pkh2(float lo, float hi) { f32x2 v = {lo, hi}; f16x2 h = __builtin_convertvector(v, f16x2); return __builtin_bit_cast(unsigned, h); }
__device__ __forceinline__ float bflo(unsigned w) { return __builtin_bit_cast(float, w << 16); }
__device__ __forceinline__ float bfhi(unsigned w) { return __builtin_bit_cast(float, w & 0xffff0000u); }
__device__ __forceinline__ float fexp(float x) { return __builtin_amdgcn_exp2f(x * 1.4426950408889634f); }
__device__ __forceinline__ float flog(float x) { return __builtin_amdgcn_logf(x) * 0.6931471805599453f; }
__device__ __forceinline__ float log_sigmoid(float z) { return fminf(z, 0.f) - flog(1.f + fexp(-fabsf(z))); }
__device__ __forceinline__ s16x4 tr16(const LAS unsigned char* p) { return __builtin_bit_cast(s16x4, __builtin_amdgcn_ds_read_tr16_b64_v4i16((LAS v4i16_t*)p)); }
__device__ __forceinline__ float wave_sum(float v) {
#pragma unroll
    for (int o = 1; o < 64; o <<= 1) v += __shfl_xor(v, o);
    return v;
}

#define XB_TMO      128
#define XB_XCNT(j)  (256  + 64 * (j))
#define XB_XSUB(j)  (1280 + 64 * (j))
#define XB_XGEN(j)  (2304 + 64 * (j))
#define XB_TOP      3328
#define XB_TOPGEN   3392
#define XCD_BAR_WORDS 3456
#define XB_SPIN_CAP (1u << 20)
__device__ __forceinline__ unsigned xb_ld(unsigned* p)              { return __hip_atomic_load(p, __ATOMIC_RELAXED, __HIP_MEMORY_SCOPE_AGENT); }
__device__ __forceinline__ unsigned xb_add(unsigned* p, unsigned v) { return __hip_atomic_fetch_add(p, v, __ATOMIC_RELAXED, __HIP_MEMORY_SCOPE_AGENT); }
__device__ __forceinline__ unsigned xb_xcc_id() { return (unsigned)__builtin_amdgcn_s_getreg((3 << 11) | 20) & 0xFu; }
#define XB_SPIN(cond, bar) do { unsigned _sp = 0; while (cond) { __builtin_amdgcn_s_sleep(1); \
    if ((++_sp & 255u) == 0u) { if (xb_ld(&(bar)[XB_TMO])) break; if (_sp > XB_SPIN_CAP) { atomicAdd(&(bar)[XB_TMO], 1u); break; } } } } while (0)
struct XcdBarrier { unsigned* bar; unsigned x; volatile LAS unsigned* st; };
__device__ __forceinline__ XcdBarrier xcd_barrier_post(unsigned* bar, volatile LAS unsigned* st) {
    XcdBarrier b; b.bar = bar; b.x = xb_xcc_id(); b.st = st;
    if (threadIdx.x == 0) (void)xb_add(&bar[XB_XCNT(b.x)], 1u);
    return b;
}
__device__ __forceinline__ void xcd_barrier_complete(unsigned* bar, unsigned x, unsigned& nloc, unsigned& nx) {
    const unsigned G = gridDim.x * gridDim.y * gridDim.z;
    unsigned sum, cnt, mine, sp = 0u;
    for (;;) {
        sum = 0u; cnt = 0u; mine = 0u;
#pragma unroll
        for (unsigned j = 0; j < 16; ++j) { const unsigned c = xb_ld(&bar[XB_XCNT(j)]); sum += c; cnt += (c > 0u) ? 1u : 0u; mine = (j == x) ? c : mine; }
        if (sum == G) break;
        __builtin_amdgcn_s_sleep(1);
        if ((++sp & 255u) == 0u) { if (xb_ld(&bar[XB_TMO])) break; if (sp > XB_SPIN_CAP) { atomicAdd(&bar[XB_TMO], 1u); break; } }
    }
    nloc = mine > 0u ? mine : 1u; nx = cnt > 0u ? cnt : 1u;
}
__device__ __forceinline__ void xcd_barrier(const XcdBarrier& b) {
    asm volatile("s_waitcnt vmcnt(0)" ::: "memory");
    __syncthreads();
    if (threadIdx.x == 0) {
        unsigned* bar = b.bar;
        __builtin_amdgcn_s_waitcnt(0);
        unsigned nloc = b.st[0], nx = b.st[1];
        if (nloc == 0u) { xcd_barrier_complete(bar, b.x, nloc, nx); b.st[0] = nloc; b.st[1] = nx; }
        const unsigned old = xb_add(&bar[XB_XSUB(b.x)], 1u);
        const unsigned gen = old / nloc;
        if (old + 1u == (gen + 1u) * nloc) {
            __builtin_amdgcn_fence(__ATOMIC_RELEASE, "agent");
            asm volatile("s_waitcnt vmcnt(0)" ::: "memory");
            const unsigned og = xb_add(&bar[XB_TOP], 1u);
            const unsigned tg = og / nx;
            if (og + 1u == (tg + 1u) * nx) xb_add(&bar[XB_TOPGEN], 1u);
            else XB_SPIN(xb_ld(&bar[XB_TOPGEN]) == tg, bar);
            __builtin_amdgcn_fence(__ATOMIC_ACQUIRE, "agent");
            xb_add(&bar[XB_XGEN(b.x)], 1u);
            asm volatile("s_waitcnt vmcnt(0)" ::: "memory");
        } else {
            XB_SPIN(xb_ld(&bar[XB_XGEN(b.x)]) == gen, bar);
            __builtin_amdgcn_fence(__ATOMIC_ACQUIRE, "agent");
            asm volatile("s_waitcnt vmcnt(0)" ::: "memory");
        }
    }
    __syncthreads();
}

struct Args {
    const float* x; const float* mem; const float* norm_w; const float* w_in; const float* gla_wup; const float* gla_b; const float* gla_nw; const float* hgrn_lb;
    const float* hgrn_nw; const float* mem_nw; const float* w_mkv; const float* xattn_nw; const float* w_out; const float* final_nw;
    float* out; unsigned char* ws; int ph_lo, ph_hi;
};
struct Frame {
    LAS unsigned char* lds; volatile LAS unsigned* MISC; unsigned* ctl;
    int wave, vcu, G;
};

__device__ __forceinline__ void tr_item(const float* W, int Nsrc, int srccol0, const float* kscale, float rscale, bf16* WT, int ldt, int dstrow0, int k0, LAS float* scr, int lane) {
#pragma unroll 8
    for (int i = 0; i < 32; ++i) { const int kk = 2 * i + (lane >> 5); const float ks = kscale ? kscale[k0 + kk] * rscale : rscale;
        scr[kk * 33 + (lane & 31)] = W[(size_t)(k0 + kk) * Nsrc + srccol0 + (lane & 31)] * ks; }
    LDS_WAIT(); asm volatile("" ::: "memory");
    const int c = lane & 7;
#pragma unroll
    for (int j = 0; j < 4; ++j) { const int n = (lane >> 3) + 8 * j; const LAS float* s = scr + (8 * c) * 33 + n;
        u32x4 o; o.x = pk2(s[0 * 33], s[1 * 33]); o.y = pk2(s[2 * 33], s[3 * 33]); o.z = pk2(s[4 * 33], s[5 * 33]); o.w = pk2(s[6 * 33], s[7 * 33]);
        *(u32x4*)(WT + (size_t)(dstrow0 + n) * ldt + k0 + 8 * c) = o; }
    LDS_WAIT(); asm volatile("" ::: "memory");
}
__device__ __forceinline__ void prep_w1(const Frame& F, const Args& a, int layer) {
    const int lane_ = fresh_tid() & 63;
    LAS float* scr = (LAS float*)(F.lds + F.wave * 16384);
    const int gw = F.vcu * 8 + F.wave, NGW = F.G * 8;
    const float* W = a.w_in + (size_t)layer * D * DINP; const float* nw = a.norm_w + layer * D; bf16* WT = (bf16*)(a.ws + WS_W1T);
    constexpr int NBLK = (NP - 512) / 32;
    for (int it = gw; it < NBLK * 16; it += NGW) {
        const int kb = it & 15; int nb = it >> 4; if (nb >= 32) nb += 16;
        const int n0 = nb * 32; const int src = n0 < 1024 ? n0 : (n0 < 2560 ? n0 - 512 : n0 - 496);
        const float rs = (n0 < 512 || (n0 >= 4096 && n0 < 4608)) ? 0.08838834764831845f : 1.f;
        tr_item(W, DINP, src, nw, rs, WT, D, n0, kb * 64, scr, lane_);
    }
    const float* wup = a.gla_wup + (size_t)layer * 16 * 512;
    for (int it = gw; it < 512 * 2; it += NGW) {
        const int c = it >> 1, ko = ((it & 1) * 64 + lane_) * 8;
        float up[16];
#pragma unroll
        for (int r = 0; r < 16; ++r) up[r] = wup[r * 512 + c];
        float o[8];
#pragma unroll
        for (int kk = 0; kk < 8; ++kk) { const float* wr_ = W + (size_t)(ko + kk) * DINP + 2048; float s = 0.f;
#pragma unroll
            for (int r4 = 0; r4 < 4; ++r4) { const f32x4 w4 = *(const f32x4*)(wr_ + 4 * r4); s += w4.x * up[4 * r4] + w4.y * up[4 * r4 + 1] + w4.z * up[4 * r4 + 2] + w4.w * up[4 * r4 + 3]; }
            o[kk] = s * nw[ko + kk]; }
        u32x4 w; w.x = pk2(o[0], o[1]); w.y = pk2(o[2], o[3]); w.z = pk2(o[4], o[5]); w.w = pk2(o[6], o[7]);
        *(u32x4*)(WT + (size_t)(1024 + c) * D + ko) = w;
    }
}
__device__ __forceinline__ void prep_w2(const Frame& F, const Args& a, int layer) {
    const int lane_ = fresh_tid() & 63;
    LAS float* scr = (LAS float*)(F.lds + F.wave * 16384);
    const int gw = F.vcu * 8 + F.wave, NGW = F.G * 8;
    const float* W = a.w_out + (size_t)layer * DMIX * D; bf16* WT = (bf16*)(a.ws + WS_W2T);
    for (int it = gw; it < 32 * 32; it += NGW) { const int kb = it & 31, nb = it >> 5; tr_item(W, D, nb * 32, nullptr, 1.f, WT, DMIX, nb * 32, kb * 64, scr, lane_); }
}
__device__ __forceinline__ void prep_wkv(const Frame& F, const Args& a) {
    const int lane_ = fresh_tid() & 63;
    LAS float* scr = (LAS float*)(F.lds + F.wave * 16384);
    const int gw = F.vcu * 8 + F.wave, NGW = F.G * 8;
    bf16* WT = (bf16*)((unsigned char*)a.out + DO_WKVT);
    for (int it = gw; it < 2 * 32 * 16; it += NGW) { const int layer = it >> 9, r = it & 511, kb = r & 15, nb = r >> 4;
        tr_item(a.w_mkv + (size_t)layer * D * 1024, 1024, nb * 32, a.mem_nw + layer * D, 1.f, WT, D, layer * 1024 + nb * 32, kb * 64, scr, lane_); }
}
__device__ __forceinline__ float row_to_bf16(const float* xrow, bf16* orow, int lane) {
    const f32x4* xr = (const f32x4*)xrow + lane; f32x4 v[4]; float s = 0.f;
#pragma unroll
    for (int j = 0; j < 4; ++j) { v[j] = xr[64 * j]; s += (v[j].x * v[j].x + v[j].y * v[j].y) + (v[j].z * v[j].z + v[j].w * v[j].w); }
    u32x2* o8 = (u32x2*)orow + lane;
#pragma unroll
    for (int j = 0; j < 4; ++j) { u32x2 w; w.x = pk2(v[j].x, v[j].y); w.y = pk2(v[j].z, v[j].w); o8[64 * j] = w; }
    return wave_sum(s);
}
__device__ __forceinline__ void prep_x(const Frame& F, const Args& a) {
    const int lane_ = fresh_tid() & 63;
    const int gw = F.vcu * 8 + F.wave, NGW = F.G * 8;
    bf16* xb = (bf16*)(a.ws + WS_XB); float* ssq0 = (float*)((unsigned char*)a.out + DO_SSQ0);
    for (int m = gw; m < T; m += NGW) { const float s = row_to_bf16(a.x + (size_t)m * D, xb + (size_t)m * D, lane_);
        if (lane_ < 16) ssq0[(size_t)m * 16 + lane_] = lane_ == 0 ? s : 0.f; }
    bf16* memb = (bf16*)((unsigned char*)a.out + DO_MEMB); float* rstdm = (float*)((unsigned char*)a.out + DO_RSTDM);
    for (int m = gw; m < MROWS; m += NGW) { const float s = row_to_bf16(a.mem + (size_t)m * D, memb + (size_t)m * D, lane_);
        if (lane_ == 0) rstdm[m] = 1.0f / sqrtf(s * (1.f / D) + NORM_EPS); }
}

struct EpiProj {
    static constexpr bool PERM = true;
    bf16* P; const float* ssq; const float* gbias; const float* hlb;
    int layer;
    template <int KIND>
    __device__ __forceinline__ void store_tile(const f32x4 (&acc)[2][2][4][2], bf16* rowp0, const float (&rstd)[2][4], int cbase) const {
#pragma unroll
        for (int bj = 0; bj < 2; ++bj) {
            float ca[8], cb[8];
#pragma unroll
            for (int e = 0; e < 8; ++e) { ca[e] = 0.f; cb[e] = 0.f; }
            if (KIND == 1) {
#pragma unroll
                for (int e = 0; e < 8; ++e) ca[e] = gbias[cbase + bj * 128 + e];
            }
            if (KIND == 2) {
#pragma unroll
                for (int e = 0; e < 8; ++e) { const int c = cbase + bj * 128 + e; float lb = 0.f;
                    if (layer == 1) { const float h0 = hlb[c], h1 = hlb[512 + c]; lb = 1.f / (1.f + fexp(h0 - h1)); }
                    ca[e] = logf(fmaxf(lb, 1e-30f)); cb[e] = log1pf(-lb); }
            }
#pragma unroll
            for (int ai = 0; ai < 2; ++ai)
#pragma unroll
                for (int m = 0; m < 4; ++m) { const float rs = rstd[ai][m]; float v[8];
#pragma unroll
                    for (int e = 0; e < 4; ++e) { v[e] = acc[ai][bj][m][0][e] * rs; v[4 + e] = acc[ai][bj][m][1][e] * rs; }
                    u32x4 w;
                    if (KIND == 0) { w.x = pk2(v[0], v[1]); w.y = pk2(v[2], v[3]); w.z = pk2(v[4], v[5]); w.w = pk2(v[6], v[7]); }
                    else if (KIND == 3) {
#pragma unroll
                        for (int e = 0; e < 8; ++e) v[e] = v[e] * __builtin_amdgcn_rcpf(1.f + fexp(-v[e]));
                        w.x = pk2(v[0], v[1]); w.y = pk2(v[2], v[3]); w.z = pk2(v[4], v[5]); w.w = pk2(v[6], v[7]); }
                    else if (KIND == 1) {
#pragma unroll
                        for (int e = 0; e < 8; ++e) v[e] = log_sigmoid(v[e] + ca[e]) * 0.0625f;
                        w.x = pkh2(v[0], v[1]); w.y = pkh2(v[2], v[3]); w.z = pkh2(v[4], v[5]); w.w = pkh2(v[6], v[7]); }
                    else {
#pragma unroll
                        for (int e = 0; e < 8; ++e) { const float aa = ca[e], bb = cb[e] + log_sigmoid(v[e]); const float mx = fmaxf(aa, bb); v[e] = mx + flog(1.f + fexp(-fabsf(aa - bb))); }
                        w.x = pkh2(v[0], v[1]); w.y = pkh2(v[2], v[3]); w.z = pkh2(v[4], v[5]); w.w = pkh2(v[6], v[7]); }
                    *(u32x4*)(rowp0 + (size_t)(ai * 128 + m * 16) * LDP + bj * 128) = w; }
        }
    }
    __device__ __forceinline__ void operator()(const f32x4 (&acc)[2][2][4][2], const pg8::Unit& u, int wr, int wc, int fr, int fq) const {
        const int pn = u.pn; int kind, dcol, cb0 = 0;
        if (pn < 2) { kind = 0; dcol = C_GQ + 256 * pn; } else if (pn < 4) { kind = 0; dcol = C_GK + 256 * (pn - 2); } else if (pn < 6) { kind = 1; dcol = C_GG + 256 * (pn - 4); cb0 = 256 * (pn - 4); }
        else if (pn < 10) { kind = 0; dcol = C_GV + 256 * (pn - 6); } else if (pn < 12) { kind = 0; dcol = C_HQ + 256 * (pn - 10); } else if (pn < 14) { kind = 2; dcol = C_HLF + 256 * (pn - 12); cb0 = 256 * (pn - 12); }
        else if (pn < 16) { kind = 0; dcol = C_HI + 256 * (pn - 14); } else if (pn < 18) { kind = 0; dcol = C_XQ + 256 * (pn - 16); } else { kind = 3; dcol = C_SG + 256 * (pn - 18); }
        const int row0 = u.pm * 256 + wr * 64 + fr;
        float rstd[2][4];
#pragma unroll
        for (int ai = 0; ai < 2; ++ai)
#pragma unroll
            for (int m = 0; m < 4; ++m) { const f32x4 s4 = *(const f32x4*)(ssq + (size_t)(row0 + ai * 128 + m * 16) * 16 + 4 * fq);
                float s = (s4.x + s4.y) + (s4.z + s4.w); s += __shfl_xor(s, 16); s += __shfl_xor(s, 32);
                rstd[ai][m] = 1.0f / sqrtf(s * (1.f / D) + NORM_EPS); }
        const int cw = wc * 32 + 8 * fq;
        bf16* rowp0 = P + (size_t)row0 * LDP + dcol + cw;
        if (kind == 0) store_tile<0>(acc, rowp0, rstd, 0);
        else if (kind == 3) store_tile<3>(acc, rowp0, rstd, 0);
        else if (kind == 1) store_tile<1>(acc, rowp0, rstd, cb0 + cw);
        else store_tile<2>(acc, rowp0, rstd, cb0 + cw);
    }
};
struct EpiMem {
    static constexpr bool PERM = true;
    bf16* O; const float* rstdm;
    __device__ __forceinline__ void operator()(const f32x4 (&acc)[2][2][4][2], const pg8::Unit& u, int wr, int wc, int fr, int fq) const {
        const int row0 = u.pm * 256 + wr * 64 + fr, col0 = u.pn * 256 + wc * 32 + 8 * fq;
#pragma unroll
        for (int ai = 0; ai < 2; ++ai)
#pragma unroll
            for (int m = 0; m < 4; ++m) { const int row = row0 + ai * 128 + m * 16; const float rs = rstdm[row]; bf16* rowp = O + (size_t)row * 2048 + col0;
#pragma unroll
                for (int bj = 0; bj < 2; ++bj) { const f32x4 v0 = acc[ai][bj][m][0] * rs, v1 = acc[ai][bj][m][1] * rs; u32x4 w;
                    w.x = pk2(v0[0], v0[1]); w.y = pk2(v0[2], v0[3]); w.z = pk2(v1[0], v1[1]); w.w = pk2(v1[2], v1[3]); *(u32x4*)(rowp + bj * 128) = w; } }
    }
};
struct EpiRes {
    static constexpr bool PERM = false;
    const float* resid; float* out; bf16* xb; float* ssq;
    __device__ __forceinline__ void operator()(const f32x4 (&acc)[2][2][4][2], const pg8::Unit& u, int wr, int wc, int fr, int fq) const {
        const int row0 = u.pm * 256 + wr * 64 + fr, col0 = u.pn * 256 + wc * 32 + 4 * fq;
#pragma unroll
        for (int ai = 0; ai < 2; ++ai)
#pragma unroll
            for (int m = 0; m < 4; ++m) { const int row = row0 + ai * 128 + m * 16; const size_t off = (size_t)row * D + col0; float ss = 0.f;
#pragma unroll
                for (int bj = 0; bj < 2; ++bj)
#pragma unroll
                    for (int n = 0; n < 2; ++n) { const f32x4 r4 = *(const f32x4*)(resid + off + bj * 128 + n * 16); const f32x4 o = r4 + acc[ai][bj][m][n];
                        *(f32x4*)(out + off + bj * 128 + n * 16) = o; u32x2 w; w.x = pk2(o[0], o[1]); w.y = pk2(o[2], o[3]); *(u32x2*)(xb + off + bj * 128 + n * 16) = w;
                        ss += (o[0] * o[0] + o[1] * o[1]) + (o[2] * o[2] + o[3] * o[3]); }
                ss += __shfl_xor(ss, 16); ss += __shfl_xor(ss, 32);
                if (fq == 0) ssq[(size_t)row * 16 + u.pn * 4 + wc] = ss; }
    }
};

namespace mx {
constexpr int RSB = 272;
constexpr int TILE_BYTES = 64 * RSB;
constexpr int OFF_Q = 0, OFF_K = TILE_BYTES, OFF_K2 = 2 * TILE_BYTES, OFF_V = 3 * TILE_BYTES, OFF_DC = 4 * TILE_BYTES, OFF_END = OFF_DC + 2048;
constexpr int HALF_BYTES = OFF_END;
constexpr int OFF_SSX = 2 * HALF_BYTES;
constexpr int OS_STRIDE = 132;
static_assert(64 * OS_STRIDE * 4 <= 2 * TILE_BYTES && OFF_SSX + 512 <= MISC_OFF, "mixer LDS map");

struct Half {
    int kind;
    int t0;
    int qcol, kcol, gcol, vcol, ocol;
    const float* nw;
    int hu;
    int seg;
};
__device__ __forceinline__ Half make_half(int u, int half, int layer, const Args& a) {
    Half h;
    if (u < 256) { const int b = u >> 5, hd = (u >> 3) & 3, seg = u & 7; h.kind = 0; h.seg = seg; h.t0 = b * SEQ + seg * SEGLEN;
        h.qcol = C_GQ + hd * 128; h.kcol = C_GK + hd * 128; h.gcol = C_GG + hd * 128; h.vcol = C_GV + hd * 256 + half * 128; h.ocol = C_SG + hd * 256 + half * 128; h.nw = a.gla_nw + layer * 256 + half * 128; }
    else { const int v = u - 256, b = v >> 4, hp = (v >> 3) & 1, seg = v & 7, hd = 2 * hp + half; h.kind = 1; h.seg = seg; h.t0 = b * SEQ + seg * SEGLEN;
        h.qcol = C_HQ + hd * 128; h.kcol = 0; h.gcol = C_HLF + hd * 128; h.vcol = C_HI + hd * 128; h.ocol = C_SG + 1024 + hd * 128; h.nw = a.hgrn_nw + layer * 128; }
    h.hu = u * 2 + half;
    return h;
}

template <int PASS>
__device__ __forceinline__ void mix_unit(const Frame& F, const Args& a, int u, int layer) {
    const int tid = fresh_tid();
    const int lane = tid & 63, half = F.wave >> 2, hw = F.wave & 3, tih = tid & 255;
    const int li = lane & 15, g4 = lane >> 4, q_ = li >> 2, p_ = li & 3;
    const Half H = make_half(u, half, layer, a);
    LAS unsigned char* L = F.lds + half * HALF_BYTES;
    const bf16* P = (const bf16*)(a.ws + WS_P);
    float* SEND = (float*)(a.ws + WS_SEND); float* DTOT = (float*)(a.ws + WS_DTOT);
    f32x4 S[8][2];
#pragma unroll
    for (int dt = 0; dt < 8; ++dt) { S[dt][0] = (f32x4){0.f, 0.f, 0.f, 0.f}; S[dt][1] = (f32x4){0.f, 0.f, 0.f, 0.f}; }
    if (PASS == 1) {
        for (int s = 0; s < H.seg; ++s) { const int hu2 = H.hu - 2 * (H.seg - s); const float* sp = SEND + (size_t)hu2 * 16384 + (size_t)(hw * 16) * 256 + lane * 4; const float* dp = DTOT + (size_t)hu2 * 128 + 4 * g4;
#pragma unroll
            for (int dt = 0; dt < 8; ++dt) { const f32x4 dv = *(const f32x4*)(dp + 16 * dt);
#pragma unroll
                for (int vt = 0; vt < 2; ++vt) { const f32x4 sv = *(const f32x4*)(sp + (dt * 2 + vt) * 256); S[dt][vt] = S[dt][vt] * dv + sv; } } }
    }
    float lt0 = 0.f, lt1 = 0.f;
    for (int mc = 0; mc < NMC; ++mc) {
        const int tb = H.t0 + mc * 64;
        {
            const bf16* rowp = P + (size_t)(tb + 16 * hw) * LDP + 2 * lane;
            unsigned gw_[16], kw_[16], qw_[16];
#pragma unroll
            for (int j = 0; j < 16; ++j) { gw_[j] = *(const unsigned*)(rowp + (size_t)j * LDP + H.gcol);
                if (H.kind == 0) kw_[j] = *(const unsigned*)(rowp + (size_t)j * LDP + H.kcol); else kw_[j] = 0u;
                if (PASS == 1) qw_[j] = *(const unsigned*)(rowp + (size_t)j * LDP + H.qcol); else qw_[j] = 0u; }
            u32x4 vv[4];
#pragma unroll
            for (int i = 0; i < 4; ++i) { const int p = tih + 256 * i, r = p >> 4, c8 = p & 15; vv[i] = *(const u32x4*)(P + (size_t)(tb + r) * LDP + H.vcol + 8 * c8); }
#pragma unroll
            for (int i = 0; i < 4; ++i) { const int p = tih + 256 * i, r = p >> 4, c8 = p & 15; *(LAS u32x4*)(L + OFF_V + r * RSB + c8 * 16) = vv[i]; }
            float g0[16], g1[16], k0[16], k1[16];
#pragma unroll
            for (int j = 0; j < 16; ++j) { const f16x2 gh = __builtin_bit_cast(f16x2, gw_[j]); g0[j] = (float)gh.x; g1[j] = (float)gh.y;
                if (H.kind == 0) { k0[j] = bflo(kw_[j]); k1[j] = bfhi(kw_[j]); } else { k0[j] = 1.f - fexp(g0[j]); k1[j] = 1.f - fexp(g1[j]); } }
            if (PASS == 1) {
                float r0 = 0.f, r1 = 0.f;
#pragma unroll
                for (int j = 0; j < 16; ++j) { r0 += g0[j]; r1 += g1[j];
                    const float q0 = bflo(qw_[j]) * fexp(r0), q1 = bfhi(qw_[j]) * fexp(r1);
                    const float kh0 = k0[j] * fexp(fminf(-r0, 80.f)), kh1 = k1[j] * fexp(fminf(-r1, 80.f));
                    *(LAS unsigned*)(L + OFF_Q + (16 * hw + j) * RSB + lane * 4) = pk2(q0, q1);
                    *(LAS unsigned*)(L + OFF_K + (16 * hw + j) * RSB + lane * 4) = pk2(kh0, kh1); }
            }
            float s0 = 0.f, s1 = 0.f;
#pragma unroll
            for (int j = 15; j >= 0; --j) { *(LAS unsigned*)(L + OFF_K2 + (16 * hw + j) * RSB + lane * 4) = pk2(k0[j] * fexp(s0), k1[j] * fexp(s1)); s0 += g0[j]; s1 += g1[j]; }
            f32x2 dd; dd.x = fexp(s0); dd.y = fexp(s1);
            *(LAS f32x2*)(L + OFF_DC + hw * 512 + lane * 8) = dd;
            lt0 += s0; lt1 += s1;
        }
        LDS_WAIT(); __syncthreads();
        f32x4 oc[4][2];
#pragma unroll
        for (int c = 0; c < 4; ++c) {
            const int rb = 16 * c;
            bf16x8 vb[2];
#pragma unroll
            for (int vt = 0; vt < 2; ++vt) { const s16x4 t4 = tr16(L + OFF_V + (rb + 4 * g4 + q_) * RSB + (32 * hw + 16 * vt + 4 * p_) * 2); vb[vt] = (bf16x8){t4[0], t4[1], t4[2], t4[3], 0, 0, 0, 0}; }
            if (PASS == 1) {
                f32x4 at = (f32x4){0.f, 0.f, 0.f, 0.f};
#pragma unroll
                for (int ks = 0; ks < 4; ++ks) { const bf16x8 ka = *(const LAS bf16x8*)(L + OFF_K + (rb + li) * RSB + (32 * ks + 8 * g4) * 2); const bf16x8 qb = *(const LAS bf16x8*)(L + OFF_Q + (rb + li) * RSB + (32 * ks + 8 * g4) * 2);
                    at = __builtin_amdgcn_mfma_f32_16x16x32_bf16(ka, qb, at, 0, 0, 0); }
#pragma unroll
                for (int r = 0; r < 4; ++r) at[r] = (4 * g4 + r <= li) ? at[r] : 0.f;
                const unsigned pa0 = pk2(at[0], at[1]), pa1 = pk2(at[2], at[3]);
                const bf16x8 pa = __builtin_bit_cast(bf16x8, (u32x4){pa0, pa1, 0u, 0u});
                f32x4 o0 = __builtin_amdgcn_mfma_f32_16x16x32_bf16(pa, vb[0], (f32x4){0.f, 0.f, 0.f, 0.f}, 0, 0, 0);
                f32x4 o1 = __builtin_amdgcn_mfma_f32_16x16x32_bf16(pa, vb[1], (f32x4){0.f, 0.f, 0.f, 0.f}, 0, 0, 0);
#pragma unroll
                for (int ks = 0; ks < 4; ++ks) {
                    const u32x2 qa0 = *(const LAS u32x2*)(L + OFF_Q + (rb + li) * RSB + (32 * ks + 4 * g4) * 2), qa1 = *(const LAS u32x2*)(L + OFF_Q + (rb + li) * RSB + (32 * ks + 16 + 4 * g4) * 2);
                    const bf16x8 qa = __builtin_bit_cast(bf16x8, (u32x4){qa0.x, qa0.y, qa1.x, qa1.y});
                    const bf16x8 sb0 = __builtin_bit_cast(bf16x8, (u32x4){pk2(S[2 * ks][0][0], S[2 * ks][0][1]), pk2(S[2 * ks][0][2], S[2 * ks][0][3]), pk2(S[2 * ks + 1][0][0], S[2 * ks + 1][0][1]), pk2(S[2 * ks + 1][0][2], S[2 * ks + 1][0][3])});
                    const bf16x8 sb1 = __builtin_bit_cast(bf16x8, (u32x4){pk2(S[2 * ks][1][0], S[2 * ks][1][1]), pk2(S[2 * ks][1][2], S[2 * ks][1][3]), pk2(S[2 * ks + 1][1][0], S[2 * ks + 1][1][1]), pk2(S[2 * ks + 1][1][2], S[2 * ks + 1][1][3])});
                    o0 = __builtin_amdgcn_mfma_f32_16x16x32_bf16(qa, sb0, o0, 0, 0, 0);
                    o1 = __builtin_amdgcn_mfma_f32_16x16x32_bf16(qa, sb1, o1, 0, 0, 0); }
                oc[c][0] = o0; oc[c][1] = o1;
            }
#pragma unroll
            for (int dt = 0; dt < 8; ++dt) { const s16x4 t4 = tr16(L + OFF_K2 + (rb + 4 * g4 + q_) * RSB + (16 * dt + 4 * p_) * 2); const bf16x8 ka = (bf16x8){t4[0], t4[1], t4[2], t4[3], 0, 0, 0, 0};
                const f32x4 dv = *(const LAS f32x4*)(L + OFF_DC + c * 512 + (16 * dt + 4 * g4) * 4);
                S[dt][0] = __builtin_amdgcn_mfma_f32_16x16x32_bf16(ka, vb[0], S[dt][0] * dv, 0, 0, 0);
                S[dt][1] = __builtin_amdgcn_mfma_f32_16x16x32_bf16(ka, vb[1], S[dt][1] * dv, 0, 0, 0); }
        }
        LDS_WAIT(); __syncthreads();
        if (PASS == 1) {
            LAS float* Os = (LAS float*)(L + OFF_Q);
#pragma unroll
            for (int c = 0; c < 4; ++c)
#pragma unroll
                for (int vt = 0; vt < 2; ++vt)
#pragma unroll
                    for (int r = 0; r < 4; ++r) Os[(16 * c + 4 * g4 + r) * OS_STRIDE + 32 * hw + 16 * vt + li] = oc[c][vt][r];
            const int i = tih >> 2, vq = tih & 3;
            bf16* orow = (bf16*)P + (size_t)(tb + i) * LDP + H.ocol + 32 * vq;
            u32x4 gt[4];
#pragma unroll
            for (int k = 0; k < 4; ++k) gt[k] = *(const u32x4*)(orow + 8 * k);
            LDS_WAIT(); __syncthreads();
            f32x4 ov[8]; float ss = 0.f;
#pragma unroll
            for (int k = 0; k < 8; ++k) { ov[k] = *(const LAS f32x4*)(Os + i * OS_STRIDE + 32 * vq + 4 * k); ss += (ov[k].x * ov[k].x + ov[k].y * ov[k].y) + (ov[k].z * ov[k].z + ov[k].w * ov[k].w); }
            ss += __shfl_xor(ss, 1); ss += __shfl_xor(ss, 2);
            float tot = ss, nd = 128.f;
            if (H.kind == 0) {
                LAS float* SX = (LAS float*)(F.lds + OFF_SSX);
                if (vq == 0) SX[half * 64 + i] = ss;
                LDS_WAIT(); __syncthreads();
                tot = SX[i] + SX[64 + i]; nd = 256.f;
            }
            const float rstd = 1.0f / sqrtf(tot / nd + NORM_EPS);
#pragma unroll
            for (int k = 0; k < 4; ++k) { const f32x4 w0 = *(const f32x4*)(H.nw + 32 * vq + 8 * k), w1 = *(const f32x4*)(H.nw + 32 * vq + 8 * k + 4); const f32x4 a0 = ov[2 * k], a1 = ov[2 * k + 1]; const u32x4 gg = gt[k];
                u32x4 w; w.x = pk2(a0.x * rstd * w0.x * bflo(gg.x), a0.y * rstd * w0.y * bfhi(gg.x)); w.y = pk2(a0.z * rstd * w0.z * bflo(gg.y), a0.w * rstd * w0.w * bfhi(gg.y));
                w.z = pk2(a1.x * rstd * w1.x * bflo(gg.z), a1.y * rstd * w1.y * bfhi(gg.z)); w.w = pk2(a1.z * rstd * w1.z * bflo(gg.w), a1.w * rstd * w1.w * bfhi(gg.w));
                *(u32x4*)(orow + 8 * k) = w; }
            LDS_WAIT(); __syncthreads();
        }
    }
    if (PASS == 0) {
        float* sp = SEND + (size_t)H.hu * 16384 + (size_t)(hw * 16) * 256 + lane * 4;
#pragma unroll
        for (int dt = 0; dt < 8; ++dt)
#pragma unroll
            for (int vt = 0; vt < 2; ++vt) *(f32x4*)(sp + (dt * 2 + vt) * 256) = S[dt][vt];
        LAS float* LT = (LAS float*)(L + OFF_DC);
        f32x2 lt; lt.x = lt0; lt.y = lt1; *(LAS f32x2*)(L + OFF_DC + hw * 512 + lane * 8) = lt;
        LDS_WAIT(); __syncthreads();
        if (tih < 128) DTOT[(size_t)H.hu * 128 + tih] = fexp(LT[tih] + LT[128 + tih] + LT[256 + tih] + LT[384 + tih]);
        LDS_WAIT(); __syncthreads();
    }
}
}

namespace xa {
constexpr int RSB = 272;
constexpr int OFF_KX = 0, OFF_VX = 256 * RSB;
static_assert(2 * 256 * RSB <= MISC_OFF, "xattn LDS map");
__device__ __forceinline__ void xa_unit(const Frame& F, const Args& a, int x, int layer) {
    const int tid = fresh_tid();
    const int lane = tid & 63, wid = F.wave, li = lane & 15, g4 = lane >> 4, q_ = li >> 2, p_ = li & 3;
    const int b = x >> 5, h = (x >> 3) & 3, tr = x & 7, t0 = b * SEQ + tr * 512 + wid * 64;
    LAS unsigned char* L = F.lds;
    bf16* P = (bf16*)(a.ws + WS_P); const bf16* MKV = (const bf16*)(a.ws + WS_MKV);
    const float* nw = a.xattn_nw + layer * 128;
#pragma unroll
    for (int i = 0; i < 8; ++i) { const int p = tid + 512 * i, r = p >> 4, c8 = p & 15; const bf16* src = MKV + (size_t)(b * MEML + r) * 2048 + layer * 1024 + h * 128 + 8 * c8;
        const u32x4 kk = *(const u32x4*)src, vv = *(const u32x4*)(src + 512);
        *(LAS u32x4*)(L + OFF_KX + r * RSB + c8 * 16) = kk; *(LAS u32x4*)(L + OFF_VX + r * RSB + c8 * 16) = vv; }
    LDS_WAIT(); __syncthreads();
    for (int it = 0; it < 4; ++it) {
        const int tb = t0 + 16 * it;
        unsigned kxo = OFF_KX, vxo = OFF_VX; asm volatile("" : "+v"(kxo), "+v"(vxo));
        bf16x8 qb[4];
#pragma unroll
        for (int ks = 0; ks < 4; ++ks) qb[ks] = *(const bf16x8*)(P + (size_t)(tb + li) * LDP + C_XQ + h * 128 + 32 * ks + 8 * g4);
        f32x4 s[16];
#pragma unroll
        for (int mt = 0; mt < 16; ++mt) { s[mt] = (f32x4){0.f, 0.f, 0.f, 0.f};
#pragma unroll
            for (int ks = 0; ks < 4; ++ks) { const bf16x8 ka = *(const LAS bf16x8*)(L + kxo + (16 * mt + li) * RSB + (32 * ks + 8 * g4) * 2); s[mt] = __builtin_amdgcn_mfma_f32_16x16x32_bf16(ka, qb[ks], s[mt], 0, 0, 0); } }
        float mxv = s[0][0];
#pragma unroll
        for (int mt = 0; mt < 16; ++mt)
#pragma unroll
            for (int r = 0; r < 4; ++r) mxv = fmaxf(mxv, s[mt][r]);
        mxv = fmaxf(mxv, __shfl_xor(mxv, 16)); mxv = fmaxf(mxv, __shfl_xor(mxv, 32));
        float lsum = 0.f;
#pragma unroll
        for (int mt = 0; mt < 16; ++mt)
#pragma unroll
            for (int r = 0; r < 4; ++r) { s[mt][r] = fexp(s[mt][r] - mxv); lsum += s[mt][r]; }
        lsum += __shfl_xor(lsum, 16); lsum += __shfl_xor(lsum, 32);
        f32x4 o[8];
#pragma unroll
        for (int vt = 0; vt < 8; ++vt) o[vt] = (f32x4){0.f, 0.f, 0.f, 0.f};
#pragma unroll
        for (int k2 = 0; k2 < 8; ++k2) {
            const bf16x8 pa = __builtin_bit_cast(bf16x8, (u32x4){pk2(s[2 * k2][0], s[2 * k2][1]), pk2(s[2 * k2][2], s[2 * k2][3]), pk2(s[2 * k2 + 1][0], s[2 * k2 + 1][1]), pk2(s[2 * k2 + 1][2], s[2 * k2 + 1][3])});
#pragma unroll
            for (int vt = 0; vt < 8; ++vt) { const s16x4 t0_ = tr16(L + vxo + (32 * k2 + 4 * g4 + q_) * RSB + (16 * vt + 4 * p_) * 2), t1_ = tr16(L + vxo + (32 * k2 + 16 + 4 * g4 + q_) * RSB + (16 * vt + 4 * p_) * 2);
                const bf16x8 vb = (bf16x8){t0_[0], t0_[1], t0_[2], t0_[3], t1_[0], t1_[1], t1_[2], t1_[3]};
                o[vt] = __builtin_amdgcn_mfma_f32_16x16x32_bf16(pa, vb, o[vt], 0, 0, 0); } }
        float ssq[4];
#pragma unroll
        for (int r = 0; r < 4; ++r) { const float linv = 1.0f / __shfl(lsum, 4 * g4 + r); float ss = 0.f;
#pragma unroll
            for (int vt = 0; vt < 8; ++vt) { o[vt][r] *= linv; ss += o[vt][r] * o[vt][r]; }
            ss += __shfl_xor(ss, 1); ss += __shfl_xor(ss, 2); ss += __shfl_xor(ss, 4); ss += __shfl_xor(ss, 8); ssq[r] = ss; }
#pragma unroll
        for (int r = 0; r < 4; ++r) { const float rstd = 1.0f / sqrtf(ssq[r] * (1.f / 128.f) + NORM_EPS); bf16* orow = P + (size_t)(tb + 4 * g4 + r) * LDP + C_SG + 1536 + h * 128 + li;
#pragma unroll
            for (int vt = 0; vt < 8; ++vt) { const float gate = __builtin_bit_cast(float, (unsigned)orow[16 * vt] << 16); orow[16 * vt] = (bf16)f2bf(o[vt][r] * rstd * nw[16 * vt + li] * gate); } }
    }
    LDS_WAIT(); __syncthreads();
}
}

__device__ __forceinline__ int next_item(const Frame& F, unsigned* head) {
    if (threadIdx.x == 0) F.MISC[4] = __hip_atomic_fetch_add(head, 1u, RLX_AGENT);
    __syncthreads();
    const int it = (int)F.MISC[4];
    __syncthreads();
    return it;
}

constexpr int N_PHASES = 10;
__global__ void __launch_bounds__(512, 2) mega(Args args) {
    extern __shared__ __attribute__((aligned(16))) unsigned char lds_raw[];
    Frame F;
    F.lds = (LAS unsigned char*)lds_raw; F.MISC = (volatile LAS unsigned*)(F.lds + MISC_OFF);
    F.wave = __builtin_amdgcn_readfirstlane(threadIdx.x >> 6);
    F.G = gridDim.x; { const int bx = blockIdx.x; F.vcu = (F.G % 8 == 0) ? (bx % 8) * (F.G / 8) + bx / 8 : bx; }
    F.ctl = (unsigned*)(args.ws + WS_CTL);
    if (threadIdx.x < 16) F.MISC[threadIdx.x] = 0u;
    __syncthreads();
    XcdBarrier bar; bar.bar = F.ctl + CW_BAR; bar.x = 0; bar.st = nullptr;
    if (!MK_PER_PHASE) bar = xcd_barrier_post(F.ctl + CW_BAR, F.MISC + 8);
    const int lo = args.ph_lo, hi = args.ph_hi;
#define IN(k) (lo <= (k) && (k) < hi)
#define SEAM(k) do { if (IN(k) && IN((k) + 1)) xcd_barrier(bar); } while (0)
    bf16* P = (bf16*)(args.ws + WS_P);
    bf16* XB = (bf16*)(args.ws + WS_XB);

    if (IN(0)) { prep_w1(F, args, 0); prep_w2(F, args, 0); prep_wkv(F, args); prep_x(F, args); }
    SEAM(0);
    for (int layer = 0; layer < DEPTH; ++layer) {
        const int pb = 1 + 4 * layer;
        if (IN(pb)) {
            if (layer == 0) {
                pg8::Gemm g{(const bf16*)((unsigned char*)args.out + DO_MEMB), (const bf16*)((unsigned char*)args.out + DO_WKVT), MROWS, 2048, D, D, D};
                pg8::StaticOrder S; S.init(MROWS, 2048, F.G, (int)blockIdx.x);
                EpiMem E{(bf16*)(args.ws + WS_MKV), (const float*)((unsigned char*)args.out + DO_RSTDM)};
                pg8::gemm_phase<EpiMem, pg8::StaticOrder, true, true>(F.lds, g, S, E);
            }
            pg8::Gemm g{XB, (const bf16*)(args.ws + WS_W1T), T, NP, D, D, D};
            pg8::StaticOrder S; S.init(T, NP, F.G, (int)blockIdx.x);
            EpiProj E{P, layer == 0 ? (const float*)((unsigned char*)args.out + DO_SSQ0) : (const float*)(args.ws + WS_SSQ1), args.gla_b + layer * 512, args.hgrn_lb, layer};
            pg8::gemm_phase<EpiProj, pg8::StaticOrder, true, true>(F.lds, g, S, E);
        }
        SEAM(pb);
        if (IN(pb + 1)) {
            if (layer == 0) prep_w1(F, args, 1); else prep_w2(F, args, 1);
            __syncthreads();
            unsigned* head = F.ctl + CW_QUEUE + 64 * (2 * layer);
            for (;;) { const int it = next_item(F, head); if (it >= N_MIX_UNITS + N_XA_UNITS) break;
                if (it < N_MIX_UNITS) mx::mix_unit<0>(F, args, it, layer); else xa::xa_unit(F, args, it - N_MIX_UNITS, layer); }
        }
        SEAM(pb + 1);
        if (IN(pb + 2)) {
            unsigned* head = F.ctl + CW_QUEUE + 64 * (2 * layer + 1);
            for (;;) { const int it = next_item(F, head); if (it >= N_MIX_UNITS) break; mx::mix_unit<1>(F, args, it, layer); }
        }
        SEAM(pb + 2);
        if (IN(pb + 3)) {
            pg8::Gemm g{P + C_SG, (const bf16*)(args.ws + WS_W2T), T, D, DMIX, LDP, DMIX};
            pg8::StaticOrder S; S.init(T, D, F.G, (int)blockIdx.x);
            EpiRes E{layer == 0 ? args.x : (const float*)args.out, args.out, XB, (float*)(args.ws + (layer == 0 ? WS_SSQ1 : WS_SSQ2))};
            pg8::gemm_phase<EpiRes, pg8::StaticOrder, true, true>(F.lds, g, S, E);
        }
        SEAM(pb + 3);
    }
    if (IN(9)) {
        const int lane_ = fresh_tid() & 63;
        const int gw = F.vcu * 8 + F.wave, NGW = F.G * 8; const float* ssq = (const float*)(args.ws + WS_SSQ2);
        f32x4 fw[4];
#pragma unroll
        for (int j = 0; j < 4; ++j) fw[j] = *((const f32x4*)args.final_nw + lane_ + 64 * j);
        for (int m = gw; m < T; m += NGW) { float s = lane_ < 16 ? ssq[(size_t)m * 16 + lane_] : 0.f; s = wave_sum(s); const float rstd = 1.0f / sqrtf(s * (1.f / D) + NORM_EPS);
            f32x4* xr = (f32x4*)(args.out + (size_t)m * D) + lane_;
#pragma unroll
            for (int j = 0; j < 4; ++j) { const f32x4 v = xr[64 * j]; xr[64 * j] = v * rstd * fw[j]; } }
    }
#undef IN
#undef SEAM
}

extern "C" void kernel_launch(void* const* d_in, const int* in_sizes, int n_in, void* d_out, int out_size, void* d_ws, size_t ws_size, hipStream_t stream) {
    static int grid = 0;
    if (grid == 0) {
        if (n_in != 14 || in_sizes[0] != T * D || out_size != T * D || ws_size < WS_END) { fprintf(stderr, "kernel_launch: unexpected shapes (n_in %d, in0 %d, out %d, ws %zu)\n", n_in, n_in > 0 ? in_sizes[0] : -1, out_size, ws_size); grid = -1; return; }
        int dev = 0, cus = 0, per_cu = 0;
        if (hipGetDevice(&dev) != hipSuccess || hipDeviceGetAttribute(&cus, hipDeviceAttributeMultiprocessorCount, dev) != hipSuccess) { grid = -1; return; }
        if (hipFuncSetAttribute((const void*)mega, hipFuncAttributeMaxDynamicSharedMemorySize, LDS_BYTES) != hipSuccess) { fprintf(stderr, "kernel_launch: hipFuncSetAttribute failed\n"); grid = -1; return; }
        if (hipOccupancyMaxActiveBlocksPerMultiprocessor(&per_cu, (const void*)mega, 512, LDS_BYTES) != hipSuccess || per_cu < 1) { fprintf(stderr, "kernel_launch: occupancy query says %d blocks per CU\n", per_cu); grid = -1; (void)hipGetLastError(); return; }
        grid = cus;
    }
    if (grid < 0) return;
    (void)hipMemsetAsync((char*)d_ws + WS_CTL, 0, CTL_ZERO_BYTES, stream);
    Args a{};
    a.x = (const float*)d_in[0]; a.mem = (const float*)d_in[1]; a.norm_w = (const float*)d_in[2]; a.w_in = (const float*)d_in[3]; a.gla_wup = (const float*)d_in[4]; a.gla_b = (const float*)d_in[5];
    a.gla_nw = (const float*)d_in[6]; a.hgrn_lb = (const float*)d_in[7]; a.hgrn_nw = (const float*)d_in[8]; a.mem_nw = (const float*)d_in[9]; a.w_mkv = (const float*)d_in[10]; a.xattn_nw = (const float*)d_in[11];
    a.w_out = (const float*)d_in[12]; a.final_nw = (const float*)d_in[13]; a.out = (float*)d_out; a.ws = (unsigned char*)d_ws;
#if MK_PER_PHASE
    for (int p = 0; p < N_PHASES; ++p) { a.ph_lo = p; a.ph_hi = p + 1; hipLaunchKernelGGL(mega, dim3(grid), dim3(512), LDS_BYTES, stream, a); }
#else
    a.ph_lo = 0; a.ph_hi = N_PHASES;
    void* kargs[] = {&a};
    hipError_t e = hipLaunchCooperativeKernel((const void*)mega, dim3(grid), dim3(512), kargs, LDS_BYTES, stream);
    if (e != hipSuccess) fprintf(stderr, "kernel_launch: cooperative launch failed: %s (grid %d)\n", hipGetErrorString(e), grid);
#endif
}
```

```cpp
#include <hip/hip_runtime.h>
#include <cstdio>
#include <cstdint>

#ifndef MK_PER_PHASE
#define MK_PER_PHASE 0
#endif
#ifndef PROBE_SUB
#define PROBE_SUB 0
#endif
#ifndef PROBE_REP
#define PROBE_REP -1
#endif

#define LAS __attribute__((address_space(3)))
#define GAS __attribute__((address_space(1)))
__device__ __forceinline__ int lane_id() { int l; asm volatile("v_mbcnt_lo_u32_b32 %0, -1, 0\n\tv_mbcnt_hi_u32_b32 %0, -1, %0" : "=v"(l)); return l; }
__device__ __forceinline__ int fresh_tid(int wave) { int t = wave * 64 + lane_id(); asm volatile("" : "+v"(t)); return t; }

namespace pg8 {
typedef unsigned short bf16_t;
typedef short bf16x8 __attribute__((ext_vector_type(8)));
typedef float f32x4 __attribute__((ext_vector_type(4)));
typedef unsigned u32x4 __attribute__((ext_vector_type(4)));
typedef unsigned u32x2 __attribute__((ext_vector_type(2)));
constexpr int BM = 256, BK = 64, HALF = 128, HTB = HALF * BK * 2, STAGE_BYTES = 8 * HTB, NXCD = 8, WGM = 8;

__host__ __device__ __forceinline__ int lds_byte(int r, int c) { const int st = (r >> 4) * 2 + (c >> 5), rr = r & 15, cc = c & 31, ob = rr * 64 + cc * 2; return st * 1024 + (ob ^ (((ob >> 9) & 1) << 5)); }
__host__ __device__ __forceinline__ void stage_rc(int b, int& R, int& C) { const int st = b / 1024, sb = b % 1024, swz = sb ^ (((sb >> 9) & 1) << 5); R = (st >> 1) * 16 + swz / 64; C = (st & 1) * 32 + (swz % 64) / 2; }
__host__ __device__ __forceinline__ int perm32(int rho) { const int n = rho >> 4, i = rho & 15; return 8 * (i >> 2) + 4 * n + (i & 3); }

struct Unit { int pm, pn; };
template <int M_, int N_, int K_, int LDA_, int LDB_, size_t K2A_ = 256> struct Gemm { const bf16_t* A; const bf16_t* Bt; static constexpr int M = M_, N = N_, K = K_, lda = LDA_, ldb = LDB_; static constexpr size_t k2A = K2A_; };

template <int M_, int N_> struct StaticOrder {
    static constexpr int nM = M_ / BM, nN = N_ / BM, nwg = nM * nN;
    int G, c;
    __host__ __device__ void init(int G_, int c_) { G = G_; c = c_; }
    __host__ __device__ bool next(int i, Unit& u) const {
        const long L = (long)i * G + c; if (L >= nwg) return false;
        int wgid = (int)L; { const int q = nwg / NXCD, r = nwg % NXCD, xcd = wgid % NXCD, off = wgid / NXCD; wgid = (xcd < r ? xcd * (q + 1) : r * (q + 1) + (xcd - r) * q) + off; }
        const int nig = WGM * nN, gid = wgid / nig, fm = gid * WGM, gsz = (nM - fm) < WGM ? (nM - fm) : WGM;
        u.pm = fm + ((wgid % nig) % gsz); u.pn = (wgid % nig) / gsz; return true;
    }
    __device__ __forceinline__ void a_ready(const Unit&) const {}
    __device__ __forceinline__ void done(const Unit&) const {}
};

template <class Epi, class Sched, class GemmT, bool ALIGN_EPI = false, bool SP2 = false>
__device__ __forceinline__ void gemm_phase(LAS unsigned char* lds, const GemmT g, const Sched& S, const Epi& E, int wave_) {
    const int tid = fresh_tid(wave_);
    const int wid = wave_, lane = tid & 63, wr = wid >> 2, wc = wid & 3, fr = lane & 15, fq = lane >> 4;
    constexpr int K = GemmT::K, nt = K / BK;
    unsigned voffA[2], voffB[2];
#pragma unroll
    for (int i = 0; i < 2; ++i) { int R, C; stage_rc(tid * 16 + i * 8192, R, C); const int Rb = Epi::PERM ? ((R & ~31) + perm32(R & 31)) : R;
        voffA[i] = (unsigned)(R * GemmT::lda + C) * 2u; voffB[i] = (unsigned)(Rb * GemmT::ldb + C) * 2u; }
    constexpr size_t kstep = (size_t)(BK * 2);
    constexpr size_t hstepA = (size_t)HALF * GemmT::lda * 2, hstepB = (size_t)HALF * GemmT::ldb * 2;
    constexpr size_t tstepA = 2 * hstepA, tstepB = 2 * hstepB;
    const unsigned ldsw = (unsigned)wid * 1024u;
    const int aoff = lds_byte(wr * 64 + fr, fq * 8), boff = lds_byte(wc * 32 + fr, fq * 8);
#define PG8_SA(b, h) (((b) * 2 + (h)) * HTB)
#define PG8_SB(b, h) ((4 + (b) * 2 + (h)) * HTB)
#define PG8_STAGE(bufoff, gbase, voff) do { _Pragma("unroll") for (int _i = 0; _i < 2; ++_i) \
        __builtin_amdgcn_global_load_lds((const unsigned*)((const char*)(gbase) + (voff)[_i]), (LAS unsigned*)(lds + (bufoff) + ldsw + _i * 8192), 16, 0, 0); } while (0)
#define PG8_LDA(dst, b, h) do { _Pragma("unroll") for (int m = 0; m < 4; ++m) _Pragma("unroll") for (int k = 0; k < 2; ++k) dst[m][k] = *(const LAS bf16x8*)(lds + PG8_SA(b, h) + aoff + m * 2048 + k * 1024); } while (0)
#define PG8_LDB(dst, b, h) do { _Pragma("unroll") for (int n = 0; n < 2; ++n) _Pragma("unroll") for (int k = 0; k < 2; ++k) dst[n][k] = *(const LAS bf16x8*)(lds + PG8_SB(b, h) + boff + n * 2048 + k * 1024); } while (0)
#define PG8_MMA(ai, bj, At, Bt) do { __builtin_amdgcn_s_setprio(1); _Pragma("unroll") for (int m = 0; m < 4; ++m) _Pragma("unroll") for (int n = 0; n < 2; ++n) _Pragma("unroll") for (int k = 0; k < 2; ++k) \
        acc[ai][bj][m][n] = __builtin_amdgcn_mfma_f32_16x16x32_bf16(Bt[n][k], At[m][k], acc[ai][bj][m][n], 0, 0, 0); __builtin_amdgcn_s_setprio(0); } while (0)
#define PG8_WAIT_V(n) asm volatile("s_waitcnt vmcnt(" #n ")" ::: "memory")
#define PG8_WAIT_L(n) asm volatile("s_waitcnt lgkmcnt(" #n ")" ::: "memory")
#define PG8_BAR __builtin_amdgcn_s_barrier()
#define PG8_SCHED __builtin_amdgcn_sched_barrier(0)
    Unit cur, nxt; int ui = 0;
    if (!S.next(0, cur)) return;
    f32x4 acc[2][2][4][2];
#pragma unroll
    for (int a = 0; a < 2; ++a)
#pragma unroll
        for (int b = 0; b < 2; ++b)
#pragma unroll
            for (int m = 0; m < 4; ++m)
#pragma unroll
                for (int n = 0; n < 2; ++n) acc[a][b][m][n] = (f32x4){0.f, 0.f, 0.f, 0.f};
    bf16x8 At[4][2], B0[2][2], B1[2][2];
    const char* cA = (const char*)g.A + (size_t)cur.pm * tstepA; const char* cB = (const char*)g.Bt + (size_t)cur.pn * tstepB;
    S.a_ready(cur);
    if constexpr (SP2) {
        PG8_STAGE(PG8_SB(0, 0), cB, voffB); PG8_STAGE(PG8_SB(0, 1), cB + hstepB, voffB); PG8_STAGE(PG8_SA(0, 0), cA, voffA); PG8_STAGE(PG8_SA(0, 1), cA + hstepA, voffA);
        if (wr == 1) PG8_BAR;
        PG8_WAIT_V(2); PG8_BAR;
        PG8_STAGE(PG8_SB(1, 0), cB + kstep, voffB); PG8_STAGE(PG8_SA(1, 0), cA + kstep, voffA); PG8_STAGE(PG8_SB(1, 1), cB + hstepB + kstep, voffB);
        PG8_WAIT_V(6); PG8_BAR;
    } else {
        PG8_STAGE(PG8_SB(0, 0), cB, voffB); PG8_STAGE(PG8_SA(0, 0), cA, voffA); PG8_STAGE(PG8_SB(0, 1), cB + hstepB, voffB); PG8_STAGE(PG8_SA(0, 1), cA + hstepA, voffA);
        if (wr == 1) PG8_BAR;
        PG8_WAIT_V(4); PG8_BAR;
        PG8_STAGE(PG8_SB(1, 0), cB + kstep, voffB); PG8_STAGE(PG8_SA(1, 0), cA + kstep, voffA); PG8_STAGE(PG8_SB(1, 1), cB + hstepB + kstep, voffB);
        PG8_WAIT_V(6); PG8_BAR;
    }
    for (;;) {
        const bool has_next = S.next(ui + 1, nxt);
        const char* nA = has_next ? (const char*)g.A + (size_t)nxt.pm * tstepA : cA; const char* nB = has_next ? (const char*)g.Bt + (size_t)nxt.pn * tstepB : cB;
        for (int t = 0; t < nt; t += 2) {
            const bool last = (t == nt - 2);
            const char* a1 = cA + (size_t)(t >> 1) * GemmT::k2A + kstep;
            const char* a2 = last ? nA : cA + (size_t)((t >> 1) + 1) * GemmT::k2A; const char* b2 = last ? nB : cB + (size_t)(t + 2) * kstep;
            const char* a3 = a2 + kstep; const char* b3 = b2 + kstep;
            if (last && has_next) S.a_ready(nxt);
            if constexpr (SP2) {
            PG8_LDB(B0, 0, 0); PG8_LDB(B1, 0, 1); PG8_SCHED; PG8_LDA(At, 0, 0); PG8_STAGE(PG8_SA(1, 1), a1 + hstepA, voffA);
            PG8_WAIT_V(8); PG8_WAIT_L(0); PG8_BAR; PG8_MMA(0, 0, At, B0); PG8_MMA(0, 1, At, B1); PG8_BAR; PG8_SCHED;
            PG8_LDA(At, 0, 1); PG8_STAGE(PG8_SB(0, 0), b2, voffB); PG8_STAGE(PG8_SB(0, 1), b2 + hstepB, voffB); PG8_STAGE(PG8_SA(0, 0), a2, voffA);
            PG8_WAIT_V(8); PG8_WAIT_L(0); PG8_BAR; PG8_MMA(1, 0, At, B0); PG8_MMA(1, 1, At, B1); PG8_BAR; PG8_SCHED;
            PG8_LDB(B0, 1, 0); PG8_LDB(B1, 1, 1); PG8_SCHED; PG8_LDA(At, 1, 0); PG8_STAGE(PG8_SA(0, 1), a2 + hstepA, voffA);
            PG8_WAIT_V(8); PG8_WAIT_L(0); PG8_BAR; PG8_MMA(0, 0, At, B0); PG8_MMA(0, 1, At, B1); PG8_BAR; PG8_SCHED;
            PG8_LDA(At, 1, 1); PG8_STAGE(PG8_SB(1, 0), b3, voffB); PG8_STAGE(PG8_SB(1, 1), b3 + hstepB, voffB); PG8_STAGE(PG8_SA(1, 0), a3, voffA);
            PG8_WAIT_V(8); PG8_WAIT_L(0); PG8_BAR; PG8_MMA(1, 0, At, B0); PG8_MMA(1, 1, At, B1); PG8_BAR; PG8_SCHED;
            } else {
            PG8_LDB(B0, 0, 0); PG8_SCHED; PG8_LDA(At, 0, 0); PG8_STAGE(PG8_SA(1, 1), a1 + hstepA, voffA);
            PG8_WAIT_L(8); PG8_BAR; PG8_WAIT_L(0); PG8_MMA(0, 0, At, B0); PG8_BAR; PG8_SCHED;
            PG8_LDB(B1, 0, 1); PG8_STAGE(PG8_SB(0, 0), b2, voffB);
            PG8_BAR; PG8_WAIT_L(0); PG8_MMA(0, 1, At, B1); PG8_BAR;
            PG8_LDA(At, 0, 1); PG8_STAGE(PG8_SA(0, 0), a2, voffA);
            PG8_BAR; PG8_WAIT_L(0); PG8_MMA(1, 0, At, B0); PG8_BAR; PG8_SCHED;
            PG8_STAGE(PG8_SB(0, 1), b2 + hstepB, voffB);
            PG8_WAIT_V(6); PG8_BAR; PG8_MMA(1, 1, At, B1); PG8_BAR;
            PG8_LDB(B0, 1, 0); PG8_SCHED; PG8_LDA(At, 1, 0); PG8_STAGE(PG8_SA(0, 1), a2 + hstepA, voffA);
            PG8_WAIT_L(8); PG8_BAR; PG8_WAIT_L(0); PG8_MMA(0, 0, At, B0); PG8_BAR; PG8_SCHED;
            PG8_LDB(B1, 1, 1); PG8_STAGE(PG8_SB(1, 0), b3, voffB);
            PG8_BAR; PG8_WAIT_L(0); PG8_MMA(0, 1, At, B1); PG8_BAR;
            PG8_LDA(At, 1, 1); PG8_STAGE(PG8_SA(1, 0), a3, voffA);
            PG8_BAR; PG8_WAIT_L(0); PG8_MMA(1, 0, At, B0); PG8_BAR; PG8_SCHED;
            PG8_STAGE(PG8_SB(1, 1), b3 + hstepB, voffB);
            PG8_WAIT_V(6); PG8_BAR; PG8_MMA(1, 1, At, B1); PG8_BAR;
            }
        }
        if constexpr (ALIGN_EPI) { if (wr == 0) PG8_BAR; }
        E(acc, cur, wr, wc, fr, fq); S.done(cur);
        if (!has_next) break;
#pragma unroll
        for (int a = 0; a < 2; ++a)
#pragma unroll
            for (int b = 0; b < 2; ++b)
#pragma unroll
                for (int m = 0; m < 4; ++m)
#pragma unroll
                    for (int n = 0; n < 2; ++n) acc[a][b][m][n] = (f32x4){0.f, 0.f, 0.f, 0.f};
        cur = nxt; cA = nA; cB = nB; ++ui;
        if constexpr (ALIGN_EPI) { if (wr == 1) PG8_BAR; }
    }
    PG8_WAIT_V(0);
    if constexpr (!ALIGN_EPI) { if (wr == 0) PG8_BAR; }
    PG8_BAR;
#undef PG8_SA
#undef PG8_SB
#undef PG8_STAGE
#undef PG8_LDA
#undef PG8_LDB
#undef PG8_MMA
#undef PG8_WAIT_V
#undef PG8_WAIT_L
#undef PG8_BAR
#undef PG8_SCHED
}
}

typedef unsigned short bf16;
typedef short bf16x8 __attribute__((ext_vector_type(8)));
typedef short s16x4 __attribute__((ext_vector_type(4)));
typedef float f32x4 __attribute__((ext_vector_type(4)));
typedef float f32x2 __attribute__((ext_vector_type(2)));
typedef unsigned u32x4 __attribute__((ext_vector_type(4)));
typedef unsigned u32x2 __attribute__((ext_vector_type(2)));
typedef _Float16 f16x2 __attribute__((ext_vector_type(2)));
typedef __bf16 bf16x2_t __attribute__((ext_vector_type(2)));
typedef short v4i16_t __attribute__((ext_vector_type(4)));

constexpr int NB = 8, SEQ = 4096, T = NB * SEQ, D = 1024, DEPTH = 2, DINP = 6160, DMIX = 2048, MEML = 256, MROWS = NB * MEML;
constexpr int NP = 6656;
constexpr int LDP = 6656;
constexpr size_t PGS = (size_t)32768 * 128;
__host__ __device__ constexpr size_t pgo(int col, int t) { return (size_t)(col >> 7) * PGS + (size_t)t * 128 + (col & 127); }
constexpr int C_GQ = 0, C_GK = 512, C_GG = 1024, C_GV = 1536, C_HQ = 2560, C_HLF = 3072, C_HI = 3584, C_XQ = 4096, C_SG = 4608;
constexpr float NORM_EPS = 1e-6f;
constexpr int NSEG = 8, SEGLEN = 512, NMC = SEGLEN / 64;
constexpr int N_MIX_UNITS = 512;
constexpr int N_XA_UNITS = 256;

constexpr size_t MiB = 1u << 20;
constexpr size_t WS_CTL = 0, CTL_ZERO_BYTES = 1 * MiB;
constexpr size_t WS_SSQ1 = 1 * MiB, WS_SSQ2 = 3 * MiB;
constexpr size_t WS_MKV = 5 * MiB;
constexpr size_t WS_W1T = 13 * MiB;
constexpr size_t WS_W2T = 27 * MiB;
constexpr size_t WS_XB = 31 * MiB;
constexpr size_t WS_SEND = WS_XB, WS_DTOT = WS_XB + 48 * MiB;
constexpr size_t WS_P = 95 * MiB;
constexpr size_t WS_END = WS_P + (size_t)T * LDP * 2;
static_assert(WS_END <= 512 * MiB, "workspace map");
constexpr size_t DO_MEMB = 0, DO_WKVT = 4 * MiB, DO_SSQ0 = 8 * MiB, DO_RSTDM = 10 * MiB;
constexpr int CW_BAR = 4096;
constexpr int CW_QUEUE = 2048;
constexpr size_t WS_HTAB = 512 * 1024;
constexpr int LDS_BYTES = 147456, MISC_OFF = LDS_BYTES - 64;

#define LDS_WAIT() asm volatile("s_waitcnt lgkmcnt(0)" ::: "memory")
#define VM_WAIT() asm volatile("s_waitcnt vmcnt(0)" ::: "memory")
#define RLX_AGENT __ATOMIC_RELAXED, __HIP_MEMORY_SCOPE_AGENT
__device__ __forceinline__ unsigned f2bf(float f) { unsigned u = __builtin_bit_cast(unsigned, f); return (u + 0x7fffu + ((u >> 16) & 1u)) >> 16; }
__device__ __forceinline__ unsigned pk2(float lo, float hi) { f32x2 v = {lo, hi}; bf16x2_t b = __builtin_convertvector(v, bf16x2_t); return __builtin_bit_cast(unsigned, b); }
__device__ __forceinline__ unsigned pkh2(float lo, float hi) { f32x2 v = {lo, hi}; f16x2 h = __builtin_convertvector(v, f16x2); return __builtin_bit_cast(unsigned, h); }
__device__ __forceinline__ float bflo(unsigned w) { return __builtin_bit_cast(float, w << 16); }
__device__ __forceinline__ float bfhi(unsigned w) { return __builtin_bit_cast(float, w & 0xffff0000u); }
__device__ __forceinline__ float fexp(float x) { return __builtin_amdgcn_exp2f(x * 1.4426950408889634f); }
__device__ __forceinline__ float flog(float x) { return __builtin_amdgcn_logf(x) * 0.6931471805599453f; }
__device__ __forceinline__ float log_sigmoid(float z) { return fminf(z, 0.f) - flog(1.f + fexp(-fabsf(z))); }
__device__ __forceinline__ s16x4 tr16(const LAS unsigned char* p) { return __builtin_bit_cast(s16x4, __builtin_amdgcn_ds_read_tr16_b64_v4i16((LAS v4i16_t*)p)); }
__device__ __forceinline__ float wave_sum(float v) {
#pragma unroll
    for (int o = 1; o < 64; o <<= 1) v += __shfl_xor(v, o);
    return v;
}

#define XB_TMO      128
#define XB_XCNT(j)  (256  + 64 * (j))
#define XB_XSUB(j)  (1280 + 64 * (j))
#define XB_XGEN(j)  (2304 + 64 * (j))
#define XB_TOP      3328
#define XB_TOPGEN   3392
#define XCD_BAR_WORDS 3456
#define XB_SPIN_CAP (1u << 20)
__device__ __forceinline__ unsigned xb_ld(unsigned* p)              { return __hip_atomic_load(p, __ATOMIC_RELAXED, __HIP_MEMORY_SCOPE_AGENT); }
__device__ __forceinline__ unsigned xb_add(unsigned* p, unsigned v) { return __hip_atomic_fetch_add(p, v, __ATOMIC_RELAXED, __HIP_MEMORY_SCOPE_AGENT); }
__device__ __forceinline__ unsigned xb_xcc_id() { return (unsigned)__builtin_amdgcn_s_getreg((3 << 11) | 20) & 0xFu; }
#define XB_SPIN(cond, bar) do { unsigned _sp = 0; while (cond) { __builtin_amdgcn_s_sleep(1); \
    if ((++_sp & 255u) == 0u) { if (xb_ld(&(bar)[XB_TMO])) break; if (_sp > XB_SPIN_CAP) { atomicAdd(&(bar)[XB_TMO], 1u); break; } } } } while (0)
struct XcdBarrier { unsigned* bar; unsigned x; volatile LAS unsigned* st; int wave; };
__device__ __forceinline__ XcdBarrier xcd_barrier_post(unsigned* bar, volatile LAS unsigned* st, int wave) {
    XcdBarrier b; b.bar = bar; b.x = xb_xcc_id(); b.st = st; b.wave = wave;
    if (wave == 0 && lane_id() == 0) (void)xb_add(&bar[XB_XCNT(b.x)], 1u);
    return b;
}
__device__ __forceinline__ void xcd_barrier_complete(unsigned* bar, unsigned x, unsigned& nloc, unsigned& nx) {
    const unsigned G = gridDim.x * gridDim.y * gridDim.z;
    unsigned sum, cnt, mine, sp = 0u;
    for (;;) {
        sum = 0u; cnt = 0u; mine = 0u;
#pragma unroll 1
        for (unsigned j = 0; j < 16; ++j) { const unsigned c = xb_ld(&bar[XB_XCNT(j)]); sum += c; cnt += (c > 0u) ? 1u : 0u; mine = (j == x) ? c : mine; }
        if (sum == G) break;
        __builtin_amdgcn_s_sleep(1);
        if ((++sp & 255u) == 0u) { if (xb_ld(&bar[XB_TMO])) break; if (sp > XB_SPIN_CAP) { atomicAdd(&bar[XB_TMO], 1u); break; } }
    }
    nloc = mine > 0u ? mine : 1u; nx = cnt > 0u ? cnt : 1u;
}
__device__ __forceinline__ void xcd_barrier(const XcdBarrier& b) {
    asm volatile("s_waitcnt vmcnt(0)" ::: "memory");
    __syncthreads();
    if (b.wave == 0 && lane_id() == 0) {
        unsigned* bar = b.bar;
        __builtin_amdgcn_s_waitcnt(0);
        unsigned nloc = b.st[0], nx = b.st[1];
        if (nloc == 0u) { xcd_barrier_complete(bar, b.x, nloc, nx); b.st[0] = nloc; b.st[1] = nx; }
        const unsigned old = xb_add(&bar[XB_XSUB(b.x)], 1u);
        const unsigned gen = old / nloc;
        if (old + 1u == (gen + 1u) * nloc) {
            __builtin_amdgcn_fence(__ATOMIC_RELEASE, "agent");
            asm volatile("s_waitcnt vmcnt(0)" ::: "memory");
            const unsigned og = xb_add(&bar[XB_TOP], 1u);
            const unsigned tg = og / nx;
            if (og + 1u == (tg + 1u) * nx) xb_add(&bar[XB_TOPGEN], 1u);
            else XB_SPIN(xb_ld(&bar[XB_TOPGEN]) == tg, bar);
            __builtin_amdgcn_fence(__ATOMIC_ACQUIRE, "agent");
            xb_add(&bar[XB_XGEN(b.x)], 1u);
            asm volatile("s_waitcnt vmcnt(0)" ::: "memory");
        } else {
            XB_SPIN(xb_ld(&bar[XB_XGEN(b.x)]) == gen, bar);
            __builtin_amdgcn_fence(__ATOMIC_ACQUIRE, "agent");
            asm volatile("s_waitcnt vmcnt(0)" ::: "memory");
        }
    }
    __syncthreads();
}

struct Args {
    const float* x; const float* mem; const float* norm_w; const float* w_in; const float* gla_wup; const float* gla_b; const float* gla_nw; const float* hgrn_lb;
    const float* hgrn_nw; const float* mem_nw; const float* w_mkv; const float* xattn_nw; const float* w_out; const float* final_nw;
    float* out; unsigned char* ws; int ph_lo, ph_hi, probe, pad;
};
struct Frame {
    LAS unsigned char* lds; volatile LAS unsigned* MISC; unsigned* ctl;
    int wave, vcu, G;
};

__device__ __forceinline__ void tr_item(const float* W, int Nsrc, int srccol0, const float* kscale, float rscale, bf16* WT, int ldt, int dstrow0, int k0, LAS float* scr, int lane) {
    float wv_[32], ks_[32];
#pragma unroll
    for (int i = 0; i < 32; ++i) { const int kk = 2 * i + (lane >> 5); ks_[i] = kscale ? kscale[k0 + kk] : 1.f; wv_[i] = W[(size_t)(k0 + kk) * Nsrc + srccol0 + (lane & 31)]; }
#pragma unroll
    for (int i = 0; i < 32; ++i) { const int kk = 2 * i + (lane >> 5); scr[kk * 33 + (lane & 31)] = wv_[i] * ks_[i] * rscale; }
    LDS_WAIT(); asm volatile("" ::: "memory");
    const int c = lane & 7;
#pragma unroll
    for (int j = 0; j < 4; ++j) { const int n = (lane >> 3) + 8 * j; const LAS float* s = scr + (8 * c) * 33 + n;
        u32x4 o; o.x = pk2(s[0 * 33], s[1 * 33]); o.y = pk2(s[2 * 33], s[3 * 33]); o.z = pk2(s[4 * 33], s[5 * 33]); o.w = pk2(s[6 * 33], s[7 * 33]);
        *(u32x4*)(WT + (size_t)(dstrow0 + n) * ldt + k0 + 8 * c) = o; }
    LDS_WAIT(); asm volatile("" ::: "memory");
}
__device__ __forceinline__ void prep_w1(const Frame& F, const Args& a, int layer) {
    const int lane_ = fresh_tid(F.wave) & 63;
    LAS float* scr = (LAS float*)(F.lds + F.wave * 16384);
    const int gw = F.vcu * 8 + F.wave, NGW = F.G * 8;
    const float* W = a.w_in + (size_t)layer * D * DINP; const float* nw = a.norm_w + layer * D; bf16* WT = (bf16*)(a.ws + WS_W1T);
    constexpr int NBLK = (NP - 512) / 32;
    for (int it = gw; it < NBLK * 16; it += NGW) {
        const int kb = it & 15; int nb = it >> 4; if (nb >= 32) nb += 16;
        const int n0 = nb * 32; const int src = n0 < 1024 ? n0 : (n0 < 2560 ? n0 - 512 : n0 - 496);
        const float rs = (n0 < 512 || (n0 >= 4096 && n0 < 4608)) ? 0.08838834764831845f : 1.f;
        tr_item(W, DINP, src, nw, rs, WT, D, n0, kb * 64, scr, lane_);
    }
    const float* wup = a.gla_wup + (size_t)layer * 16 * 512;
    for (int it = gw; it < 512 * 2; it += NGW) {
        const int c = it >> 1, ko = ((it & 1) * 64 + lane_) * 8;
        float up[16];
#pragma unroll
        for (int r = 0; r < 16; ++r) up[r] = wup[r * 512 + c];
        float o[8];
#pragma unroll
        for (int kk = 0; kk < 8; ++kk) { const float* wr_ = W + (size_t)(ko + kk) * DINP + 2048; float s = 0.f;
#pragma unroll
            for (int r4 = 0; r4 < 4; ++r4) { const f32x4 w4 = *(const f32x4*)(wr_ + 4 * r4); s += w4.x * up[4 * r4] + w4.y * up[4 * r4 + 1] + w4.z * up[4 * r4 + 2] + w4.w * up[4 * r4 + 3]; }
            o[kk] = s * nw[ko + kk]; }
        u32x4 w; w.x = pk2(o[0], o[1]); w.y = pk2(o[2], o[3]); w.z = pk2(o[4], o[5]); w.w = pk2(o[6], o[7]);
        *(u32x4*)(WT + (size_t)(1024 + c) * D + ko) = w;
    }
}
__device__ __forceinline__ void prep_w2(const Frame& F, const Args& a, int layer) {
    const int lane_ = fresh_tid(F.wave) & 63;
    LAS float* scr = (LAS float*)(F.lds + F.wave * 16384);
    const int gw = F.vcu * 8 + F.wave, NGW = F.G * 8;
    const float* W = a.w_out + (size_t)layer * DMIX * D; bf16* WT = (bf16*)(a.ws + WS_W2T);
    for (int it = gw; it < 32 * 32; it += NGW) { const int kb = it & 31, nb = it >> 5; tr_item(W, D, nb * 32, nullptr, 1.f, WT, DMIX, nb * 32, kb * 64, scr, lane_); }
}
__device__ __forceinline__ void prep_wkv(const Frame& F, const Args& a) {
    const int lane_ = fresh_tid(F.wave) & 63;
    LAS float* scr = (LAS float*)(F.lds + F.wave * 16384);
    const int gw = F.vcu * 8 + F.wave, NGW = F.G * 8;
    bf16* WT = (bf16*)((unsigned char*)a.out + DO_WKVT);
    for (int it = gw; it < 2 * 32 * 16; it += NGW) { const int layer = it >> 9, r = it & 511, kb = r & 15, nb = r >> 4;
        tr_item(a.w_mkv + (size_t)layer * D * 1024, 1024, nb * 32, a.mem_nw + layer * D, 1.f, WT, D, layer * 1024 + nb * 32, kb * 64, scr, lane_); }
}
template <int RB>
__device__ __forceinline__ void rows_to_bf16(const float* x0, bf16* o0, int lane, float (&ss)[RB]) {
    f32x4 v[RB][4];
#pragma unroll
    for (int r = 0; r < RB; ++r)
#pragma unroll
        for (int j = 0; j < 4; ++j) v[r][j] = *((const f32x4*)(x0 + (size_t)r * D) + lane + 64 * j);
#pragma unroll
    for (int r = 0; r < RB; ++r) { float s = 0.f; u32x2* o8 = (u32x2*)(o0 + (size_t)r * D) + lane;
#pragma unroll
        for (int j = 0; j < 4; ++j) { s += (v[r][j].x * v[r][j].x + v[r][j].y * v[r][j].y) + (v[r][j].z * v[r][j].z + v[r][j].w * v[r][j].w); u32x2 w; w.x = pk2(v[r][j].x, v[r][j].y); w.y = pk2(v[r][j].z, v[r][j].w); o8[64 * j] = w; }
        ss[r] = wave_sum(s); }
}
__device__ __forceinline__ void prep_x(const Frame& F, const Args& a) {
    const int lane_ = fresh_tid(F.wave) & 63;
    const int gw = F.vcu * 8 + F.wave, NGW = F.G * 8;
    if (gw < 16) {
        float* ht = (float*)(a.ws + WS_HTAB); const int c = (gw & 7) * 64 + lane_, l = gw >> 3; float lb = 0.f;
        if (l == 1) { const float h0 = a.hgrn_lb[c], h1 = a.hgrn_lb[512 + c]; lb = 1.f / (1.f + expf(h0 - h1)); }
        ht[l * 1024 + c] = logf(fmaxf(lb, 1e-30f)); ht[l * 1024 + 512 + c] = log1pf(-lb); }
    bf16* xb = (bf16*)(a.ws + WS_XB); float* ssq0 = (float*)((unsigned char*)a.out + DO_SSQ0);
    for (int m = 4 * gw; m < T; m += 4 * NGW) { float ss[4]; rows_to_bf16<4>(a.x + (size_t)m * D, xb + (size_t)m * D, lane_, ss);
#pragma unroll
        for (int r = 0; r < 4; ++r) if (lane_ < 16) ssq0[(size_t)(m + r) * 16 + lane_] = lane_ == 0 ? ss[r] : 0.f; }
    bf16* memb = (bf16*)((unsigned char*)a.out + DO_MEMB); float* rstdm = (float*)((unsigned char*)a.out + DO_RSTDM);
    for (int m = gw; m < MROWS; m += NGW) { float ss[1]; rows_to_bf16<1>(a.mem + (size_t)m * D, memb + (size_t)m * D, lane_, ss);
        if (lane_ == 0) rstdm[m] = 1.0f / sqrtf(ss[0] * (1.f / D) + NORM_EPS); }
}

struct EpiProj {
    static constexpr bool PERM = true;
    bf16* P; const float* ssq; const float* gbias; const float* htab;
    template <int KIND>
    __device__ __forceinline__ void store_tile(const f32x4 (&acc)[2][2][4][2], bf16* rowp0, const float* ssqp, int cbase, int fq) const {
#pragma unroll
        for (int ai = 0; ai < 2; ++ai)
#pragma unroll
            for (int m = 0; m < 4; ++m) {
                const f32x4 s4 = *(const f32x4*)(ssqp + (size_t)(ai * 128 + m * 16) * 16 + 4 * fq);
                float sq = (s4.x + s4.y) + (s4.z + s4.w); sq += __shfl_xor(sq, 16); sq += __shfl_xor(sq, 32);
                const float rs = __builtin_amdgcn_rsqf(sq * (1.f / D) + NORM_EPS);
#pragma unroll
                for (int bj = 0; bj < 2; ++bj) { float v[8];
#pragma unroll
                    for (int e = 0; e < 4; ++e) { v[e] = acc[ai][bj][m][0][e] * rs; v[4 + e] = acc[ai][bj][m][1][e] * rs; }
                    u32x4 w;
                    if (KIND == 0) { w.x = pk2(v[0], v[1]); w.y = pk2(v[2], v[3]); w.z = pk2(v[4], v[5]); w.w = pk2(v[6], v[7]); }
                    else if (KIND == 3) {
#pragma unroll
                        for (int e = 0; e < 8; ++e) v[e] = v[e] * __builtin_amdgcn_rcpf(1.f + fexp(-v[e]));
                        w.x = pk2(v[0], v[1]); w.y = pk2(v[2], v[3]); w.z = pk2(v[4], v[5]); w.w = pk2(v[6], v[7]); }
                    else if (KIND == 1) { const f32x4 b0 = *(const f32x4*)(gbias + cbase + bj * 128), b1 = *(const f32x4*)(gbias + cbase + bj * 128 + 4);
#pragma unroll
                        for (int e = 0; e < 8; ++e) v[e] = log_sigmoid(v[e] + (e < 4 ? b0[e & 3] : b1[e & 3])) * (0.0625f * 1.4426950408889634f);
                        w.x = pkh2(v[0], v[1]); w.y = pkh2(v[2], v[3]); w.z = pkh2(v[4], v[5]); w.w = pkh2(v[6], v[7]); }
                    else { const f32x4 a0 = *(const f32x4*)(htab + cbase + bj * 128), a1 = *(const f32x4*)(htab + cbase + bj * 128 + 4), c0 = *(const f32x4*)(htab + 512 + cbase + bj * 128), c1 = *(const f32x4*)(htab + 512 + cbase + bj * 128 + 4);
#pragma unroll
                        for (int e = 0; e < 8; ++e) { const float aa = e < 4 ? a0[e & 3] : a1[e & 3], bb = (e < 4 ? c0[e & 3] : c1[e & 3]) + log_sigmoid(v[e]); const float mx = fmaxf(aa, bb);
                            v[e] = (mx + flog(1.f + fexp(-fabsf(aa - bb)))) * 1.4426950408889634f; }
                        w.x = pkh2(v[0], v[1]); w.y = pkh2(v[2], v[3]); w.z = pkh2(v[4], v[5]); w.w = pkh2(v[6], v[7]); }
                    *(u32x4*)(rowp0 + (size_t)(ai * 128 + m * 16) * 128 + (size_t)bj * PGS) = w; }
            }
    }
    __device__ __forceinline__ void operator()(const f32x4 (&acc)[2][2][4][2], const pg8::Unit& u, int wr, int wc, int fr, int fq) const {
        const int pn = u.pn; int kind, dcol, cb0 = 0;
        if (pn < 2) { kind = 0; dcol = C_GQ + 256 * pn; } else if (pn < 4) { kind = 0; dcol = C_GK + 256 * (pn - 2); } else if (pn < 6) { kind = 1; dcol = C_GG + 256 * (pn - 4); cb0 = 256 * (pn - 4); }
        else if (pn < 10) { kind = 0; dcol = C_GV + 256 * (pn - 6); } else if (pn < 12) { kind = 0; dcol = C_HQ + 256 * (pn - 10); } else if (pn < 14) { kind = 2; dcol = C_HLF + 256 * (pn - 12); cb0 = 256 * (pn - 12); }
        else if (pn < 16) { kind = 0; dcol = C_HI + 256 * (pn - 14); } else if (pn < 18) { kind = 0; dcol = C_XQ + 256 * (pn - 16); } else { kind = 3; dcol = C_SG + 256 * (pn - 18); }
        const int row0 = u.pm * 256 + wr * 64 + fr;
        const int cw = wc * 32 + 8 * fq;
        bf16* rowp0 = P + pgo(dcol, row0) + cw; const float* ssqp = ssq + (size_t)row0 * 16;
        if (kind == 0) store_tile<0>(acc, rowp0, ssqp, 0, fq);
        else if (kind == 3) store_tile<3>(acc, rowp0, ssqp, 0, fq);
        else if (kind == 1) store_tile<1>(acc, rowp0, ssqp, cb0 + cw, fq);
        else store_tile<2>(acc, rowp0, ssqp, cb0 + cw, fq);
    }
};
struct EpiMem {
    static constexpr bool PERM = true;
    bf16* O; const float* rstdm;
    __device__ __forceinline__ void operator()(const f32x4 (&acc)[2][2][4][2], const pg8::Unit& u, int wr, int wc, int fr, int fq) const {
        const int row0 = u.pm * 256 + wr * 64 + fr, col0 = u.pn * 256 + wc * 32 + 8 * fq;
#pragma unroll
        for (int ai = 0; ai < 2; ++ai)
#pragma unroll
            for (int m = 0; m < 4; ++m) { const int row = row0 + ai * 128 + m * 16; const float rs = rstdm[row]; bf16* rowp = O + (size_t)row * 2048 + col0;
#pragma unroll
                for (int bj = 0; bj < 2; ++bj) { const f32x4 v0 = acc[ai][bj][m][0] * rs, v1 = acc[ai][bj][m][1] * rs; u32x4 w;
                    w.x = pk2(v0[0], v0[1]); w.y = pk2(v0[2], v0[3]); w.z = pk2(v1[0], v1[1]); w.w = pk2(v1[2], v1[3]); *(u32x4*)(rowp + bj * 128) = w; } }
    }
};
struct EpiRes {
    static constexpr bool PERM = false;
    const float* resid; float* out; bf16* xb; float* ssq;
    __device__ __forceinline__ void operator()(const f32x4 (&acc)[2][2][4][2], const pg8::Unit& u, int wr, int wc, int fr, int fq) const {
        const int row0 = u.pm * 256 + wr * 64 + fr, col0 = u.pn * 256 + wc * 32 + 4 * fq;
#pragma unroll
        for (int ai = 0; ai < 2; ++ai)
#pragma unroll
            for (int m = 0; m < 4; ++m) { const int row = row0 + ai * 128 + m * 16; const size_t off = (size_t)row * D + col0; float ss = 0.f;
#pragma unroll
                for (int bj = 0; bj < 2; ++bj)
#pragma unroll
                    for (int n = 0; n < 2; ++n) { const f32x4 r4 = *(const f32x4*)(resid + off + bj * 128 + n * 16); const f32x4 o = r4 + acc[ai][bj][m][n];
                        *(f32x4*)(out + off + bj * 128 + n * 16) = o; u32x2 w; w.x = pk2(o[0], o[1]); w.y = pk2(o[2], o[3]); *(u32x2*)(xb + off + bj * 128 + n * 16) = w;
                        ss += (o[0] * o[0] + o[1] * o[1]) + (o[2] * o[2] + o[3] * o[3]); }
                ss += __shfl_xor(ss, 16); ss += __shfl_xor(ss, 32);
                if (fq == 0) ssq[(size_t)row * 16 + u.pn * 4 + wc] = ss; }
    }
};

namespace mx {
constexpr int RSB = 272;
constexpr int TILE_BYTES = 64 * RSB;
constexpr int OFF_Q = 0, OFF_K = TILE_BYTES, OFF_K2 = 2 * TILE_BYTES, OFF_V = 3 * TILE_BYTES;
constexpr int OFF_DC = OFF_V + 64 * 528, OFF_END = OFF_DC + 2048;
static_assert(OFF_END <= MISC_OFF && 64 * 260 * 4 <= OFF_DC, "mixer LDS map");

template <int PASS, int KIND>
__device__ __forceinline__ void mix_unit(const Frame& F, const Args& a, int u, int layer, bool dry) {
    constexpr int NVT = KIND == 0 ? 2 : 1, DV = 128 * NVT, VRS = DV * 2 + 16, OSS = DV + 4, NVP = 2 * NVT  , NGP = 2 * NVT  ;
    const int tid = fresh_tid(F.wave), lane = tid & 63, w = F.wave;
    const int li = lane & 15, g4 = lane >> 4, q_ = li >> 2, p_ = li & 3;
    const int ul = KIND == 0 ? u : u - 256, b = ul >> 5, hd = (ul >> 3) & 3, seg = ul & 7;
    const int t0 = b * SEQ + seg * SEGLEN;
    const int qcol = KIND == 0 ? C_GQ + hd * 128 : C_HQ + hd * 128, kcol = C_GK + hd * 128, gcol = KIND == 0 ? C_GG + hd * 128 : C_HLF + hd * 128;
    const int vcol = KIND == 0 ? C_GV + hd * 256 : C_HI + hd * 128, ocol = KIND == 0 ? C_SG + hd * 256 : C_SG + 1024 + hd * 128;
    const float* nw = KIND == 0 ? a.gla_nw + layer * 256 : a.hgrn_nw + layer * 128;
    LAS unsigned char* L = F.lds;
    const bf16* P = (const bf16*)(a.ws + WS_P);
    float* SEND = (float*)(a.ws + WS_SEND) + (KIND == 0 ? (size_t)ul * 32768 : (size_t)256 * 32768 + (size_t)ul * 16384);
    float* DTOT = (float*)(a.ws + WS_DTOT) + (size_t)u * 128;
    constexpr int SEND_UNIT = KIND == 0 ? 32768 : 16384;
    f32x4 S[8][NVT];
#pragma unroll
    for (int dt = 0; dt < 8; ++dt)
#pragma unroll
        for (int vt = 0; vt < NVT; ++vt) S[dt][vt] = (f32x4){0.f, 0.f, 0.f, 0.f};
    if (PASS == 1 && !(dry && (PROBE_SUB & 1))) {
        for (int s = 0; s < seg; ++s) { const float* sp = SEND - (size_t)(seg - s) * SEND_UNIT + (size_t)(w * 8 * NVT) * 256 + lane * 4; const float* dp = DTOT - (size_t)(seg - s) * 128 + 4 * g4;
#pragma unroll
            for (int dt = 0; dt < 8; ++dt) { const f32x4 dv = *(const f32x4*)(dp + 16 * dt);
#pragma unroll
                for (int vt = 0; vt < NVT; ++vt) { const f32x4 sv = *(const f32x4*)(sp + (dt * NVT + vt) * 256); S[dt][vt] = S[dt][vt] * dv + sv; } } }
    }
    const int ca = w >> 1, th = w & 1;
    unsigned gw_[16], kw_[8], qw_[8]; u32x4 vv[NVP];
#define MX_LOADS(mc_) do { const size_t ro_ = (size_t)(t0 + (mc_) * 64 + 16 * ca) * 128 + 2 * lane;     \
        const bf16* gp_ = P + (size_t)(gcol >> 7) * PGS + ro_; const bf16* kp_ = P + (size_t)(kcol >> 7) * PGS + ro_; const bf16* qp_ = P + (size_t)(qcol >> 7) * PGS + ro_; \
        _Pragma("unroll") for (int j = 0; j < 8; ++j) { gw_[j] = *(const unsigned*)(gp_ + (8 * th + j) * 128); gw_[8 + j] = *(const unsigned*)(gp_ + (8 - 8 * th + j) * 128); } \
        if (KIND == 0) { _Pragma("unroll") for (int j = 0; j < 8; ++j) kw_[j] = *(const unsigned*)(kp_ + (8 * th + j) * 128); } \
        if (PASS == 1) { _Pragma("unroll") for (int j = 0; j < 8; ++j) qw_[j] = *(const unsigned*)(qp_ + (8 * th + j) * 128); } \
        _Pragma("unroll") for (int i = 0; i < NVP; ++i) { const int p = tid + 512 * i, r = p / (DV / 8), c8 = p % (DV / 8); vv[i] = *(const u32x4*)(P + (size_t)((vcol >> 7) + (c8 >> 4)) * PGS + (size_t)(t0 + (mc_) * 64 + r) * 128 + 8 * (c8 & 15)); } } while (0)
    if (!(dry && (PROBE_SUB & 16))) MX_LOADS(0);
    float lt0 = 0.f, lt1 = 0.f;
    for (int mc = 0; mc < NMC; ++mc) {
        const int tb = t0 + mc * 64;
        if (!(dry && (PROBE_SUB & 2))) {
#pragma unroll
            for (int i = 0; i < NVP; ++i) { const int p = tid + 512 * i, r = p / (DV / 8), c8 = p % (DV / 8); *(LAS u32x4*)(L + OFF_V + r * VRS + c8 * 16) = vv[i]; }
            float go0[8], go1[8], k0[8], k1[8];
            float ot0 = 0.f, ot1 = 0.f, ow0 = 0.f, ow1 = 0.f;
#pragma unroll
            for (int j = 0; j < 8; ++j) { const f16x2 gh = __builtin_bit_cast(f16x2, gw_[j]), gx = __builtin_bit_cast(f16x2, gw_[8 + j]); go0[j] = (float)gh.x; go1[j] = (float)gh.y;
                ow0 += go0[j]; ow1 += go1[j]; ot0 += (float)gx.x; ot1 += (float)gx.y;
                if (KIND == 0) { k0[j] = bflo(kw_[j]); k1[j] = bfhi(kw_[j]); } else { k0[j] = 1.f - __builtin_amdgcn_exp2f(go0[j]); k1[j] = 1.f - __builtin_amdgcn_exp2f(go1[j]); } }
            const float lo0 = th ? ot0 : 0.f, lo1 = th ? ot1 : 0.f, hi0 = th ? 0.f : ot0, hi1 = th ? 0.f : ot1;
            const int row0 = 16 * ca + 8 * th;
            if (PASS == 1) {
                float r0 = lo0, r1 = lo1;
#pragma unroll
                for (int j = 0; j < 8; ++j) { r0 += go0[j]; r1 += go1[j];
                    const float q0 = bflo(qw_[j]) * __builtin_amdgcn_exp2f(r0), q1 = bfhi(qw_[j]) * __builtin_amdgcn_exp2f(r1);
                    const float kh0 = k0[j] * __builtin_amdgcn_exp2f(fminf(-r0, 115.f)), kh1 = k1[j] * __builtin_amdgcn_exp2f(fminf(-r1, 115.f));
                    *(LAS unsigned*)(L + OFF_Q + (row0 + j) * RSB + lane * 4) = pk2(q0, q1);
                    *(LAS unsigned*)(L + OFF_K + (row0 + j) * RSB + lane * 4) = pk2(kh0, kh1); }
            }
            float s0 = hi0, s1 = hi1;
#pragma unroll
            for (int j = 7; j >= 0; --j) { *(LAS unsigned*)(L + OFF_K2 + (row0 + j) * RSB + lane * 4) = pk2(k0[j] * __builtin_amdgcn_exp2f(s0), k1[j] * __builtin_amdgcn_exp2f(s1)); s0 += go0[j]; s1 += go1[j]; }
            const float tt0 = ow0 + ot0, tt1 = ow1 + ot1;
            if (th == 0) { f32x2 dd; dd.x = __builtin_amdgcn_exp2f(tt0); dd.y = __builtin_amdgcn_exp2f(tt1); *(LAS f32x2*)(L + OFF_DC + ca * 512 + lane * 8) = dd; }
            lt0 += tt0; lt1 += tt1;
        }
        LDS_WAIT(); __syncthreads();
        if (mc + 1 < NMC && !(dry && (PROBE_SUB & 16))) MX_LOADS(mc + 1);
        const int ei = tid >> 3, ve = tid & 7;
        bf16* orow = (bf16*)P + (size_t)(ocol >> 7) * PGS + (size_t)(tb + ei) * 128 + 8 * ve;
        u32x4 gt[NGP];
        if (PASS == 1) {
#pragma unroll
            for (int k = 0; k < NGP; ++k) gt[k] = *(const u32x4*)(orow + (size_t)(k >> 1) * PGS + 64 * (k & 1));
        }
        f32x4 oc[4][NVT];
        if (!(dry && (PROBE_SUB & 4))) {
#pragma unroll
        for (int c = 0; c < 4; ++c) {
            const int rb = 16 * c;
            bf16x8 vb[NVT];
#pragma unroll
            for (int vt = 0; vt < NVT; ++vt) { const s16x4 t4 = tr16(L + OFF_V + (rb + 4 * g4 + q_) * VRS + (16 * NVT * w + 16 * vt + 4 * p_) * 2); vb[vt] = (bf16x8){t4[0], t4[1], t4[2], t4[3], 0, 0, 0, 0}; }
            if (PASS == 1) {
                f32x4 at = (f32x4){0.f, 0.f, 0.f, 0.f};
#pragma unroll
                for (int ks = 0; ks < 4; ++ks) { const bf16x8 ka = *(const LAS bf16x8*)(L + OFF_K + (rb + li) * RSB + (32 * ks + 8 * g4) * 2); const bf16x8 qb = *(const LAS bf16x8*)(L + OFF_Q + (rb + li) * RSB + (32 * ks + 8 * g4) * 2);
                    at = __builtin_amdgcn_mfma_f32_16x16x32_bf16(ka, qb, at, 0, 0, 0); }
#pragma unroll
                for (int r = 0; r < 4; ++r) at[r] = (4 * g4 + r <= li) ? at[r] : 0.f;
                const bf16x8 pa = __builtin_bit_cast(bf16x8, (u32x4){pk2(at[0], at[1]), pk2(at[2], at[3]), 0u, 0u});
                f32x4 o[NVT];
#pragma unroll
                for (int vt = 0; vt < NVT; ++vt) o[vt] = __builtin_amdgcn_mfma_f32_16x16x32_bf16(pa, vb[vt], (f32x4){0.f, 0.f, 0.f, 0.f}, 0, 0, 0);
#pragma unroll
                for (int ks = 0; ks < 4; ++ks) {
                    const u32x2 qa0 = *(const LAS u32x2*)(L + OFF_Q + (rb + li) * RSB + (32 * ks + 4 * g4) * 2), qa1 = *(const LAS u32x2*)(L + OFF_Q + (rb + li) * RSB + (32 * ks + 16 + 4 * g4) * 2);
                    const bf16x8 qa = __builtin_bit_cast(bf16x8, (u32x4){qa0.x, qa0.y, qa1.x, qa1.y});
#pragma unroll
                    for (int vt = 0; vt < NVT; ++vt) {
                        const bf16x8 sb = __builtin_bit_cast(bf16x8, (u32x4){pk2(S[2 * ks][vt][0], S[2 * ks][vt][1]), pk2(S[2 * ks][vt][2], S[2 * ks][vt][3]), pk2(S[2 * ks + 1][vt][0], S[2 * ks + 1][vt][1]), pk2(S[2 * ks + 1][vt][2], S[2 * ks + 1][vt][3])});
                        o[vt] = __builtin_amdgcn_mfma_f32_16x16x32_bf16(qa, sb, o[vt], 0, 0, 0); } }
#pragma unroll
                for (int vt = 0; vt < NVT; ++vt) oc[c][vt] = o[vt];
            }
#pragma unroll
            for (int dt = 0; dt < 8; ++dt) { const s16x4 t4 = tr16(L + OFF_K2 + (rb + 4 * g4 + q_) * RSB + (16 * dt + 4 * p_) * 2); const bf16x8 ka = (bf16x8){t4[0], t4[1], t4[2], t4[3], 0, 0, 0, 0};
                const f32x4 dv = *(const LAS f32x4*)(L + OFF_DC + c * 512 + (16 * dt + 4 * g4) * 4);
#pragma unroll
                for (int vt = 0; vt < NVT; ++vt) S[dt][vt] = __builtin_amdgcn_mfma_f32_16x16x32_bf16(ka, vb[vt], S[dt][vt] * dv, 0, 0, 0); }
        }
        }
        LDS_WAIT(); __syncthreads();
        if (PASS == 1 && !(dry && (PROBE_SUB & 12))) {
            LAS float* Os = (LAS float*)L;
#pragma unroll
            for (int c = 0; c < 4; ++c)
#pragma unroll
                for (int vt = 0; vt < NVT; ++vt)
#pragma unroll
                    for (int r = 0; r < 4; ++r) Os[(16 * c + 4 * g4 + r) * OSS + 16 * NVT * w + 16 * vt + li] = oc[c][vt][r];
            LDS_WAIT(); __syncthreads();
            f32x4 ov[2 * NGP]; float ss = 0.f;
#pragma unroll
            for (int k = 0; k < NGP; ++k) { ov[2 * k] = *(const LAS f32x4*)(Os + ei * OSS + 64 * k + 8 * ve); ov[2 * k + 1] = *(const LAS f32x4*)(Os + ei * OSS + 64 * k + 8 * ve + 4);
                ss += (ov[2 * k].x * ov[2 * k].x + ov[2 * k].y * ov[2 * k].y) + (ov[2 * k].z * ov[2 * k].z + ov[2 * k].w * ov[2 * k].w) + (ov[2 * k + 1].x * ov[2 * k + 1].x + ov[2 * k + 1].y * ov[2 * k + 1].y) + (ov[2 * k + 1].z * ov[2 * k + 1].z + ov[2 * k + 1].w * ov[2 * k + 1].w); }
            LDS_WAIT(); __syncthreads();
            ss += __shfl_xor(ss, 1); ss += __shfl_xor(ss, 2); ss += __shfl_xor(ss, 4);
            const float rstd = __builtin_amdgcn_rsqf(ss * (1.f / DV) + NORM_EPS);
#pragma unroll
            for (int k = 0; k < NGP; ++k) { const f32x4 w0 = *(const f32x4*)(nw + 64 * k + 8 * ve), w1 = *(const f32x4*)(nw + 64 * k + 8 * ve + 4); const f32x4 a0 = ov[2 * k], a1 = ov[2 * k + 1]; const u32x4 gg = gt[k];
                u32x4 wv; wv.x = pk2(a0.x * rstd * w0.x * bflo(gg.x), a0.y * rstd * w0.y * bfhi(gg.x)); wv.y = pk2(a0.z * rstd * w0.z * bflo(gg.y), a0.w * rstd * w0.w * bfhi(gg.y));
                wv.z = pk2(a1.x * rstd * w1.x * bflo(gg.z), a1.y * rstd * w1.y * bfhi(gg.z)); wv.w = pk2(a1.z * rstd * w1.z * bflo(gg.w), a1.w * rstd * w1.w * bfhi(gg.w));
                if (!dry) *(u32x4*)(orow + (size_t)(k >> 1) * PGS + 64 * (k & 1)) = wv; }
        }
    }
#undef MX_LOADS
    if (PASS == 0) {
        float* sp = SEND + (size_t)(w * 8 * NVT) * 256 + lane * 4;
#pragma unroll
        for (int dt = 0; dt < 8; ++dt)
#pragma unroll
            for (int vt = 0; vt < NVT; ++vt) *(f32x4*)(sp + (dt * NVT + vt) * 256) = S[dt][vt];
        LAS float* LT = (LAS float*)(L + OFF_DC);
        if (th == 0) { f32x2 lt; lt.x = lt0; lt.y = lt1; *(LAS f32x2*)(L + OFF_DC + ca * 512 + lane * 8) = lt; }
        LDS_WAIT(); __syncthreads();
        if (tid < 128) DTOT[tid] = __builtin_amdgcn_exp2f(LT[tid] + LT[128 + tid] + LT[256 + tid] + LT[384 + tid]);
        LDS_WAIT(); __syncthreads();
    }
}
}

namespace xa {
constexpr int RSB = 272;
constexpr int OFF_KX = 0, OFF_VX = 256 * RSB;
static_assert(2 * 256 * RSB <= MISC_OFF, "xattn LDS map");
__device__ __forceinline__ void xa_unit(const Frame& F, const Args& a, int x, int layer, bool dry) {
    const int tid = fresh_tid(F.wave);
    const int lane = tid & 63, wid = F.wave, li = lane & 15, g4 = lane >> 4, q_ = li >> 2, p_ = li & 3;
    const int b = x >> 5, h = (x >> 3) & 3, tr = x & 7, t0 = b * SEQ + tr * 512 + wid * 64;
    LAS unsigned char* L = F.lds;
    bf16* P = (bf16*)(a.ws + WS_P); const bf16* MKV = (const bf16*)(a.ws + WS_MKV);
    const float* nw = a.xattn_nw + layer * 128;
#pragma unroll
    for (int i = 0; i < 8; ++i) { const int p = tid + 512 * i, r = p >> 4, c8 = p & 15; const bf16* src = MKV + (size_t)(b * MEML + r) * 2048 + layer * 1024 + h * 128 + 8 * c8;
        const u32x4 kk = *(const u32x4*)src, vv = *(const u32x4*)(src + 512);
        *(LAS u32x4*)(L + OFF_KX + r * RSB + c8 * 16) = kk; *(LAS u32x4*)(L + OFF_VX + r * RSB + c8 * 16) = vv; }
    LDS_WAIT(); __syncthreads();
    for (int it = 0; it < 4; ++it) {
        const int tb = t0 + 16 * it;
        unsigned kxo = OFF_KX, vxo = OFF_VX; asm volatile("" : "+v"(kxo), "+v"(vxo));
        bf16x8 qb[4];
#pragma unroll
        for (int ks = 0; ks < 4; ++ks) qb[ks] = *(const bf16x8*)(P + pgo(C_XQ + h * 128, tb + li) + 32 * ks + 8 * g4);
        f32x4 s[16];
#pragma unroll
        for (int mt = 0; mt < 16; ++mt) { s[mt] = (f32x4){0.f, 0.f, 0.f, 0.f};
#pragma unroll
            for (int ks = 0; ks < 4; ++ks) { const bf16x8 ka = *(const LAS bf16x8*)(L + kxo + (16 * mt + li) * RSB + (32 * ks + 8 * g4) * 2); s[mt] = __builtin_amdgcn_mfma_f32_16x16x32_bf16(ka, qb[ks], s[mt], 0, 0, 0); } }
        float mxv = s[0][0];
#pragma unroll
        for (int mt = 0; mt < 16; ++mt)
#pragma unroll
            for (int r = 0; r < 4; ++r) mxv = fmaxf(mxv, s[mt][r]);
        mxv = fmaxf(mxv, __shfl_xor(mxv, 16)); mxv = fmaxf(mxv, __shfl_xor(mxv, 32));
        float lsum = 0.f;
#pragma unroll
        for (int mt = 0; mt < 16; ++mt)
#pragma unroll
            for (int r = 0; r < 4; ++r) { s[mt][r] = fexp(s[mt][r] - mxv); lsum += s[mt][r]; }
        lsum += __shfl_xor(lsum, 16); lsum += __shfl_xor(lsum, 32);
        f32x4 o[8];
#pragma unroll
        for (int vt = 0; vt < 8; ++vt) o[vt] = (f32x4){0.f, 0.f, 0.f, 0.f};
#pragma unroll
        for (int k2 = 0; k2 < 8; ++k2) {
            const bf16x8 pa = __builtin_bit_cast(bf16x8, (u32x4){pk2(s[2 * k2][0], s[2 * k2][1]), pk2(s[2 * k2][2], s[2 * k2][3]), pk2(s[2 * k2 + 1][0], s[2 * k2 + 1][1]), pk2(s[2 * k2 + 1][2], s[2 * k2 + 1][3])});
#pragma unroll
            for (int vt = 0; vt < 8; ++vt) { const s16x4 t0_ = tr16(L + vxo + (32 * k2 + 4 * g4 + q_) * RSB + (16 * vt + 4 * p_) * 2), t1_ = tr16(L + vxo + (32 * k2 + 16 + 4 * g4 + q_) * RSB + (16 * vt + 4 * p_) * 2);
                const bf16x8 vb = (bf16x8){t0_[0], t0_[1], t0_[2], t0_[3], t1_[0], t1_[1], t1_[2], t1_[3]};
                o[vt] = __builtin_amdgcn_mfma_f32_16x16x32_bf16(pa, vb, o[vt], 0, 0, 0); } }
        float ssq[4];
#pragma unroll
        for (int r = 0; r < 4; ++r) { const float linv = 1.0f / __shfl(lsum, 4 * g4 + r); float ss = 0.f;
#pragma unroll
            for (int vt = 0; vt < 8; ++vt) { o[vt][r] *= linv; ss += o[vt][r] * o[vt][r]; }
            ss += __shfl_xor(ss, 1); ss += __shfl_xor(ss, 2); ss += __shfl_xor(ss, 4); ss += __shfl_xor(ss, 8); ssq[r] = ss; }
#pragma unroll
        for (int r = 0; r < 4; ++r) { const float rstd = 1.0f / sqrtf(ssq[r] * (1.f / 128.f) + NORM_EPS); bf16* orow = P + pgo(C_SG + 1536 + h * 128, tb + 4 * g4 + r) + li;
#pragma unroll
            for (int vt = 0; vt < 8; ++vt) { const float gate = __builtin_bit_cast(float, (unsigned)orow[16 * vt] << 16); const bf16 ov_ = (bf16)f2bf(o[vt][r] * rstd * nw[16 * vt + li] * gate); if (!dry) orow[16 * vt] = ov_; } }
    }
    LDS_WAIT(); __syncthreads();
}
}

__device__ __forceinline__ int next_item(const Frame& F, unsigned* head) {
    if (F.wave == 0 && lane_id() == 0) F.MISC[4] = __hip_atomic_fetch_add(head, 1u, RLX_AGENT);
    __syncthreads();
    const int it = (int)F.MISC[4];
    __syncthreads();
    return it;
}

constexpr int N_PHASES = 10;
__global__ void __launch_bounds__(512, 2) mega(Args args) {
    extern __shared__ __attribute__((aligned(16))) unsigned char lds_raw[];
    Frame F;
    F.lds = (LAS unsigned char*)lds_raw; F.MISC = (volatile LAS unsigned*)(F.lds + MISC_OFF);
    F.wave = __builtin_amdgcn_readfirstlane(threadIdx.x >> 6);
    F.G = gridDim.x; { const int bx = blockIdx.x; F.vcu = (F.G % 8 == 0) ? (bx % 8) * (F.G / 8) + bx / 8 : bx; }
    F.ctl = (unsigned*)(args.ws + WS_CTL);
    if (threadIdx.x < 16) F.MISC[threadIdx.x] = 0u;
    __syncthreads();
    XcdBarrier bar; bar.bar = F.ctl + CW_BAR; bar.x = 0; bar.st = nullptr; bar.wave = F.wave;
    if (!MK_PER_PHASE) bar = xcd_barrier_post(F.ctl + CW_BAR, F.MISC + 8, F.wave);
    const int lo = args.ph_lo, hi = args.ph_hi;
#define IN(k) (lo <= (k) && (k) < hi)
#define SEAM(k) do { if (IN(k) && IN((k) + 1)) xcd_barrier(bar); } while (0)
#define LAUNDER(la) Args la = args; asm volatile("" : "+s"(la.ws), "+s"(la.out)); Frame Fp = F; int bid = blockIdx.x; asm volatile("" : "+s"(Fp.vcu), "+s"(Fp.G), "+s"(Fp.wave), "+s"(bid))

    if (IN(0)) { LAUNDER(la); prep_w1(Fp, la, 0); prep_w2(Fp, la, 0); prep_wkv(Fp, la); prep_x(Fp, la);
        if (PROBE_REP == 0) { xcd_barrier(bar); prep_w1(Fp, la, 0); prep_w2(Fp, la, 0); prep_wkv(Fp, la); prep_x(Fp, la); } }
    SEAM(0);
    for (int layer = 0; layer < DEPTH; ++layer) {
        const int pb = 1 + 4 * layer;
        if (IN(pb)) { LAUNDER(la);
            if (layer == 0) {
                typedef pg8::Gemm<MROWS, 2048, D, D, D> GM; typedef pg8::StaticOrder<MROWS, 2048> SM;
                GM g{(const bf16*)((unsigned char*)la.out + DO_MEMB), (const bf16*)((unsigned char*)la.out + DO_WKVT)};
                SM S; S.init(Fp.G, bid);
                EpiMem E{(bf16*)(la.ws + WS_MKV), (const float*)((unsigned char*)la.out + DO_RSTDM)};
                pg8::gemm_phase<EpiMem, SM, GM, true, true>(Fp.lds, g, S, E, Fp.wave);
            }
            typedef pg8::Gemm<T, NP, D, D, D> G1; typedef pg8::StaticOrder<T, NP> S1;
            G1 g{(const bf16*)(la.ws + WS_XB), (const bf16*)(la.ws + WS_W1T)};
            S1 S; S.init(Fp.G, bid);
            EpiProj E{(bf16*)(la.ws + WS_P), layer == 0 ? (const float*)((unsigned char*)la.out + DO_SSQ0) : (const float*)(la.ws + WS_SSQ1), la.gla_b + layer * 512, (const float*)(la.ws + WS_HTAB) + layer * 1024};
            pg8::gemm_phase<EpiProj, S1, G1, true, true>(Fp.lds, g, S, E, Fp.wave);
            if (PROBE_REP == pb) { xcd_barrier(bar); pg8::gemm_phase<EpiProj, S1, G1, true, true>(Fp.lds, g, S, E, Fp.wave); }
        }
        SEAM(pb);
        if (IN(pb + 1)) { LAUNDER(la);
            if (layer == 0) prep_w1(Fp, la, 1); else prep_w2(Fp, la, 1);
            __syncthreads();
            const int reps = (PROBE_REP == pb + 1) ? 2 : 1;
            for (int rep = 0; rep < reps; ++rep) { const bool dry = (rep + 1 < reps) && la.probe;
                unsigned* head = Fp.ctl + CW_QUEUE + 64 * (2 * layer) + 512 * rep;
                for (;;) { const int it = next_item(Fp, head); if (it >= N_MIX_UNITS + N_XA_UNITS) break;
                    const int grp = it / 3, rr = it - 3 * grp;
                    if (rr == 2) { if (!(dry && (PROBE_SUB & 64))) xa::xa_unit(Fp, la, grp, layer, dry); }
                    else if (!(dry && (PROBE_SUB & 128))) { const int mu = 2 * grp + rr; if (mu < 256) mx::mix_unit<0, 0>(Fp, la, mu, layer, dry); else mx::mix_unit<0, 1>(Fp, la, mu, layer, dry); } }
                if (rep + 1 < reps) xcd_barrier(bar); }
        }
        SEAM(pb + 1);
        if (IN(pb + 2)) { LAUNDER(la);
            const int reps = (PROBE_REP == pb + 2) ? 2 : 1;
            for (int rep = 0; rep < reps; ++rep) { const bool dry = (rep + 1 < reps) && la.probe;
                unsigned* head = Fp.ctl + CW_QUEUE + 64 * (2 * layer + 1) + 512 * rep;
                for (;;) { const int it = next_item(Fp, head); if (it >= N_MIX_UNITS) break; if (it < 256) mx::mix_unit<1, 0>(Fp, la, it, layer, dry); else mx::mix_unit<1, 1>(Fp, la, it, layer, dry); }
                if (rep + 1 < reps) xcd_barrier(bar); }
        }
        SEAM(pb + 2);
        if (IN(pb + 3)) { LAUNDER(la);
            typedef pg8::Gemm<T, D, DMIX, 128, DMIX, PGS * 2> G2; typedef pg8::StaticOrder<T, D> S2;
            G2 g{(const bf16*)(la.ws + WS_P) + pgo(C_SG, 0), (const bf16*)(la.ws + WS_W2T)};
            S2 S; S.init(Fp.G, bid);
            EpiRes E{layer == 0 ? la.x : (const float*)la.out, la.out, (bf16*)(la.ws + WS_XB), (float*)(la.ws + (layer == 0 ? WS_SSQ1 : WS_SSQ2))};
            pg8::gemm_phase<EpiRes, S2, G2, true, true>(Fp.lds, g, S, E, Fp.wave);
            if (PROBE_REP == pb + 3 && layer == 0) { xcd_barrier(bar); pg8::gemm_phase<EpiRes, S2, G2, true, true>(Fp.lds, g, S, E, Fp.wave); }
        }
        SEAM(pb + 3);
    }
    if (IN(9)) { LAUNDER(la);
        const int lane_ = fresh_tid(Fp.wave) & 63;
        const int gw = Fp.vcu * 8 + Fp.wave, NGW = Fp.G * 8; const float* ssq = (const float*)(la.ws + WS_SSQ2);
        f32x4 fw[4];
#pragma unroll
        for (int j = 0; j < 4; ++j) fw[j] = *((const f32x4*)la.final_nw + lane_ + 64 * j);
        for (int m = 4 * gw; m < T; m += 4 * NGW) { f32x4 v[4][4]; float sq[4];
#pragma unroll
            for (int r = 0; r < 4; ++r) { sq[r] = lane_ < 16 ? ssq[(size_t)(m + r) * 16 + lane_] : 0.f;
#pragma unroll
                for (int j = 0; j < 4; ++j) v[r][j] = *((const f32x4*)(la.out + (size_t)(m + r) * D) + lane_ + 64 * j); }
#pragma unroll
            for (int r = 0; r < 4; ++r) { const float rstd = 1.0f / sqrtf(wave_sum(sq[r]) * (1.f / D) + NORM_EPS);
#pragma unroll
                for (int j = 0; j < 4; ++j) *((f32x4*)(la.out + (size_t)(m + r) * D) + lane_ + 64 * j) = v[r][j] * rstd * fw[j]; } }
    }
#undef IN
#undef SEAM
}

extern "C" void kernel_launch(void* const* d_in, const int* in_sizes, int n_in, void* d_out, int out_size, void* d_ws, size_t ws_size, hipStream_t stream) {
    static int grid = 0;
    if (grid == 0) {
        if (n_in != 14 || in_sizes[0] != T * D || out_size != T * D || ws_size < WS_END) { fprintf(stderr, "kernel_launch: unexpected shapes (n_in %d, in0 %d, out %d, ws %zu)\n", n_in, n_in > 0 ? in_sizes[0] : -1, out_size, ws_size); grid = -1; return; }
        int dev = 0, cus = 0, per_cu = 0;
        if (hipGetDevice(&dev) != hipSuccess || hipDeviceGetAttribute(&cus, hipDeviceAttributeMultiprocessorCount, dev) != hipSuccess) { grid = -1; return; }
        if (hipFuncSetAttribute((const void*)mega, hipFuncAttributeMaxDynamicSharedMemorySize, LDS_BYTES) != hipSuccess) { fprintf(stderr, "kernel_launch: hipFuncSetAttribute failed\n"); grid = -1; return; }
        if (hipOccupancyMaxActiveBlocksPerMultiprocessor(&per_cu, (const void*)mega, 512, LDS_BYTES) != hipSuccess || per_cu < 1) { fprintf(stderr, "kernel_launch: occupancy query says %d blocks per CU\n", per_cu); grid = -1; (void)hipGetLastError(); return; }
        grid = cus;
    }
    if (grid < 0) return;
    (void)hipMemsetAsync((char*)d_ws + WS_CTL, 0, CTL_ZERO_BYTES, stream);
    Args a{};
    a.x = (const float*)d_in[0]; a.mem = (const float*)d_in[1]; a.norm_w = (const float*)d_in[2]; a.w_in = (const float*)d_in[3]; a.gla_wup = (const float*)d_in[4]; a.gla_b = (const float*)d_in[5];
    a.gla_nw = (const float*)d_in[6]; a.hgrn_lb = (const float*)d_in[7]; a.hgrn_nw = (const float*)d_in[8]; a.mem_nw = (const float*)d_in[9]; a.w_mkv = (const float*)d_in[10]; a.xattn_nw = (const float*)d_in[11];
    a.w_out = (const float*)d_in[12]; a.final_nw = (const float*)d_in[13]; a.out = (float*)d_out; a.ws = (unsigned char*)d_ws;
#if MK_PER_PHASE
    for (int p = 0; p < N_PHASES; ++p) { a.ph_lo = p; a.ph_hi = p + 1; hipLaunchKernelGGL(mega, dim3(grid), dim3(512), LDS_BYTES, stream, a); }
#else
    a.ph_lo = 0; a.ph_hi = N_PHASES; a.probe = 1;
    void* kargs[] = {&a};
    hipError_t e = hipLaunchCooperativeKernel((const void*)mega, dim3(grid), dim3(512), kargs, LDS_BYTES, stream);
    if (e != hipSuccess) fprintf(stderr, "kernel_launch: cooperative launch failed: %s (grid %d)\n", hipGetErrorString(e), grid);
#endif
}
```

```cpp
#include <hip/hip_runtime.h>
#include <cstdio>
#include <cstdint>

#ifndef MK_PER_PHASE
#define MK_PER_PHASE 0
#endif
#ifndef PROBE_SUB
#define PROBE_SUB 0
#endif
#ifndef PROBE_REP
#define PROBE_REP -1
#endif

#define LAS __attribute__((address_space(3)))
#define GAS __attribute__((address_space(1)))
__device__ __forceinline__ int lane_id() { int l; asm volatile("v_mbcnt_lo_u32_b32 %0, -1, 0\n\tv_mbcnt_hi_u32_b32 %0, -1, %0" : "=v"(l)); return l; }
__device__ __forceinline__ int fresh_tid(int wave) { int t = wave * 64 + lane_id(); asm volatile("" : "+v"(t)); return t; }

namespace pg8 {
typedef unsigned short bf16_t;
typedef short bf16x8 __attribute__((ext_vector_type(8)));
typedef float f32x4 __attribute__((ext_vector_type(4)));
typedef unsigned u32x4 __attribute__((ext_vector_type(4)));
typedef unsigned u32x2 __attribute__((ext_vector_type(2)));
constexpr int BM = 256, BK = 64, HALF = 128, HTB = HALF * BK * 2, STAGE_BYTES = 8 * HTB, NXCD = 8, WGM = 8;

__host__ __device__ __forceinline__ int lds_byte(int r, int c) { const int st = (r >> 4) * 2 + (c >> 5), rr = r & 15, cc = c & 31, ob = rr * 64 + cc * 2; return st * 1024 + (ob ^ (((ob >> 9) & 1) << 5)); }
__host__ __device__ __forceinline__ void stage_rc(int b, int& R, int& C) { const int st = b / 1024, sb = b % 1024, swz = sb ^ (((sb >> 9) & 1) << 5); R = (st >> 1) * 16 + swz / 64; C = (st & 1) * 32 + (swz % 64) / 2; }
__host__ __device__ __forceinline__ int perm32(int rho) { const int n = rho >> 4, i = rho & 15; return 8 * (i >> 2) + 4 * n + (i & 3); }

struct Unit { int pm, pn, idx; };
template <int M_, int N_, int K_, int LDA_, int LDB_, size_t K2A_ = 256> struct Gemm { const bf16_t* A; const bf16_t* Bt; static constexpr int M = M_, N = N_, K = K_, lda = LDA_, ldb = LDB_; static constexpr size_t k2A = K2A_; };

template <int M_, int N_> struct StaticOrder {
    static constexpr int nM = M_ / BM, nN = N_ / BM, nwg = nM * nN;
    int G, c;
    __host__ __device__ void init(int G_, int c_) { G = G_; c = c_; }
    __host__ __device__ bool next(int i, Unit& u) const {
        const long L = (long)i * G + c; if (L >= nwg) return false;
        int wgid = (int)L; { const int q = nwg / NXCD, r = nwg % NXCD, xcd = wgid % NXCD, off = wgid / NXCD; wgid = (xcd < r ? xcd * (q + 1) : r * (q + 1) + (xcd - r) * q) + off; }
        const int nig = WGM * nN, gid = wgid / nig, fm = gid * WGM, gsz = (nM - fm) < WGM ? (nM - fm) : WGM;
        u.pm = fm + ((wgid % nig) % gsz); u.pn = (wgid % nig) / gsz; u.idx = i; return true;
    }
    __device__ __forceinline__ void a_ready(const Unit&) const {}
    __device__ __forceinline__ void done(const Unit&) const {}
};

template <class Epi, class Sched, class GemmT, bool ALIGN_EPI = false, bool SP2 = false>
__device__ __forceinline__ void gemm_phase(LAS unsigned char* lds, const GemmT g, const Sched& S, const Epi& E, int wave_) {
    const int tid = fresh_tid(wave_);
    const int wid = wave_, lane = tid & 63, wr = wid >> 2, wc = wid & 3, fr = lane & 15, fq = lane >> 4;
    constexpr int K = GemmT::K, nt = K / BK;
    unsigned voffA[2], voffB[2];
#pragma unroll
    for (int i = 0; i < 2; ++i) { int R, C; stage_rc(tid * 16 + i * 8192, R, C); const int Rb = Epi::PERM ? ((R & ~31) + perm32(R & 31)) : R;
        voffA[i] = (unsigned)(R * GemmT::lda + C) * 2u; voffB[i] = (unsigned)(Rb * GemmT::ldb + C) * 2u; }
    constexpr size_t kstep = (size_t)(BK * 2);
    constexpr size_t hstepA = (size_t)HALF * GemmT::lda * 2, hstepB = (size_t)HALF * GemmT::ldb * 2;
    constexpr size_t tstepA = 2 * hstepA, tstepB = 2 * hstepB;
    const unsigned ldsw = (unsigned)wid * 1024u;
    const int aoff = lds_byte(wr * 64 + fr, fq * 8), boff = lds_byte(wc * 32 + fr, fq * 8);
#define PG8_SA(b, h) (((b) * 2 + (h)) * HTB)
#define PG8_SB(b, h) ((4 + (b) * 2 + (h)) * HTB)
#define PG8_STAGE(bufoff, gbase, voff) do { _Pragma("unroll") for (int _i = 0; _i < 2; ++_i) \
        __builtin_amdgcn_global_load_lds((const unsigned*)((const char*)(gbase) + (voff)[_i]), (LAS unsigned*)(lds + (bufoff) + ldsw + _i * 8192), 16, 0, 0); } while (0)
#define PG8_LDA(dst, b, h) do { _Pragma("unroll") for (int m = 0; m < 4; ++m) _Pragma("unroll") for (int k = 0; k < 2; ++k) dst[m][k] = *(const LAS bf16x8*)(lds + PG8_SA(b, h) + aoff + m * 2048 + k * 1024); } while (0)
#define PG8_LDB(dst, b, h) do { _Pragma("unroll") for (int n = 0; n < 2; ++n) _Pragma("unroll") for (int k = 0; k < 2; ++k) dst[n][k] = *(const LAS bf16x8*)(lds + PG8_SB(b, h) + boff + n * 2048 + k * 1024); } while (0)
#define PG8_MMA(ai, bj, At, Bt) do { __builtin_amdgcn_s_setprio(1); _Pragma("unroll") for (int m = 0; m < 4; ++m) _Pragma("unroll") for (int n = 0; n < 2; ++n) _Pragma("unroll") for (int k = 0; k < 2; ++k) \
        acc[ai][bj][m][n] = __builtin_amdgcn_mfma_f32_16x16x32_bf16(Bt[n][k], At[m][k], acc[ai][bj][m][n], 0, 0, 0); __builtin_amdgcn_s_setprio(0); } while (0)
#define PG8_WAIT_V(n) asm volatile("s_waitcnt vmcnt(" #n ")" ::: "memory")
#define PG8_WAIT_L(n) asm volatile("s_waitcnt lgkmcnt(" #n ")" ::: "memory")
#define PG8_BAR __builtin_amdgcn_s_barrier()
#define PG8_SCHED __builtin_amdgcn_sched_barrier(0)
    Unit cur, nxt; int ui = 0;
    if (!S.next(0, cur)) return;
    f32x4 acc[2][2][4][2];
#pragma unroll
    for (int a = 0; a < 2; ++a)
#pragma unroll
        for (int b = 0; b < 2; ++b)
#pragma unroll
            for (int m = 0; m < 4; ++m)
#pragma unroll
                for (int n = 0; n < 2; ++n) acc[a][b][m][n] = (f32x4){0.f, 0.f, 0.f, 0.f};
    bf16x8 At[4][2], B0[2][2], B1[2][2];
    const char* cA = (const char*)g.A + (size_t)cur.pm * tstepA; const char* cB = (const char*)g.Bt + (size_t)cur.pn * tstepB;
    S.a_ready(cur);
    if constexpr (SP2) {
        PG8_STAGE(PG8_SB(0, 0), cB, voffB); PG8_STAGE(PG8_SB(0, 1), cB + hstepB, voffB); PG8_STAGE(PG8_SA(0, 0), cA, voffA); PG8_STAGE(PG8_SA(0, 1), cA + hstepA, voffA);
        if (wr == 1) PG8_BAR;
        PG8_WAIT_V(2); PG8_BAR;
        PG8_STAGE(PG8_SB(1, 0), cB + kstep, voffB); PG8_STAGE(PG8_SA(1, 0), cA + kstep, voffA); PG8_STAGE(PG8_SB(1, 1), cB + hstepB + kstep, voffB);
        PG8_WAIT_V(6); PG8_BAR;
    } else {
        PG8_STAGE(PG8_SB(0, 0), cB, voffB); PG8_STAGE(PG8_SA(0, 0), cA, voffA); PG8_STAGE(PG8_SB(0, 1), cB + hstepB, voffB); PG8_STAGE(PG8_SA(0, 1), cA + hstepA, voffA);
        if (wr == 1) PG8_BAR;
        PG8_WAIT_V(4); PG8_BAR;
        PG8_STAGE(PG8_SB(1, 0), cB + kstep, voffB); PG8_STAGE(PG8_SA(1, 0), cA + kstep, voffA); PG8_STAGE(PG8_SB(1, 1), cB + hstepB + kstep, voffB);
        PG8_WAIT_V(6); PG8_BAR;
    }
    for (;;) {
        const bool has_next = S.next(ui + 1, nxt);
        const char* nA = has_next ? (const char*)g.A + (size_t)nxt.pm * tstepA : cA; const char* nB = has_next ? (const char*)g.Bt + (size_t)nxt.pn * tstepB : cB;
        for (int t = 0; t < nt; t += 2) {
            const bool last = (t == nt - 2);
            const char* a1 = cA + (size_t)(t >> 1) * GemmT::k2A + kstep;
            const char* a2 = last ? nA : cA + (size_t)((t >> 1) + 1) * GemmT::k2A; const char* b2 = last ? nB : cB + (size_t)(t + 2) * kstep;
            const char* a3 = a2 + kstep; const char* b3 = b2 + kstep;
            if (last && has_next) S.a_ready(nxt);
            if constexpr (SP2) {
            PG8_LDB(B0, 0, 0); PG8_LDB(B1, 0, 1); PG8_SCHED; PG8_LDA(At, 0, 0); PG8_STAGE(PG8_SA(1, 1), a1 + hstepA, voffA);
            PG8_WAIT_V(8); PG8_WAIT_L(0); PG8_BAR; PG8_MMA(0, 0, At, B0); PG8_MMA(0, 1, At, B1); PG8_BAR; PG8_SCHED;
            PG8_LDA(At, 0, 1); PG8_STAGE(PG8_SB(0, 0), b2, voffB); PG8_STAGE(PG8_SB(0, 1), b2 + hstepB, voffB); PG8_STAGE(PG8_SA(0, 0), a2, voffA);
            PG8_WAIT_V(8); PG8_WAIT_L(0); PG8_BAR; PG8_MMA(1, 0, At, B0); PG8_MMA(1, 1, At, B1); PG8_BAR; PG8_SCHED;
            PG8_LDB(B0, 1, 0); PG8_LDB(B1, 1, 1); PG8_SCHED; PG8_LDA(At, 1, 0); PG8_STAGE(PG8_SA(0, 1), a2 + hstepA, voffA);
            PG8_WAIT_V(8); PG8_WAIT_L(0); PG8_BAR; PG8_MMA(0, 0, At, B0); PG8_MMA(0, 1, At, B1); PG8_BAR; PG8_SCHED;
            PG8_LDA(At, 1, 1); PG8_STAGE(PG8_SB(1, 0), b3, voffB); PG8_STAGE(PG8_SB(1, 1), b3 + hstepB, voffB); PG8_STAGE(PG8_SA(1, 0), a3, voffA);
            PG8_WAIT_V(8); PG8_WAIT_L(0); PG8_BAR; PG8_MMA(1, 0, At, B0); PG8_MMA(1, 1, At, B1); PG8_BAR; PG8_SCHED;
            } else {
            PG8_LDB(B0, 0, 0); PG8_SCHED; PG8_LDA(At, 0, 0); PG8_STAGE(PG8_SA(1, 1), a1 + hstepA, voffA);
            PG8_WAIT_L(8); PG8_BAR; PG8_WAIT_L(0); PG8_MMA(0, 0, At, B0); PG8_BAR; PG8_SCHED;
            PG8_LDB(B1, 0, 1); PG8_STAGE(PG8_SB(0, 0), b2, voffB);
            PG8_BAR; PG8_WAIT_L(0); PG8_MMA(0, 1, At, B1); PG8_BAR;
            PG8_LDA(At, 0, 1); PG8_STAGE(PG8_SA(0, 0), a2, voffA);
            PG8_BAR; PG8_WAIT_L(0); PG8_MMA(1, 0, At, B0); PG8_BAR; PG8_SCHED;
            PG8_STAGE(PG8_SB(0, 1), b2 + hstepB, voffB);
            PG8_WAIT_V(6); PG8_BAR; PG8_MMA(1, 1, At, B1); PG8_BAR;
            PG8_LDB(B0, 1, 0); PG8_SCHED; PG8_LDA(At, 1, 0); PG8_STAGE(PG8_SA(0, 1), a2 + hstepA, voffA);
            PG8_WAIT_L(8); PG8_BAR; PG8_WAIT_L(0); PG8_MMA(0, 0, At, B0); PG8_BAR; PG8_SCHED;
            PG8_LDB(B1, 1, 1); PG8_STAGE(PG8_SB(1, 0), b3, voffB);
            PG8_BAR; PG8_WAIT_L(0); PG8_MMA(0, 1, At, B1); PG8_BAR;
            PG8_LDA(At, 1, 1); PG8_STAGE(PG8_SA(1, 0), a3, voffA);
            PG8_BAR; PG8_WAIT_L(0); PG8_MMA(1, 0, At, B0); PG8_BAR; PG8_SCHED;
            PG8_STAGE(PG8_SB(1, 1), b3 + hstepB, voffB);
            PG8_WAIT_V(6); PG8_BAR; PG8_MMA(1, 1, At, B1); PG8_BAR;
            }
        }
        if constexpr (ALIGN_EPI) { if (wr == 0) PG8_BAR; }
        E(acc, cur, wr, wc, fr, fq); S.done(cur);
        if (!has_next) break;
#pragma unroll
        for (int a = 0; a < 2; ++a)
#pragma unroll
            for (int b = 0; b < 2; ++b)
#pragma unroll
                for (int m = 0; m < 4; ++m)
#pragma unroll
                    for (int n = 0; n < 2; ++n) acc[a][b][m][n] = (f32x4){0.f, 0.f, 0.f, 0.f};
        cur = nxt; cA = nA; cB = nB; ++ui;
        if constexpr (ALIGN_EPI) { if (wr == 1) PG8_BAR; }
    }
    PG8_WAIT_V(0);
    if constexpr (!ALIGN_EPI) { if (wr == 0) PG8_BAR; }
    PG8_BAR;
#undef PG8_SA
#undef PG8_SB
#undef PG8_STAGE
#undef PG8_LDA
#undef PG8_LDB
#undef PG8_MMA
#undef PG8_WAIT_V
#undef PG8_WAIT_L
#undef PG8_BAR
#undef PG8_SCHED
}
}

typedef unsigned short bf16;
typedef short bf16x8 __attribute__((ext_vector_type(8)));
typedef short s16x4 __attribute__((ext_vector_type(4)));
typedef float f32x4 __attribute__((ext_vector_type(4)));
typedef float f32x2 __attribute__((ext_vector_type(2)));
typedef unsigned u32x4 __attribute__((ext_vector_type(4)));
typedef unsigned u32x2 __attribute__((ext_vector_type(2)));
typedef _Float16 f16x2 __attribute__((ext_vector_type(2)));
typedef __bf16 bf16x2_t __attribute__((ext_vector_type(2)));
typedef short v4i16_t __attribute__((ext_vector_type(4)));

constexpr int NB = 8, SEQ = 4096, T = NB * SEQ, D = 1024, DEPTH = 2, DINP = 6160, DMIX = 2048, MEML = 256, MROWS = NB * MEML;
constexpr int NP = 6656;
constexpr int LDP = 6656;
constexpr size_t PGS = (size_t)32768 * 128;
__host__ __device__ constexpr size_t pgo(int col, int t) { return (size_t)(col >> 7) * PGS + (size_t)t * 128 + (col & 127); }
constexpr int C_GQ = 0, C_GK = 512, C_GG = 1024, C_GV = 1536, C_HQ = 2560, C_HLF = 3072, C_HI = 3584, C_XQ = 4096, C_SG = 4608;
constexpr float NORM_EPS = 1e-6f;
constexpr int NSEG = 8, SEGLEN = 512, NMC = SEGLEN / 64;
constexpr int N_MIX_UNITS = 512;
constexpr int N_XA_UNITS = 256;

constexpr size_t MiB = 1u << 20;
constexpr size_t WS_CTL = 0, CTL_ZERO_BYTES = 1 * MiB;
constexpr size_t WS_SSQ1 = 1 * MiB, WS_SSQ2 = 3 * MiB;
constexpr size_t WS_MKV = 5 * MiB;
constexpr size_t WS_W1T = 13 * MiB;
constexpr size_t WS_W2T = 27 * MiB;
constexpr size_t WS_XB = 31 * MiB;
constexpr size_t WS_SEND = WS_XB, WS_DTOT = WS_XB + 48 * MiB;
constexpr size_t WS_P = 95 * MiB;
constexpr size_t WS_END = WS_P + (size_t)T * LDP * 2;
static_assert(WS_END <= 512 * MiB, "workspace map");
constexpr size_t DO_MEMB = 0, DO_WKVT = 4 * MiB, DO_SSQ0 = 8 * MiB, DO_RSTDM = 10 * MiB;
constexpr int CW_BAR = 4096;
constexpr int CW_QUEUE = 2048;
constexpr size_t WS_HTAB = 512 * 1024;
constexpr int RSTD_OFF = 131072;
constexpr int LDS_BYTES = 147456, MISC_OFF = LDS_BYTES - 64;
static_assert(RSTD_OFF + 15 * 1024 <= MISC_OFF, "rstd table");

#define LDS_WAIT() asm volatile("s_waitcnt lgkmcnt(0)" ::: "memory")
#define VM_WAIT() asm volatile("s_waitcnt vmcnt(0)" ::: "memory")
#define RLX_AGENT __ATOMIC_RELAXED, __HIP_MEMORY_SCOPE_AGENT
__device__ __forceinline__ unsigned f2bf(float f) { unsigned u = __builtin_bit_cast(unsigned, f); return (u + 0x7fffu + ((u >> 16) & 1u)) >> 16; }
__device__ __forceinline__ unsigned pk2(float lo, float hi) { f32x2 v = {lo, hi}; bf16x2_t b = __builtin_convertvector(v, bf16x2_t); return __builtin_bit_cast(unsigned, b); }
__device__ __forceinline__ unsigned pkh2(float lo, float hi) { f32x2 v = {lo, hi}; f16x2 h = __builtin_convertvector(v, f16x2); return __builtin_bit_cast(unsigned, h); }
__device__ __forceinline__ float bflo(unsigned w) { return __builtin_bit_cast(float, w << 16); }
__device__ __forceinline__ float bfhi(unsigned w) { return __builtin_bit_cast(float, w & 0xffff0000u); }
__device__ __forceinline__ float fexp(float x) { return __builtin_amdgcn_exp2f(x * 1.4426950408889634f); }
__device__ __forceinline__ float flog(float x) { return __builtin_amdgcn_logf(x) * 0.6931471805599453f; }
__device__ __forceinline__ float log_sigmoid(float z) { return fminf(z, 0.f) - flog(1.f + fexp(-fabsf(z))); }
__device__ __forceinline__ s16x4 tr16(const LAS unsigned char* p) { return __builtin_bit_cast(s16x4, __builtin_amdgcn_ds_read_tr16_b64_v4i16((LAS v4i16_t*)p)); }
__device__ __forceinline__ float wave_sum(float v) {
#pragma unroll
    for (int o = 1; o < 64; o <<= 1) v += __shfl_xor(v, o);
    return v;
}

#define XB_TMO      128
#define XB_XCNT(j)  (256  + 64 * (j))
#define XB_XSUB(j)  (1280 + 64 * (j))
#define XB_XGEN(j)  (2304 + 64 * (j))
#define XB_TOP      3328
#define XB_TOPGEN   3392
#define XCD_BAR_WORDS 3456
#define XB_SPIN_CAP (1u << 20)
__device__ __forceinline__ unsigned xb_ld(unsigned* p)              { return __hip_atomic_load(p, __ATOMIC_RELAXED, __HIP_MEMORY_SCOPE_AGENT); }
__device__ __forceinline__ unsigned xb_add(unsigned* p, unsigned v) { return __hip_atomic_fetch_add(p, v, __ATOMIC_RELAXED, __HIP_MEMORY_SCOPE_AGENT); }
__device__ __forceinline__ unsigned xb_xcc_id() { return (unsigned)__builtin_amdgcn_s_getreg((3 << 11) | 20) & 0xFu; }
#define XB_SPIN(cond, bar) do { unsigned _sp = 0; while (cond) { __builtin_amdgcn_s_sleep(1); \
    if ((++_sp & 255u) == 0u) { if (xb_ld(&(bar)[XB_TMO])) break; if (_sp > XB_SPIN_CAP) { atomicAdd(&(bar)[XB_TMO], 1u); break; } } } } while (0)
struct XcdBarrier { unsigned* bar; unsigned x; volatile LAS unsigned* st; int wave; };
__device__ __forceinline__ XcdBarrier xcd_barrier_post(unsigned* bar, volatile LAS unsigned* st, int wave) {
    XcdBarrier b; b.bar = bar; b.x = xb_xcc_id(); b.st = st; b.wave = wave;
    if (wave == 0 && lane_id() == 0) (void)xb_add(&bar[XB_XCNT(b.x)], 1u);
    return b;
}
__device__ __forceinline__ void xcd_barrier_complete(unsigned* bar, unsigned x, unsigned& nloc, unsigned& nx) {
    const unsigned G = gridDim.x * gridDim.y * gridDim.z;
    unsigned sum, cnt, mine, sp = 0u;
    for (;;) {
        sum = 0u; cnt = 0u; mine = 0u;
#pragma unroll 1
        for (unsigned j = 0; j < 16; ++j) { const unsigned c = xb_ld(&bar[XB_XCNT(j)]); sum += c; cnt += (c > 0u) ? 1u : 0u; mine = (j == x) ? c : mine; }
        if (sum == G) break;
        __builtin_amdgcn_s_sleep(1);
        if ((++sp & 255u) == 0u) { if (xb_ld(&bar[XB_TMO])) break; if (sp > XB_SPIN_CAP) { atomicAdd(&bar[XB_TMO], 1u); break; } }
    }
    nloc = mine > 0u ? mine : 1u; nx = cnt > 0u ? cnt : 1u;
}
__device__ __forceinline__ void xcd_barrier(const XcdBarrier& b) {
    asm volatile("s_waitcnt vmcnt(0)" ::: "memory");
    __syncthreads();
    if (b.wave == 0 && lane_id() == 0) {
        unsigned* bar = b.bar;
        __builtin_amdgcn_s_waitcnt(0);
        unsigned nloc = b.st[0], nx = b.st[1];
        if (nloc == 0u) { xcd_barrier_complete(bar, b.x, nloc, nx); b.st[0] = nloc; b.st[1] = nx; }
        const unsigned old = xb_add(&bar[XB_XSUB(b.x)], 1u);
        const unsigned gen = old / nloc;
        if (old + 1u == (gen + 1u) * nloc) {
            __builtin_amdgcn_fence(__ATOMIC_RELEASE, "agent");
            asm volatile("s_waitcnt vmcnt(0)" ::: "memory");
            const unsigned og = xb_add(&bar[XB_TOP], 1u);
            const unsigned tg = og / nx;
            if (og + 1u == (tg + 1u) * nx) xb_add(&bar[XB_TOPGEN], 1u);
            else XB_SPIN(xb_ld(&bar[XB_TOPGEN]) == tg, bar);
            __builtin_amdgcn_fence(__ATOMIC_ACQUIRE, "agent");
            xb_add(&bar[XB_XGEN(b.x)], 1u);
            asm volatile("s_waitcnt vmcnt(0)" ::: "memory");
        } else {
            XB_SPIN(xb_ld(&bar[XB_XGEN(b.x)]) == gen, bar);
            __builtin_amdgcn_fence(__ATOMIC_ACQUIRE, "agent");
            asm volatile("s_waitcnt vmcnt(0)" ::: "memory");
        }
    }
    __syncthreads();
}

struct Args {
    const float* x; const float* mem; const float* norm_w; const float* w_in; const float* gla_wup; const float* gla_b; const float* gla_nw; const float* hgrn_lb;
    const float* hgrn_nw; const float* mem_nw; const float* w_mkv; const float* xattn_nw; const float* w_out; const float* final_nw;
    float* out; unsigned char* ws; int ph_lo, ph_hi, probe, pad;
};
struct Frame {
    LAS unsigned char* lds; volatile LAS unsigned* MISC; unsigned* ctl;
    int wave, vcu, G;
};

__device__ __forceinline__ void tr_item(const float* W, int Nsrc, int srccol0, const float* kscale, float rscale, bf16* WT, int ldt, int dstrow0, int k0, LAS float* scr, int lane) {
    float wv_[32], ks_[32];
#pragma unroll
    for (int i = 0; i < 32; ++i) { const int kk = 2 * i + (lane >> 5); ks_[i] = kscale ? kscale[k0 + kk] : 1.f; wv_[i] = W[(size_t)(k0 + kk) * Nsrc + srccol0 + (lane & 31)]; }
#pragma unroll
    for (int i = 0; i < 32; ++i) { const int kk = 2 * i + (lane >> 5); scr[kk * 33 + (lane & 31)] = wv_[i] * ks_[i] * rscale; }
    LDS_WAIT(); asm volatile("" ::: "memory");
    const int c = lane & 7;
#pragma unroll
    for (int j = 0; j < 4; ++j) { const int n = (lane >> 3) + 8 * j; const LAS float* s = scr + (8 * c) * 33 + n;
        u32x4 o; o.x = pk2(s[0 * 33], s[1 * 33]); o.y = pk2(s[2 * 33], s[3 * 33]); o.z = pk2(s[4 * 33], s[5 * 33]); o.w = pk2(s[6 * 33], s[7 * 33]);
        *(u32x4*)(WT + (size_t)(dstrow0 + n) * ldt + k0 + 8 * c) = o; }
    LDS_WAIT(); asm volatile("" ::: "memory");
}
__device__ __forceinline__ void prep_w1(const Frame& F, const Args& a, int layer) {
    const int lane_ = fresh_tid(F.wave) & 63;
    LAS float* scr = (LAS float*)(F.lds + F.wave * 16384);
    const int gw = F.vcu * 8 + F.wave, NGW = F.G * 8;
    const float* W = a.w_in + (size_t)layer * D * DINP; const float* nw = a.norm_w + layer * D; bf16* WT = (bf16*)(a.ws + WS_W1T);
    constexpr int NBLK = (NP - 512) / 32;
    for (int it = gw; it < NBLK * 16; it += NGW) {
        const int kb = it & 15; int nb = it >> 4; if (nb >= 32) nb += 16;
        const int n0 = nb * 32; const int src = n0 < 1024 ? n0 : (n0 < 2560 ? n0 - 512 : n0 - 496);
        const float rs = (n0 < 512 || (n0 >= 4096 && n0 < 4608)) ? 0.08838834764831845f : 1.f;
        tr_item(W, DINP, src, nw, rs, WT, D, n0, kb * 64, scr, lane_);
    }
    const float* wup = a.gla_wup + (size_t)layer * 16 * 512;
    for (int it = gw; it < 512 * 2; it += NGW) {
        const int c = it >> 1, ko = ((it & 1) * 64 + lane_) * 8;
        float up[16];
#pragma unroll
        for (int r = 0; r < 16; ++r) up[r] = wup[r * 512 + c];
        float o[8];
#pragma unroll
        for (int kk = 0; kk < 8; ++kk) { const float* wr_ = W + (size_t)(ko + kk) * DINP + 2048; float s = 0.f;
#pragma unroll
            for (int r4 = 0; r4 < 4; ++r4) { const f32x4 w4 = *(const f32x4*)(wr_ + 4 * r4); s += w4.x * up[4 * r4] + w4.y * up[4 * r4 + 1] + w4.z * up[4 * r4 + 2] + w4.w * up[4 * r4 + 3]; }
            o[kk] = s * nw[ko + kk]; }
        u32x4 w; w.x = pk2(o[0], o[1]); w.y = pk2(o[2], o[3]); w.z = pk2(o[4], o[5]); w.w = pk2(o[6], o[7]);
        *(u32x4*)(WT + (size_t)(1024 + c) * D + ko) = w;
    }
}
__device__ __forceinline__ void prep_w2(const Frame& F, const Args& a, int layer) {
    const int lane_ = fresh_tid(F.wave) & 63;
    LAS float* scr = (LAS float*)(F.lds + F.wave * 16384);
    const int gw = F.vcu * 8 + F.wave, NGW = F.G * 8;
    const float* W = a.w_out + (size_t)layer * DMIX * D; bf16* WT = (bf16*)(a.ws + WS_W2T);
    for (int it = gw; it < 32 * 32; it += NGW) { const int kb = it & 31, nb = it >> 5; tr_item(W, D, nb * 32, nullptr, 1.f, WT, DMIX, nb * 32, kb * 64, scr, lane_); }
}
__device__ __forceinline__ void prep_wkv(const Frame& F, const Args& a) {
    const int lane_ = fresh_tid(F.wave) & 63;
    LAS float* scr = (LAS float*)(F.lds + F.wave * 16384);
    const int gw = F.vcu * 8 + F.wave, NGW = F.G * 8;
    bf16* WT = (bf16*)((unsigned char*)a.out + DO_WKVT);
    for (int it = gw; it < 2 * 32 * 16; it += NGW) { const int layer = it >> 9, r = it & 511, kb = r & 15, nb = r >> 4;
        tr_item(a.w_mkv + (size_t)layer * D * 1024, 1024, nb * 32, a.mem_nw + layer * D, 1.f, WT, D, layer * 1024 + nb * 32, kb * 64, scr, lane_); }
}
template <int RB>
__device__ __forceinline__ void rows_to_bf16(const float* x0, bf16* o0, int lane, float (&ss)[RB]) {
    f32x4 v[RB][4];
#pragma unroll
    for (int r = 0; r < RB; ++r)
#pragma unroll
        for (int j = 0; j < 4; ++j) v[r][j] = *((const f32x4*)(x0 + (size_t)r * D) + lane + 64 * j);
#pragma unroll
    for (int r = 0; r < RB; ++r) { float s = 0.f; u32x2* o8 = (u32x2*)(o0 + (size_t)r * D) + lane;
#pragma unroll
        for (int j = 0; j < 4; ++j) { s += (v[r][j].x * v[r][j].x + v[r][j].y * v[r][j].y) + (v[r][j].z * v[r][j].z + v[r][j].w * v[r][j].w); u32x2 w; w.x = pk2(v[r][j].x, v[r][j].y); w.y = pk2(v[r][j].z, v[r][j].w); o8[64 * j] = w; }
        ss[r] = wave_sum(s); }
}
__device__ __forceinline__ void prep_x(const Frame& F, const Args& a) {
    const int lane_ = fresh_tid(F.wave) & 63;
    const int gw = F.vcu * 8 + F.wave, NGW = F.G * 8;
    if (gw < 16) {
        float* ht = (float*)(a.ws + WS_HTAB); const int c = (gw & 7) * 64 + lane_, l = gw >> 3; float lb = 0.f;
        if (l == 1) { const float h0 = a.hgrn_lb[c], h1 = a.hgrn_lb[512 + c]; lb = 1.f / (1.f + expf(h0 - h1)); }
        ht[l * 1024 + c] = logf(fmaxf(lb, 1e-30f)); ht[l * 1024 + 512 + c] = log1pf(-lb); }
    bf16* xb = (bf16*)(a.ws + WS_XB); float* ssq0 = (float*)((unsigned char*)a.out + DO_SSQ0);
    for (int m = 4 * gw; m < T; m += 4 * NGW) { float ss[4]; rows_to_bf16<4>(a.x + (size_t)m * D, xb + (size_t)m * D, lane_, ss);
#pragma unroll
        for (int r = 0; r < 4; ++r) if (lane_ < 16) ssq0[(size_t)(m + r) * 16 + lane_] = lane_ == 0 ? ss[r] : 0.f; }
    bf16* memb = (bf16*)((unsigned char*)a.out + DO_MEMB); float* rstdm = (float*)((unsigned char*)a.out + DO_RSTDM);
    for (int m = gw; m < MROWS; m += NGW) { float ss[1]; rows_to_bf16<1>(a.mem + (size_t)m * D, memb + (size_t)m * D, lane_, ss);
        if (lane_ == 0) rstdm[m] = 1.0f / sqrtf(ss[0] * (1.f / D) + NORM_EPS); }
}

struct EpiProj {
    static constexpr bool PERM = true;
    int dry;
    bf16* P; const LAS float* rstd_lds; const float* gbias; const float* htab;
    template <int KIND>
    __device__ __forceinline__ void store_tile(const f32x4 (&acc)[2][2][4][2], bf16* rowp0, const LAS float* rsp, int cbase, int fq) const {
#pragma unroll
        for (int ai = 0; ai < 2; ++ai)
#pragma unroll
            for (int m = 0; m < 4; ++m) {
                const float rs = rsp[ai * 128 + m * 16];
#pragma unroll
                for (int bj = 0; bj < 2; ++bj) { float v[8];
#pragma unroll
                    for (int e = 0; e < 4; ++e) { v[e] = acc[ai][bj][m][0][e] * rs; v[4 + e] = acc[ai][bj][m][1][e] * rs; }
                    u32x4 w;
                    if (KIND == 0) { w.x = pk2(v[0], v[1]); w.y = pk2(v[2], v[3]); w.z = pk2(v[4], v[5]); w.w = pk2(v[6], v[7]); }
                    else if (KIND == 3) {
#pragma unroll
                        for (int e = 0; e < 8; ++e) v[e] = v[e] * __builtin_amdgcn_rcpf(1.f + fexp(-v[e]));
                        w.x = pk2(v[0], v[1]); w.y = pk2(v[2], v[3]); w.z = pk2(v[4], v[5]); w.w = pk2(v[6], v[7]); }
                    else if (KIND == 1) { const f32x4 b0 = *(const f32x4*)(gbias + cbase + bj * 128), b1 = *(const f32x4*)(gbias + cbase + bj * 128 + 4);
#pragma unroll
                        for (int e = 0; e < 8; ++e) v[e] = log_sigmoid(v[e] + (e < 4 ? b0[e & 3] : b1[e & 3])) * (0.0625f * 1.4426950408889634f);
                        w.x = pkh2(v[0], v[1]); w.y = pkh2(v[2], v[3]); w.z = pkh2(v[4], v[5]); w.w = pkh2(v[6], v[7]); }
                    else { const f32x4 a0 = *(const f32x4*)(htab + cbase + bj * 128), a1 = *(const f32x4*)(htab + cbase + bj * 128 + 4), c0 = *(const f32x4*)(htab + 512 + cbase + bj * 128), c1 = *(const f32x4*)(htab + 512 + cbase + bj * 128 + 4);
#pragma unroll
                        for (int e = 0; e < 8; ++e) { const float aa = e < 4 ? a0[e & 3] : a1[e & 3], bb = (e < 4 ? c0[e & 3] : c1[e & 3]) + log_sigmoid(v[e]); const float mx = fmaxf(aa, bb);
                            v[e] = (mx + flog(1.f + fexp(-fabsf(aa - bb)))) * 1.4426950408889634f; }
                        w.x = pkh2(v[0], v[1]); w.y = pkh2(v[2], v[3]); w.z = pkh2(v[4], v[5]); w.w = pkh2(v[6], v[7]); }
                    if (dry != 2) *(u32x4*)(rowp0 + (size_t)(ai * 128 + m * 16) * 128 + (size_t)bj * PGS) = w; else asm volatile("" :: "v"(w)); }
            }
    }
    __device__ __forceinline__ void operator()(const f32x4 (&acc)[2][2][4][2], const pg8::Unit& u, int wr, int wc, int fr, int fq) const {
        if (dry == 1) return;
        const int pn = u.pn; int kind, dcol, cb0 = 0;
        if (pn < 2) { kind = 0; dcol = C_GQ + 256 * pn; } else if (pn < 4) { kind = 0; dcol = C_GK + 256 * (pn - 2); } else if (pn < 6) { kind = 1; dcol = C_GG + 256 * (pn - 4); cb0 = 256 * (pn - 4); }
        else if (pn < 10) { kind = 0; dcol = C_GV + 256 * (pn - 6); } else if (pn < 12) { kind = 0; dcol = C_HQ + 256 * (pn - 10); } else if (pn < 14) { kind = 2; dcol = C_HLF + 256 * (pn - 12); cb0 = 256 * (pn - 12); }
        else if (pn < 16) { kind = 0; dcol = C_HI + 256 * (pn - 14); } else if (pn < 18) { kind = 0; dcol = C_XQ + 256 * (pn - 16); } else { kind = 3; dcol = C_SG + 256 * (pn - 18); }
        const int row0 = u.pm * 256 + wr * 64 + fr;
        const int cw = wc * 32 + 8 * fq;
        bf16* rowp0 = P + pgo(dcol, row0) + cw; const LAS float* rsp = rstd_lds + u.idx * 256 + wr * 64 + fr;
        if (kind == 0) store_tile<0>(acc, rowp0, rsp, 0, fq);
        else if (kind == 3) store_tile<3>(acc, rowp0, rsp, 0, fq);
        else if (kind == 1) store_tile<1>(acc, rowp0, rsp, cb0 + cw, fq);
        else store_tile<2>(acc, rowp0, rsp, cb0 + cw, fq);
    }
};
struct EpiMem {
    static constexpr bool PERM = true;
    bf16* O; const float* rstdm;
    __device__ __forceinline__ void operator()(const f32x4 (&acc)[2][2][4][2], const pg8::Unit& u, int wr, int wc, int fr, int fq) const {
        const int row0 = u.pm * 256 + wr * 64 + fr, col0 = u.pn * 256 + wc * 32 + 8 * fq;
#pragma unroll
        for (int ai = 0; ai < 2; ++ai)
#pragma unroll
            for (int m = 0; m < 4; ++m) { const int row = row0 + ai * 128 + m * 16; const float rs = rstdm[row]; bf16* rowp = O + (size_t)row * 2048 + col0;
#pragma unroll
                for (int bj = 0; bj < 2; ++bj) { const f32x4 v0 = acc[ai][bj][m][0] * rs, v1 = acc[ai][bj][m][1] * rs; u32x4 w;
                    w.x = pk2(v0[0], v0[1]); w.y = pk2(v0[2], v0[3]); w.z = pk2(v1[0], v1[1]); w.w = pk2(v1[2], v1[3]); *(u32x4*)(rowp + bj * 128) = w; } }
    }
};
struct EpiRes {
    static constexpr bool PERM = false;
    const float* resid; float* out; bf16* xb; float* ssq;
    __device__ __forceinline__ void operator()(const f32x4 (&acc)[2][2][4][2], const pg8::Unit& u, int wr, int wc, int fr, int fq) const {
        const int row0 = u.pm * 256 + wr * 64 + fr, col0 = u.pn * 256 + wc * 32 + 4 * fq;
        f32x4 rn[2][2];
#pragma unroll
        for (int bj = 0; bj < 2; ++bj)
#pragma unroll
            for (int n = 0; n < 2; ++n) rn[bj][n] = *(const f32x4*)(resid + (size_t)row0 * D + col0 + bj * 128 + n * 16);
#pragma unroll
        for (int s8 = 0; s8 < 8; ++s8) { const int ai = s8 >> 2, m = s8 & 3; const int row = row0 + ai * 128 + m * 16; const size_t off = (size_t)row * D + col0; float ss = 0.f;
            f32x4 rc[2][2];
#pragma unroll
            for (int bj = 0; bj < 2; ++bj)
#pragma unroll
                for (int n = 0; n < 2; ++n) rc[bj][n] = rn[bj][n];
            if (s8 < 7) { const int ai2 = (s8 + 1) >> 2, m2 = (s8 + 1) & 3; const size_t off2 = (size_t)(row0 + ai2 * 128 + m2 * 16) * D + col0;
#pragma unroll
                for (int bj = 0; bj < 2; ++bj)
#pragma unroll
                    for (int n = 0; n < 2; ++n) rn[bj][n] = *(const f32x4*)(resid + off2 + bj * 128 + n * 16); }
#pragma unroll
            for (int bj = 0; bj < 2; ++bj)
#pragma unroll
                for (int n = 0; n < 2; ++n) { const f32x4 o = rc[bj][n] + acc[ai][bj][m][n];
                    *(f32x4*)(out + off + bj * 128 + n * 16) = o; u32x2 w; w.x = pk2(o[0], o[1]); w.y = pk2(o[2], o[3]); *(u32x2*)(xb + off + bj * 128 + n * 16) = w;
                    ss += (o[0] * o[0] + o[1] * o[1]) + (o[2] * o[2] + o[3] * o[3]); }
            ss += __shfl_xor(ss, 16); ss += __shfl_xor(ss, 32);
            if (fq == 0) ssq[(size_t)row * 16 + u.pn * 4 + wc] = ss; }
    }
};

namespace mx {
constexpr int RSB = 272;
constexpr int TILE_BYTES = 64 * RSB;
constexpr int OFF_Q = 0, OFF_K = TILE_BYTES, OFF_K2 = 2 * TILE_BYTES, OFF_V = 3 * TILE_BYTES;
constexpr int OFF_DC = OFF_V + 64 * 528, OFF_END = OFF_DC + 2048;
static_assert(OFF_END <= MISC_OFF && 64 * 260 * 4 <= OFF_DC, "mixer LDS map");

template <int PASS, int KIND>
__device__ __forceinline__ void mix_unit(const Frame& F, const Args& a, int u, int layer, bool dry) {
    constexpr int NVT = KIND == 0 ? 2 : 1, DV = 128 * NVT, VRS = DV * 2 + 16, OSS = DV + 4, NVP = 2 * NVT  , NGP = 2 * NVT  ;
    const int tid = fresh_tid(F.wave), lane = tid & 63, w = F.wave;
    const int li = lane & 15, g4 = lane >> 4, q_ = li >> 2, p_ = li & 3;
    const int ul = KIND == 0 ? u : u - 256, b = ul >> 5, hd = (ul >> 3) & 3, seg = ul & 7;
    const int t0 = b * SEQ + seg * SEGLEN;
    const int qcol = KIND == 0 ? C_GQ + hd * 128 : C_HQ + hd * 128, kcol = C_GK + hd * 128, gcol = KIND == 0 ? C_GG + hd * 128 : C_HLF + hd * 128;
    const int vcol = KIND == 0 ? C_GV + hd * 256 : C_HI + hd * 128, ocol = KIND == 0 ? C_SG + hd * 256 : C_SG + 1024 + hd * 128;
    const float* nw = KIND == 0 ? a.gla_nw + layer * 256 : a.hgrn_nw + layer * 128;
    LAS unsigned char* L = F.lds;
    const bf16* P = (const bf16*)(a.ws + WS_P);
    float* SEND = (float*)(a.ws + WS_SEND) + (KIND == 0 ? (size_t)ul * 32768 : (size_t)256 * 32768 + (size_t)ul * 16384);
    float* DTOT = (float*)(a.ws + WS_DTOT) + (size_t)u * 128;
    constexpr int SEND_UNIT = KIND == 0 ? 32768 : 16384;
    f32x4 S[8][NVT];
#pragma unroll
    for (int dt = 0; dt < 8; ++dt)
#pragma unroll
        for (int vt = 0; vt < NVT; ++vt) S[dt][vt] = (f32x4){0.f, 0.f, 0.f, 0.f};
    if (PASS == 1 && !(dry && (PROBE_SUB & 1))) {
        const float* sp = SEND + (size_t)(w * 8 * NVT) * 256 + lane * 4;
#pragma unroll
        for (int dt = 0; dt < 8; ++dt)
#pragma unroll
            for (int vt = 0; vt < NVT; ++vt) S[dt][vt] = *(const f32x4*)(sp + (dt * NVT + vt) * 256);
    }
    const int ca = w >> 1, th = w & 1;
    unsigned gw_[16], kw_[8], qw_[8]; u32x4 vv[NVP];
    unsigned gwn[16], kwn[8], qwn[8]; u32x4 vvn[NVP];
#define MX_LOADS(mc_) do { const size_t ro_ = (size_t)(t0 + (mc_) * 64 + 16 * ca) * 128 + 2 * lane;     \
        const bf16* gp_ = P + (size_t)(gcol >> 7) * PGS + ro_; const bf16* kp_ = P + (size_t)(kcol >> 7) * PGS + ro_; const bf16* qp_ = P + (size_t)(qcol >> 7) * PGS + ro_; \
        _Pragma("unroll") for (int j = 0; j < 8; ++j) { gwn[j] = *(const unsigned*)(gp_ + (8 * th + j) * 128); gwn[8 + j] = *(const unsigned*)(gp_ + (8 - 8 * th + j) * 128); } \
        if (KIND == 0) { _Pragma("unroll") for (int j = 0; j < 8; ++j) kwn[j] = *(const unsigned*)(kp_ + (8 * th + j) * 128); } \
        if (PASS == 1) { _Pragma("unroll") for (int j = 0; j < 8; ++j) qwn[j] = *(const unsigned*)(qp_ + (8 * th + j) * 128); } \
        _Pragma("unroll") for (int i = 0; i < NVP; ++i) { const int p = tid + 512 * i, r = p / (DV / 8), c8 = p % (DV / 8); vvn[i] = *(const u32x4*)(P + (size_t)((vcol >> 7) + (c8 >> 4)) * PGS + (size_t)(t0 + (mc_) * 64 + r) * 128 + 8 * (c8 & 15)); } } while (0)
    if (!(dry && (PROBE_SUB & 16))) MX_LOADS(0);
    float lt0 = 0.f, lt1 = 0.f;
#define MX_BARRIER() do { asm volatile("s_waitcnt lgkmcnt(0)" ::: "memory"); __builtin_amdgcn_s_barrier(); asm volatile("" ::: "memory"); } while (0)
    for (int mc = 0; mc < NMC; ++mc) {
        const int tb = t0 + mc * 64;
#pragma unroll
        for (int j = 0; j < 16; ++j) gw_[j] = gwn[j];
#pragma unroll
        for (int j = 0; j < 8; ++j) { kw_[j] = kwn[j]; qw_[j] = qwn[j]; }
#pragma unroll
        for (int i = 0; i < NVP; ++i) vv[i] = vvn[i];
        if (mc + 1 < NMC && !(dry && (PROBE_SUB & 16))) MX_LOADS(mc + 1);
        if (!(dry && (PROBE_SUB & 2))) {
#pragma unroll
            for (int i = 0; i < NVP; ++i) { const int p = tid + 512 * i, r = p / (DV / 8), c8 = p % (DV / 8); *(LAS u32x4*)(L + OFF_V + r * VRS + c8 * 16) = vv[i]; }
            float go0[8], go1[8], k0[8], k1[8];
            float ot0 = 0.f, ot1 = 0.f, ow0 = 0.f, ow1 = 0.f;
#pragma unroll
            for (int j = 0; j < 8; ++j) { const f16x2 gh = __builtin_bit_cast(f16x2, gw_[j]), gx = __builtin_bit_cast(f16x2, gw_[8 + j]); go0[j] = (float)gh.x; go1[j] = (float)gh.y;
                ow0 += go0[j]; ow1 += go1[j]; ot0 += (float)gx.x; ot1 += (float)gx.y;
                if (KIND == 0) { k0[j] = bflo(kw_[j]); k1[j] = bfhi(kw_[j]); } else { k0[j] = 1.f - __builtin_amdgcn_exp2f(go0[j]); k1[j] = 1.f - __builtin_amdgcn_exp2f(go1[j]); } }
            const float lo0 = th ? ot0 : 0.f, lo1 = th ? ot1 : 0.f, hi0 = th ? 0.f : ot0, hi1 = th ? 0.f : ot1;
            const int row0 = 16 * ca + 8 * th;
            if (PASS == 1) {
                float r0 = lo0, r1 = lo1;
#pragma unroll
                for (int j = 0; j < 8; ++j) { r0 += go0[j]; r1 += go1[j];
                    const float q0 = bflo(qw_[j]) * __builtin_amdgcn_exp2f(r0), q1 = bfhi(qw_[j]) * __builtin_amdgcn_exp2f(r1);
                    const float kh0 = k0[j] * __builtin_amdgcn_exp2f(fminf(-r0, 115.f)), kh1 = k1[j] * __builtin_amdgcn_exp2f(fminf(-r1, 115.f));
                    *(LAS unsigned*)(L + OFF_Q + (row0 + j) * RSB + lane * 4) = pk2(q0, q1);
                    *(LAS unsigned*)(L + OFF_K + (row0 + j) * RSB + lane * 4) = pk2(kh0, kh1); }
            }
            float s0 = hi0, s1 = hi1;
#pragma unroll
            for (int j = 7; j >= 0; --j) { *(LAS unsigned*)(L + OFF_K2 + (row0 + j) * RSB + lane * 4) = pk2(k0[j] * __builtin_amdgcn_exp2f(s0), k1[j] * __builtin_amdgcn_exp2f(s1)); s0 += go0[j]; s1 += go1[j]; }
            const float tt0 = ow0 + ot0, tt1 = ow1 + ot1;
            if (th == 0) { f32x2 dd; dd.x = __builtin_amdgcn_exp2f(tt0); dd.y = __builtin_amdgcn_exp2f(tt1); *(LAS f32x2*)(L + OFF_DC + ca * 512 + lane * 8) = dd; }
            lt0 += tt0; lt1 += tt1;
        }
        MX_BARRIER();
        const int ei = tid >> 3, ve = tid & 7;
        bf16* orow = (bf16*)P + (size_t)(ocol >> 7) * PGS + (size_t)(tb + ei) * 128 + 8 * ve;
        u32x4 gt[NGP];
        if (PASS == 1) {
#pragma unroll
            for (int k = 0; k < NGP; ++k) gt[k] = *(const u32x4*)(orow + (size_t)(k >> 1) * PGS + 64 * (k & 1));
        }
        f32x4 oc[4][NVT];
        if (!(dry && (PROBE_SUB & 4))) {
#pragma unroll
        for (int c = 0; c < 4; ++c) {
            const int rb = 16 * c;
            bf16x8 vb[NVT];
#pragma unroll
            for (int vt = 0; vt < NVT; ++vt) { const s16x4 t4 = tr16(L + OFF_V + (rb + 4 * g4 + q_) * VRS + (16 * NVT * w + 16 * vt + 4 * p_) * 2); vb[vt] = (bf16x8){t4[0], t4[1], t4[2], t4[3], 0, 0, 0, 0}; }
            if (PASS == 1) {
                f32x4 at = (f32x4){0.f, 0.f, 0.f, 0.f};
#pragma unroll
                for (int ks = 0; ks < 4; ++ks) { const bf16x8 ka = *(const LAS bf16x8*)(L + OFF_K + (rb + li) * RSB + (32 * ks + 8 * g4) * 2); const bf16x8 qb = *(const LAS bf16x8*)(L + OFF_Q + (rb + li) * RSB + (32 * ks + 8 * g4) * 2);
                    at = __builtin_amdgcn_mfma_f32_16x16x32_bf16(ka, qb, at, 0, 0, 0); }
#pragma unroll
                for (int r = 0; r < 4; ++r) at[r] = (4 * g4 + r <= li) ? at[r] : 0.f;
                const bf16x8 pa = __builtin_bit_cast(bf16x8, (u32x4){pk2(at[0], at[1]), pk2(at[2], at[3]), 0u, 0u});
                f32x4 o[NVT];
#pragma unroll
                for (int vt = 0; vt < NVT; ++vt) o[vt] = __builtin_amdgcn_mfma_f32_16x16x32_bf16(pa, vb[vt], (f32x4){0.f, 0.f, 0.f, 0.f}, 0, 0, 0);
#pragma unroll
                for (int ks = 0; ks < 4; ++ks) {
                    const u32x2 qa0 = *(const LAS u32x2*)(L + OFF_Q + (rb + li) * RSB + (32 * ks + 4 * g4) * 2), qa1 = *(const LAS u32x2*)(L + OFF_Q + (rb + li) * RSB + (32 * ks + 16 + 4 * g4) * 2);
                    const bf16x8 qa = __builtin_bit_cast(bf16x8, (u32x4){qa0.x, qa0.y, qa1.x, qa1.y});
#pragma unroll
                    for (int vt = 0; vt < NVT; ++vt) {
                        const bf16x8 sb = __builtin_bit_cast(bf16x8, (u32x4){pk2(S[2 * ks][vt][0], S[2 * ks][vt][1]), pk2(S[2 * ks][vt][2], S[2 * ks][vt][3]), pk2(S[2 * ks + 1][vt][0], S[2 * ks + 1][vt][1]), pk2(S[2 * ks + 1][vt][2], S[2 * ks + 1][vt][3])});
                        o[vt] = __builtin_amdgcn_mfma_f32_16x16x32_bf16(qa, sb, o[vt], 0, 0, 0); } }
#pragma unroll
                for (int vt = 0; vt < NVT; ++vt) oc[c][vt] = o[vt];
            }
#pragma unroll
            for (int dt = 0; dt < 8; ++dt) { const s16x4 t4 = tr16(L + OFF_K2 + (rb + 4 * g4 + q_) * RSB + (16 * dt + 4 * p_) * 2); const bf16x8 ka = (bf16x8){t4[0], t4[1], t4[2], t4[3], 0, 0, 0, 0};
                const f32x4 dv = *(const LAS f32x4*)(L + OFF_DC + c * 512 + (16 * dt + 4 * g4) * 4);
#pragma unroll
                for (int vt = 0; vt < NVT; ++vt) S[dt][vt] = __builtin_amdgcn_mfma_f32_16x16x32_bf16(ka, vb[vt], S[dt][vt] * dv, 0, 0, 0); }
        }
        }
        MX_BARRIER();
        if (PASS == 1 && !(dry && (PROBE_SUB & 12))) {
            LAS float* Os = (LAS float*)L;
#pragma unroll
            for (int c = 0; c < 4; ++c)
#pragma unroll
                for (int vt = 0; vt < NVT; ++vt)
#pragma unroll
                    for (int r = 0; r < 4; ++r) Os[(16 * c + 4 * g4 + r) * OSS + 16 * NVT * w + 16 * vt + li] = oc[c][vt][r];
            MX_BARRIER();
            f32x4 ov[2 * NGP]; float ss = 0.f;
#pragma unroll
            for (int k = 0; k < NGP; ++k) { ov[2 * k] = *(const LAS f32x4*)(Os + ei * OSS + 64 * k + 8 * ve); ov[2 * k + 1] = *(const LAS f32x4*)(Os + ei * OSS + 64 * k + 8 * ve + 4);
                ss += (ov[2 * k].x * ov[2 * k].x + ov[2 * k].y * ov[2 * k].y) + (ov[2 * k].z * ov[2 * k].z + ov[2 * k].w * ov[2 * k].w) + (ov[2 * k + 1].x * ov[2 * k + 1].x + ov[2 * k + 1].y * ov[2 * k + 1].y) + (ov[2 * k + 1].z * ov[2 * k + 1].z + ov[2 * k + 1].w * ov[2 * k + 1].w); }
            MX_BARRIER();
            ss += __shfl_xor(ss, 1); ss += __shfl_xor(ss, 2); ss += __shfl_xor(ss, 4);
            const float rstd = __builtin_amdgcn_rsqf(ss * (1.f / DV) + NORM_EPS);
#pragma unroll
            for (int k = 0; k < NGP; ++k) { const f32x4 w0 = *(const f32x4*)(nw + 64 * k + 8 * ve), w1 = *(const f32x4*)(nw + 64 * k + 8 * ve + 4); const f32x4 a0 = ov[2 * k], a1 = ov[2 * k + 1]; const u32x4 gg = gt[k];
                u32x4 wv; wv.x = pk2(a0.x * rstd * w0.x * bflo(gg.x), a0.y * rstd * w0.y * bfhi(gg.x)); wv.y = pk2(a0.z * rstd * w0.z * bflo(gg.y), a0.w * rstd * w0.w * bfhi(gg.y));
                wv.z = pk2(a1.x * rstd * w1.x * bflo(gg.z), a1.y * rstd * w1.y * bfhi(gg.z)); wv.w = pk2(a1.z * rstd * w1.z * bflo(gg.w), a1.w * rstd * w1.w * bfhi(gg.w));
                if (!dry) *(u32x4*)(orow + (size_t)(k >> 1) * PGS + 64 * (k & 1)) = wv; }
        }
    }
#undef MX_LOADS
#undef MX_BARRIER
    if (PASS == 0) {
        float* sp = SEND + (size_t)(w * 8 * NVT) * 256 + lane * 4;
#pragma unroll
        for (int dt = 0; dt < 8; ++dt)
#pragma unroll
            for (int vt = 0; vt < NVT; ++vt) *(f32x4*)(sp + (dt * NVT + vt) * 256) = S[dt][vt];
        LAS float* LT = (LAS float*)(L + OFF_DC);
        if (th == 0) { f32x2 lt; lt.x = lt0; lt.y = lt1; *(LAS f32x2*)(L + OFF_DC + ca * 512 + lane * 8) = lt; }
        LDS_WAIT(); __syncthreads();
        if (tid < 128) DTOT[tid] = __builtin_amdgcn_exp2f(LT[tid] + LT[128 + tid] + LT[256 + tid] + LT[384 + tid]);
        LDS_WAIT(); __syncthreads();
    }
}

__device__ __forceinline__ void scan_states(const Frame& F, const Args& a) {
    const int tid = fresh_tid(F.wave);
    float* SENDB = (float*)(a.ws + WS_SEND); const float* DT = (const float*)(a.ws + WS_DTOT);
    constexpr int NG = 32 * 8192, NH = 32 * 4096;
    for (int idx = F.vcu * 512 + tid; idx < NG + NH; idx += F.G * 512) {
        float* base; const float* dtb; size_t stride; int d0;
        if (idx < NG) { const int grp = idx >> 13, p = idx & 8191; base = SENDB + (size_t)(grp * 8) * 32768 + (size_t)p * 4; stride = 32768; dtb = DT + (size_t)(grp * 8) * 128; d0 = 16 * ((p >> 7) & 7) + 4 * ((p & 63) >> 4); }
        else { const int j = idx - NG, grp = j >> 12, p = j & 4095; base = SENDB + (size_t)256 * 32768 + (size_t)(grp * 8) * 16384 + (size_t)p * 4; stride = 16384; dtb = DT + (size_t)(256 + grp * 8) * 128; d0 = 16 * ((p >> 6) & 7) + 4 * ((p & 63) >> 4); }
        f32x4 cur[7], dv[7];
#pragma unroll
        for (int sg = 0; sg < 7; ++sg) { cur[sg] = *(const f32x4*)(base + sg * stride); dv[sg] = *(const f32x4*)(dtb + sg * 128 + d0); }
        float z_; asm volatile("v_mov_b32 %0, 0" : "=v"(z_));
        f32x4 run = (f32x4){z_, z_, z_, z_};
#pragma unroll
        for (int sg = 0; sg < 8; ++sg) { *(f32x4*)(base + sg * stride) = run; if (sg < 7) run = run * dv[sg] + cur[sg]; }
    }
}
}

namespace xa {
constexpr int RSB = 272;
constexpr int OFF_KX = 0, OFF_VX = 256 * RSB;
static_assert(2 * 256 * RSB <= MISC_OFF, "xattn LDS map");
__device__ __forceinline__ void xa_unit(const Frame& F, const Args& a, int x, int layer, bool dry) {
    const int tid = fresh_tid(F.wave);
    const int lane = tid & 63, wid = F.wave, li = lane & 15, g4 = lane >> 4, q_ = li >> 2, p_ = li & 3;
    const int b = x >> 5, h = (x >> 3) & 3, tr = x & 7, t0 = b * SEQ + tr * 512 + wid * 64;
    LAS unsigned char* L = F.lds;
    bf16* P = (bf16*)(a.ws + WS_P); const bf16* MKV = (const bf16*)(a.ws + WS_MKV);
    const float* nw = a.xattn_nw + layer * 128;
#pragma unroll
    for (int i = 0; i < 8; ++i) { const int p = tid + 512 * i, r = p >> 4, c8 = p & 15; const bf16* src = MKV + (size_t)(b * MEML + r) * 2048 + layer * 1024 + h * 128 + 8 * c8;
        const u32x4 kk = *(const u32x4*)src, vv = *(const u32x4*)(src + 512);
        *(LAS u32x4*)(L + OFF_KX + r * RSB + c8 * 16) = kk; *(LAS u32x4*)(L + OFF_VX + r * RSB + c8 * 16) = vv; }
    LDS_WAIT(); __syncthreads();
    for (int it = 0; it < 4; ++it) {
        const int tb = t0 + 16 * it;
        unsigned kxo = OFF_KX, vxo = OFF_VX; asm volatile("" : "+v"(kxo), "+v"(vxo));
        bf16x8 qb[4];
#pragma unroll
        for (int ks = 0; ks < 4; ++ks) qb[ks] = *(const bf16x8*)(P + pgo(C_XQ + h * 128, tb + li) + 32 * ks + 8 * g4);
        f32x4 s[16];
#pragma unroll
        for (int mt = 0; mt < 16; ++mt) { s[mt] = (f32x4){0.f, 0.f, 0.f, 0.f};
#pragma unroll
            for (int ks = 0; ks < 4; ++ks) { const bf16x8 ka = *(const LAS bf16x8*)(L + kxo + (16 * mt + li) * RSB + (32 * ks + 8 * g4) * 2); s[mt] = __builtin_amdgcn_mfma_f32_16x16x32_bf16(ka, qb[ks], s[mt], 0, 0, 0); } }
        float mxv = s[0][0];
#pragma unroll
        for (int mt = 0; mt < 16; ++mt)
#pragma unroll
            for (int r = 0; r < 4; ++r) mxv = fmaxf(mxv, s[mt][r]);
        mxv = fmaxf(mxv, __shfl_xor(mxv, 16)); mxv = fmaxf(mxv, __shfl_xor(mxv, 32));
        float lsum = 0.f;
#pragma unroll
        for (int mt = 0; mt < 16; ++mt)
#pragma unroll
            for (int r = 0; r < 4; ++r) { s[mt][r] = fexp(s[mt][r] - mxv); lsum += s[mt][r]; }
        lsum += __shfl_xor(lsum, 16); lsum += __shfl_xor(lsum, 32);
        f32x4 o[8];
#pragma unroll
        for (int vt = 0; vt < 8; ++vt) o[vt] = (f32x4){0.f, 0.f, 0.f, 0.f};
#pragma unroll
        for (int k2 = 0; k2 < 8; ++k2) {
            const bf16x8 pa = __builtin_bit_cast(bf16x8, (u32x4){pk2(s[2 * k2][0], s[2 * k2][1]), pk2(s[2 * k2][2], s[2 * k2][3]), pk2(s[2 * k2 + 1][0], s[2 * k2 + 1][1]), pk2(s[2 * k2 + 1][2], s[2 * k2 + 1][3])});
#pragma unroll
            for (int vt = 0; vt < 8; ++vt) { const s16x4 t0_ = tr16(L + vxo + (32 * k2 + 4 * g4 + q_) * RSB + (16 * vt + 4 * p_) * 2), t1_ = tr16(L + vxo + (32 * k2 + 16 + 4 * g4 + q_) * RSB + (16 * vt + 4 * p_) * 2);
                const bf16x8 vb = (bf16x8){t0_[0], t0_[1], t0_[2], t0_[3], t1_[0], t1_[1], t1_[2], t1_[3]};
                o[vt] = __builtin_amdgcn_mfma_f32_16x16x32_bf16(pa, vb, o[vt], 0, 0, 0); } }
        float ssq[4];
#pragma unroll
        for (int r = 0; r < 4; ++r) { const float linv = 1.0f / __shfl(lsum, 4 * g4 + r); float ss = 0.f;
#pragma unroll
            for (int vt = 0; vt < 8; ++vt) { o[vt][r] *= linv; ss += o[vt][r] * o[vt][r]; }
            ss += __shfl_xor(ss, 1); ss += __shfl_xor(ss, 2); ss += __shfl_xor(ss, 4); ss += __shfl_xor(ss, 8); ssq[r] = ss; }
#pragma unroll
        for (int r = 0; r < 4; ++r) { const float rstd = 1.0f / sqrtf(ssq[r] * (1.f / 128.f) + NORM_EPS); bf16* orow = P + pgo(C_SG + 1536 + h * 128, tb + 4 * g4 + r) + li;
#pragma unroll
            for (int vt = 0; vt < 8; ++vt) { const float gate = __builtin_bit_cast(float, (unsigned)orow[16 * vt] << 16); const bf16 ov_ = (bf16)f2bf(o[vt][r] * rstd * nw[16 * vt + li] * gate); if (!dry) orow[16 * vt] = ov_; } }
    }
    LDS_WAIT(); __syncthreads();
}
}

__device__ __forceinline__ int next_item(const Frame& F, unsigned* head) {
    if (F.wave == 0 && lane_id() == 0) F.MISC[4] = __hip_atomic_fetch_add(head, 1u, RLX_AGENT);
    __syncthreads();
    const int it = (int)F.MISC[4];
    __syncthreads();
    return it;
}

constexpr int N_PHASES = 10;
__global__ void __launch_bounds__(512, 2) mega(Args args) {
    extern __shared__ __attribute__((aligned(16))) unsigned char lds_raw[];
    Frame F;
    F.lds = (LAS unsigned char*)lds_raw; F.MISC = (volatile LAS unsigned*)(F.lds + MISC_OFF);
    F.wave = __builtin_amdgcn_readfirstlane(threadIdx.x >> 6);
    F.G = gridDim.x; { const int bx = blockIdx.x; F.vcu = (F.G % 8 == 0) ? (bx % 8) * (F.G / 8) + bx / 8 : bx; }
    F.ctl = (unsigned*)(args.ws + WS_CTL);
    if (threadIdx.x < 16) F.MISC[threadIdx.x] = 0u;
    __syncthreads();
    XcdBarrier bar; bar.bar = F.ctl + CW_BAR; bar.x = 0; bar.st = nullptr; bar.wave = F.wave;
    if (!MK_PER_PHASE) bar = xcd_barrier_post(F.ctl + CW_BAR, F.MISC + 8, F.wave);
    const int lo = args.ph_lo, hi = args.ph_hi;
#define IN(k) (lo <= (k) && (k) < hi)
#define SEAM(k) do { if (IN(k) && IN((k) + 1)) xcd_barrier(bar); } while (0)
#define LAUNDER(la) Args la = args; asm volatile("" : "+s"(la.ws), "+s"(la.out)); Frame Fp = F; int bid = blockIdx.x; asm volatile("" : "+s"(Fp.vcu), "+s"(Fp.G), "+s"(Fp.wave), "+s"(bid))

    if (IN(0)) { LAUNDER(la); prep_w1(Fp, la, 0); prep_w2(Fp, la, 0); prep_wkv(Fp, la); prep_x(Fp, la);
        if (PROBE_REP == 0) { xcd_barrier(bar); prep_w1(Fp, la, 0); prep_w2(Fp, la, 0); prep_wkv(Fp, la); prep_x(Fp, la); } }
    SEAM(0);
    for (int layer = 0; layer < DEPTH; ++layer) {
        const int pb = 1 + 4 * layer;
        if (IN(pb)) { LAUNDER(la);
            if (layer == 0) {
                typedef pg8::Gemm<MROWS, 2048, D, D, D> GM; typedef pg8::StaticOrder<MROWS, 2048> SM;
                GM g{(const bf16*)((unsigned char*)la.out + DO_MEMB), (const bf16*)((unsigned char*)la.out + DO_WKVT)};
                SM S; S.init(Fp.G, bid);
                EpiMem E{(bf16*)(la.ws + WS_MKV), (const float*)((unsigned char*)la.out + DO_RSTDM)};
                pg8::gemm_phase<EpiMem, SM, GM, true, true>(Fp.lds, g, S, E, Fp.wave);
            }
            typedef pg8::Gemm<T, NP, D, D, D> G1; typedef pg8::StaticOrder<T, NP> S1;
            G1 g{(const bf16*)(la.ws + WS_XB), (const bf16*)(la.ws + WS_W1T)};
            S1 S; S.init(Fp.G, bid);
            {
                const float* ssq = layer == 0 ? (const float*)((unsigned char*)la.out + DO_SSQ0) : (const float*)(la.ws + WS_SSQ1);
                LAS float* rt = (LAS float*)(Fp.lds + RSTD_OFF); const int t_ = fresh_tid(Fp.wave); pg8::Unit uu;
                for (int i = Fp.wave >> 2; S.next(i, uu); i += 2) { const f32x4* sp = (const f32x4*)(ssq + (size_t)(uu.pm * 256 + (t_ & 255)) * 16); const f32x4 s0 = sp[0], s1 = sp[1], s2 = sp[2], s3 = sp[3];
                    const float sq = ((s0.x + s0.y) + (s0.z + s0.w)) + ((s1.x + s1.y) + (s1.z + s1.w)) + ((s2.x + s2.y) + (s2.z + s2.w)) + ((s3.x + s3.y) + (s3.z + s3.w));
                    rt[i * 256 + (t_ & 255)] = __builtin_amdgcn_rsqf(sq * (1.f / D) + NORM_EPS); }
                LDS_WAIT(); __syncthreads();
            }
            EpiProj E{0, (bf16*)(la.ws + WS_P), (const LAS float*)(Fp.lds + RSTD_OFF), la.gla_b + layer * 512, (const float*)(la.ws + WS_HTAB) + layer * 1024};
            pg8::gemm_phase<EpiProj, S1, G1, true, true>(Fp.lds, g, S, E, Fp.wave);
            if (PROBE_REP == pb) { xcd_barrier(bar); E.dry = (PROBE_SUB & 32) ? la.probe : (PROBE_SUB & 2048) ? 2 * la.probe : 0; pg8::gemm_phase<EpiProj, S1, G1, true, true>(Fp.lds, g, S, E, Fp.wave); }
        }
        SEAM(pb);
        if (IN(pb + 1)) { LAUNDER(la);
            if (layer == 0) prep_w1(Fp, la, 1); else prep_w2(Fp, la, 1);
            __syncthreads();
            const int reps = (PROBE_REP == pb + 1) ? 2 : 1;
            for (int rep = 0; rep < reps; ++rep) { const bool dry = (rep + 1 < reps) && la.probe;
                unsigned* head = Fp.ctl + CW_QUEUE + 64 * (2 * layer) + 512 * rep;
                for (;;) { const int it = next_item(Fp, head); if (it >= N_MIX_UNITS + N_XA_UNITS) break;
                    const int grp = it / 3, rr = it - 3 * grp;
                    if (rr == 2) { if (!(dry && (PROBE_SUB & 64))) xa::xa_unit(Fp, la, grp, layer, dry); }
                    else if (!(dry && (PROBE_SUB & 128)) && ((2 * grp + rr) & 7) != 7) { const int mu = 2 * grp + rr;   if (mu < 256) mx::mix_unit<0, 0>(Fp, la, mu, layer, dry); else mx::mix_unit<0, 1>(Fp, la, mu, layer, dry); } }
                if (rep + 1 < reps) xcd_barrier(bar); }
        }
        SEAM(pb + 1);
        if (IN(pb + 2)) { LAUNDER(la);
            mx::scan_states(Fp, la); xcd_barrier(bar);
            const int reps = (PROBE_REP == pb + 2) ? 2 : 1;
            for (int rep = 0; rep < reps; ++rep) { const bool dry = (rep + 1 < reps) && la.probe;
                unsigned* head = Fp.ctl + CW_QUEUE + 64 * (2 * layer + 1) + 512 * rep;
                for (;;) { const int it = next_item(Fp, head); if (it >= N_MIX_UNITS) break; if (it < 256) mx::mix_unit<1, 0>(Fp, la, it, layer, dry); else mx::mix_unit<1, 1>(Fp, la, it, layer, dry); }
                if (rep + 1 < reps) xcd_barrier(bar); }
        }
        SEAM(pb + 2);
        if (IN(pb + 3)) { LAUNDER(la);
            typedef pg8::Gemm<T, D, DMIX, 128, DMIX, PGS * 2> G2; typedef pg8::StaticOrder<T, D> S2;
            G2 g{(const bf16*)(la.ws + WS_P) + pgo(C_SG, 0), (const bf16*)(la.ws + WS_W2T)};
            S2 S; S.init(Fp.G, bid);
            EpiRes E{layer == 0 ? la.x : (const float*)la.out, la.out, (bf16*)(la.ws + WS_XB), (float*)(la.ws + (layer == 0 ? WS_SSQ1 : WS_SSQ2))};
            pg8::gemm_phase<EpiRes, S2, G2, true, true>(Fp.lds, g, S, E, Fp.wave);
            if (PROBE_REP == pb + 3 && layer == 0) { xcd_barrier(bar); pg8::gemm_phase<EpiRes, S2, G2, true, true>(Fp.lds, g, S, E, Fp.wave); }
        }
        SEAM(pb + 3);
    }
    if (IN(9)) { LAUNDER(la);
        const int lane_ = fresh_tid(Fp.wave) & 63;
        const int gw = Fp.vcu * 8 + Fp.wave, NGW = Fp.G * 8; const float* ssq = (const float*)(la.ws + WS_SSQ2);
        f32x4 fw[4];
#pragma unroll
        for (int j = 0; j < 4; ++j) fw[j] = *((const f32x4*)la.final_nw + lane_ + 64 * j);
        for (int m = 4 * gw; m < T; m += 4 * NGW) { f32x4 v[4][4]; float sq[4];
#pragma unroll
            for (int r = 0; r < 4; ++r) { sq[r] = lane_ < 16 ? ssq[(size_t)(m + r) * 16 + lane_] : 0.f;
#pragma unroll
                for (int j = 0; j < 4; ++j) v[r][j] = *((const f32x4*)(la.out + (size_t)(m + r) * D) + lane_ + 64 * j); }
#pragma unroll
            for (int r = 0; r < 4; ++r) { const float rstd = 1.0f / sqrtf(wave_sum(sq[r]) * (1.f / D) + NORM_EPS);
#pragma unroll
                for (int j = 0; j < 4; ++j) *((f32x4*)(la.out + (size_t)(m + r) * D) + lane_ + 64 * j) = v[r][j] * rstd * fw[j]; } }
    }
#undef IN
#undef SEAM
}

extern "C" void kernel_launch(void* const* d_in, const int* in_sizes, int n_in, void* d_out, int out_size, void* d_ws, size_t ws_size, hipStream_t stream) {
    static int grid = 0;
    if (grid == 0) {
        if (n_in != 14 || in_sizes[0] != T * D || out_size != T * D || ws_size < WS_END) { fprintf(stderr, "kernel_launch: unexpected shapes (n_in %d, in0 %d, out %d, ws %zu)\n", n_in, n_in > 0 ? in_sizes[0] : -1, out_size, ws_size); grid = -1; return; }
        int dev = 0, cus = 0, per_cu = 0;
        if (hipGetDevice(&dev) != hipSuccess || hipDeviceGetAttribute(&cus, hipDeviceAttributeMultiprocessorCount, dev) != hipSuccess) { grid = -1; return; }
        if (hipFuncSetAttribute((const void*)mega, hipFuncAttributeMaxDynamicSharedMemorySize, LDS_BYTES) != hipSuccess) { fprintf(stderr, "kernel_launch: hipFuncSetAttribute failed\n"); grid = -1; return; }
        if (hipOccupancyMaxActiveBlocksPerMultiprocessor(&per_cu, (const void*)mega, 512, LDS_BYTES) != hipSuccess || per_cu < 1) { fprintf(stderr, "kernel_launch: occupancy query says %d blocks per CU\n", per_cu); grid = -1; (void)hipGetLastError(); return; }
        grid = cus;
    }
    if (grid < 0) return;
    (void)hipMemsetAsync((char*)d_ws + WS_CTL, 0, CTL_ZERO_BYTES, stream);
    Args a{};
    a.x = (const float*)d_in[0]; a.mem = (const float*)d_in[1]; a.norm_w = (const float*)d_in[2]; a.w_in = (const float*)d_in[3]; a.gla_wup = (const float*)d_in[4]; a.gla_b = (const float*)d_in[5];
    a.gla_nw = (const float*)d_in[6]; a.hgrn_lb = (const float*)d_in[7]; a.hgrn_nw = (const float*)d_in[8]; a.mem_nw = (const float*)d_in[9]; a.w_mkv = (const float*)d_in[10]; a.xattn_nw = (const float*)d_in[11];
    a.w_out = (const float*)d_in[12]; a.final_nw = (const float*)d_in[13]; a.out = (float*)d_out; a.ws = (unsigned char*)d_ws;
#if MK_PER_PHASE
    for (int p = 0; p < N_PHASES; ++p) { a.ph_lo = p; a.ph_hi = p + 1; hipLaunchKernelGGL(mega, dim3(grid), dim3(512), LDS_BYTES, stream, a); }
#else
    a.ph_lo = 0; a.ph_hi = N_PHASES; a.probe = 1;
    void* kargs[] = {&a};
    hipError_t e = hipLaunchCooperativeKernel((const void*)mega, dim3(grid), dim3(512), kargs, LDS_BYTES, stream);
    if (e != hipSuccess) fprintf(stderr, "kernel_launch: cooperative launch failed: %s (grid %d)\n", hipGetErrorString(e), grid);
#endif
}
```

```cpp
#include <hip/hip_runtime.h>
#include <cstdio>
#include <cstdint>

#ifndef MK_PER_PHASE
#define MK_PER_PHASE 0
#endif
#ifndef PROBE_SUB
#define PROBE_SUB 0
#endif
#ifndef PROBE_REP
#define PROBE_REP -1
#endif

#define LAS __attribute__((address_space(3)))
#define GAS __attribute__((address_space(1)))
__device__ __forceinline__ int lane_id() { int l; asm volatile("v_mbcnt_lo_u32_b32 %0, -1, 0\n\tv_mbcnt_hi_u32_b32 %0, -1, %0" : "=v"(l)); return l; }
__device__ __forceinline__ int fresh_tid(int wave) { int t = wave * 64 + lane_id(); asm volatile("" : "+v"(t)); return t; }

namespace pg8 {
typedef unsigned short bf16_t;
typedef short bf16x8 __attribute__((ext_vector_type(8)));
typedef float f32x4 __attribute__((ext_vector_type(4)));
typedef unsigned u32x4 __attribute__((ext_vector_type(4)));
typedef unsigned u32x2 __attribute__((ext_vector_type(2)));
constexpr int BM = 256, BK = 64, HALF = 128, HTB = HALF * BK * 2, STAGE_BYTES = 8 * HTB, NXCD = 8, WGM = 8;

__host__ __device__ __forceinline__ int lds_byte(int r, int c) { const int st = (r >> 4) * 2 + (c >> 5), rr = r & 15, cc = c & 31, ob = rr * 64 + cc * 2; return st * 1024 + (ob ^ (((ob >> 9) & 1) << 5)); }
__host__ __device__ __forceinline__ void stage_rc(int b, int& R, int& C) { const int st = b / 1024, sb = b % 1024, swz = sb ^ (((sb >> 9) & 1) << 5); R = (st >> 1) * 16 + swz / 64; C = (st & 1) * 32 + (swz % 64) / 2; }
__host__ __device__ __forceinline__ int perm32(int rho) { const int n = rho >> 4, i = rho & 15; return 8 * (i >> 2) + 4 * n + (i & 3); }

struct Unit { int pm, pn, idx; };
template <int M_, int N_, int K_, int LDA_, int LDB_, size_t K2A_ = 256> struct Gemm { const bf16_t* A; const bf16_t* Bt; static constexpr int M = M_, N = N_, K = K_, lda = LDA_, ldb = LDB_; static constexpr size_t k2A = K2A_; };

template <int M_, int N_> struct StaticOrder {
    static constexpr int nM = M_ / BM, nN = N_ / BM, nwg = nM * nN;
    int G, c;
    __host__ __device__ void init(int G_, int c_) { G = G_; c = c_; }
    __host__ __device__ bool next(int i, Unit& u) const {
        const long L = (long)i * G + c; if (L >= nwg) return false;
        int wgid = (int)L; { const int q = nwg / NXCD, r = nwg % NXCD, xcd = wgid % NXCD, off = wgid / NXCD; wgid = (xcd < r ? xcd * (q + 1) : r * (q + 1) + (xcd - r) * q) + off; }
        const int nig = WGM * nN, gid = wgid / nig, fm = gid * WGM, gsz = (nM - fm) < WGM ? (nM - fm) : WGM;
        u.pm = fm + ((wgid % nig) % gsz); u.pn = (wgid % nig) / gsz; u.idx = i; return true;
    }
    __device__ __forceinline__ void a_ready(const Unit&) const {}
    __device__ __forceinline__ void done(const Unit&) const {}
};

template <class Epi, class Sched, class GemmT, bool ALIGN_EPI = false, bool SP2 = false>
__device__ __forceinline__ void gemm_phase(LAS unsigned char* lds, const GemmT g, const Sched& S, const Epi& E, int wave_) {
    const int tid = fresh_tid(wave_);
    const int wid = wave_, lane = tid & 63, wr = wid >> 2, wc = wid & 3, fr = lane & 15, fq = lane >> 4;
    constexpr int K = GemmT::K, nt = K / BK;
    unsigned voffA[2], voffB[2];
#pragma unroll
    for (int i = 0; i < 2; ++i) { int R, C; stage_rc(tid * 16 + i * 8192, R, C); const int Rb = Epi::PERM ? ((R & ~31) + perm32(R & 31)) : R;
        voffA[i] = (unsigned)(R * GemmT::lda + C) * 2u; voffB[i] = (unsigned)(Rb * GemmT::ldb + C) * 2u; }
    constexpr size_t kstep = (size_t)(BK * 2);
    constexpr size_t hstepA = (size_t)HALF * GemmT::lda * 2, hstepB = (size_t)HALF * GemmT::ldb * 2;
    constexpr size_t tstepA = 2 * hstepA, tstepB = 2 * hstepB;
    const unsigned ldsw = (unsigned)wid * 1024u;
    const int aoff = lds_byte(wr * 64 + fr, fq * 8), boff = lds_byte(wc * 32 + fr, fq * 8);
#define PG8_SA(b, h) (((b) * 2 + (h)) * HTB)
#define PG8_SB(b, h) ((4 + (b) * 2 + (h)) * HTB)
#define PG8_STAGE(bufoff, gbase, voff) do { _Pragma("unroll") for (int _i = 0; _i < 2; ++_i) \
        __builtin_amdgcn_global_load_lds((const unsigned*)((const char*)(gbase) + (voff)[_i]), (LAS unsigned*)(lds + (bufoff) + ldsw + _i * 8192), 16, 0, 0); } while (0)
#define PG8_LDA(dst, b, h) do { _Pragma("unroll") for (int m = 0; m < 4; ++m) _Pragma("unroll") for (int k = 0; k < 2; ++k) dst[m][k] = *(const LAS bf16x8*)(lds + PG8_SA(b, h) + aoff + m * 2048 + k * 1024); } while (0)
#define PG8_LDB(dst, b, h) do { _Pragma("unroll") for (int n = 0; n < 2; ++n) _Pragma("unroll") for (int k = 0; k < 2; ++k) dst[n][k] = *(const LAS bf16x8*)(lds + PG8_SB(b, h) + boff + n * 2048 + k * 1024); } while (0)
#define PG8_MMA(ai, bj, At, Bt) do { __builtin_amdgcn_s_setprio(1); _Pragma("unroll") for (int m = 0; m < 4; ++m) _Pragma("unroll") for (int n = 0; n < 2; ++n) _Pragma("unroll") for (int k = 0; k < 2; ++k) \
        acc[ai][bj][m][n] = __builtin_amdgcn_mfma_f32_16x16x32_bf16(Bt[n][k], At[m][k], acc[ai][bj][m][n], 0, 0, 0); __builtin_amdgcn_s_setprio(0); } while (0)
#define PG8_WAIT_V(n) asm volatile("s_waitcnt vmcnt(" #n ")" ::: "memory")
#define PG8_WAIT_L(n) asm volatile("s_waitcnt lgkmcnt(" #n ")" ::: "memory")
#define PG8_BAR __builtin_amdgcn_s_barrier()
#define PG8_SCHED __builtin_amdgcn_sched_barrier(0)
    Unit cur, nxt; int ui = 0;
    if (!S.next(0, cur)) return;
    f32x4 acc[2][2][4][2];
#pragma unroll
    for (int a = 0; a < 2; ++a)
#pragma unroll
        for (int b = 0; b < 2; ++b)
#pragma unroll
            for (int m = 0; m < 4; ++m)
#pragma unroll
                for (int n = 0; n < 2; ++n) acc[a][b][m][n] = (f32x4){0.f, 0.f, 0.f, 0.f};
    bf16x8 At[4][2], B0[2][2], B1[2][2];
    const char* cA = (const char*)g.A + (size_t)cur.pm * tstepA; const char* cB = (const char*)g.Bt + (size_t)cur.pn * tstepB;
    S.a_ready(cur);
    if constexpr (SP2) {
        PG8_STAGE(PG8_SB(0, 0), cB, voffB); PG8_STAGE(PG8_SB(0, 1), cB + hstepB, voffB); PG8_STAGE(PG8_SA(0, 0), cA, voffA); PG8_STAGE(PG8_SA(0, 1), cA + hstepA, voffA);
        if (wr == 1) PG8_BAR;
        PG8_WAIT_V(2); PG8_BAR;
        PG8_STAGE(PG8_SB(1, 0), cB + kstep, voffB); PG8_STAGE(PG8_SA(1, 0), cA + kstep, voffA); PG8_STAGE(PG8_SB(1, 1), cB + hstepB + kstep, voffB);
        PG8_WAIT_V(6); PG8_BAR;
    } else {
        PG8_STAGE(PG8_SB(0, 0), cB, voffB); PG8_STAGE(PG8_SA(0, 0), cA, voffA); PG8_STAGE(PG8_SB(0, 1), cB + hstepB, voffB); PG8_STAGE(PG8_SA(0, 1), cA + hstepA, voffA);
        if (wr == 1) PG8_BAR;
        PG8_WAIT_V(4); PG8_BAR;
        PG8_STAGE(PG8_SB(1, 0), cB + kstep, voffB); PG8_STAGE(PG8_SA(1, 0), cA + kstep, voffA); PG8_STAGE(PG8_SB(1, 1), cB + hstepB + kstep, voffB);
        PG8_WAIT_V(6); PG8_BAR;
    }
    for (;;) {
        const bool has_next = S.next(ui + 1, nxt);
        const char* nA = has_next ? (const char*)g.A + (size_t)nxt.pm * tstepA : cA; const char* nB = has_next ? (const char*)g.Bt + (size_t)nxt.pn * tstepB : cB;
        for (int t = 0; t < nt; t += 2) {
            const bool last = (t == nt - 2);
            const char* a1 = cA + (size_t)(t >> 1) * GemmT::k2A + kstep;
            const char* a2 = last ? nA : cA + (size_t)((t >> 1) + 1) * GemmT::k2A; const char* b2 = last ? nB : cB + (size_t)(t + 2) * kstep;
            const char* a3 = a2 + kstep; const char* b3 = b2 + kstep;
            if (last && has_next) S.a_ready(nxt);
            if constexpr (SP2) {
            PG8_LDB(B0, 0, 0); PG8_LDB(B1, 0, 1); PG8_SCHED; PG8_LDA(At, 0, 0); PG8_STAGE(PG8_SA(1, 1), a1 + hstepA, voffA);
            PG8_WAIT_V(8); PG8_WAIT_L(0); PG8_BAR; PG8_MMA(0, 0, At, B0); PG8_MMA(0, 1, At, B1); PG8_BAR; PG8_SCHED;
            PG8_LDA(At, 0, 1); PG8_STAGE(PG8_SB(0, 0), b2, voffB); PG8_STAGE(PG8_SB(0, 1), b2 + hstepB, voffB); PG8_STAGE(PG8_SA(0, 0), a2, voffA);
            PG8_WAIT_V(8); PG8_WAIT_L(0); PG8_BAR; PG8_MMA(1, 0, At, B0); PG8_MMA(1, 1, At, B1); PG8_BAR; PG8_SCHED;
            PG8_LDB(B0, 1, 0); PG8_LDB(B1, 1, 1); PG8_SCHED; PG8_LDA(At, 1, 0); PG8_STAGE(PG8_SA(0, 1), a2 + hstepA, voffA);
            PG8_WAIT_V(8); PG8_WAIT_L(0); PG8_BAR; PG8_MMA(0, 0, At, B0); PG8_MMA(0, 1, At, B1); PG8_BAR; PG8_SCHED;
            PG8_LDA(At, 1, 1); PG8_STAGE(PG8_SB(1, 0), b3, voffB); PG8_STAGE(PG8_SB(1, 1), b3 + hstepB, voffB); PG8_STAGE(PG8_SA(1, 0), a3, voffA);
            PG8_WAIT_V(8); PG8_WAIT_L(0); PG8_BAR; PG8_MMA(1, 0, At, B0); PG8_MMA(1, 1, At, B1); PG8_BAR; PG8_SCHED;
            } else {
            PG8_LDB(B0, 0, 0); PG8_SCHED; PG8_LDA(At, 0, 0); PG8_STAGE(PG8_SA(1, 1), a1 + hstepA, voffA);
            PG8_WAIT_L(8); PG8_BAR; PG8_WAIT_L(0); PG8_MMA(0, 0, At, B0); PG8_BAR; PG8_SCHED;
            PG8_LDB(B1, 0, 1); PG8_STAGE(PG8_SB(0, 0), b2, voffB);
            PG8_BAR; PG8_WAIT_L(0); PG8_MMA(0, 1, At, B1); PG8_BAR;
            PG8_LDA(At, 0, 1); PG8_STAGE(PG8_SA(0, 0), a2, voffA);
            PG8_BAR; PG8_WAIT_L(0); PG8_MMA(1, 0, At, B0); PG8_BAR; PG8_SCHED;
            PG8_STAGE(PG8_SB(0, 1), b2 + hstepB, voffB);
            PG8_WAIT_V(6); PG8_BAR; PG8_MMA(1, 1, At, B1); PG8_BAR;
            PG8_LDB(B0, 1, 0); PG8_SCHED; PG8_LDA(At, 1, 0); PG8_STAGE(PG8_SA(0, 1), a2 + hstepA, voffA);
            PG8_WAIT_L(8); PG8_BAR; PG8_WAIT_L(0); PG8_MMA(0, 0, At, B0); PG8_BAR; PG8_SCHED;
            PG8_LDB(B1, 1, 1); PG8_STAGE(PG8_SB(1, 0), b3, voffB);
            PG8_BAR; PG8_WAIT_L(0); PG8_MMA(0, 1, At, B1); PG8_BAR;
            PG8_LDA(At, 1, 1); PG8_STAGE(PG8_SA(1, 0), a3, voffA);
            PG8_BAR; PG8_WAIT_L(0); PG8_MMA(1, 0, At, B0); PG8_BAR; PG8_SCHED;
            PG8_STAGE(PG8_SB(1, 1), b3 + hstepB, voffB);
            PG8_WAIT_V(6); PG8_BAR; PG8_MMA(1, 1, At, B1); PG8_BAR;
            }
        }
        if constexpr (ALIGN_EPI) { if (wr == 0) PG8_BAR; }
        E(acc, cur, wr, wc, fr, fq); S.done(cur);
        if (!has_next) break;
#pragma unroll
        for (int a = 0; a < 2; ++a)
#pragma unroll
            for (int b = 0; b < 2; ++b)
#pragma unroll
                for (int m = 0; m < 4; ++m)
#pragma unroll
                    for (int n = 0; n < 2; ++n) acc[a][b][m][n] = (f32x4){0.f, 0.f, 0.f, 0.f};
        cur = nxt; cA = nA; cB = nB; ++ui;
        if constexpr (ALIGN_EPI) { if (wr == 1) PG8_BAR; }
    }
    PG8_WAIT_V(0);
    if constexpr (!ALIGN_EPI) { if (wr == 0) PG8_BAR; }
    PG8_BAR;
#undef PG8_SA
#undef PG8_SB
#undef PG8_STAGE
#undef PG8_LDA
#undef PG8_LDB
#undef PG8_MMA
#undef PG8_WAIT_V
#undef PG8_WAIT_L
#undef PG8_BAR
#undef PG8_SCHED
}
}

typedef unsigned short bf16;
typedef short bf16x8 __attribute__((ext_vector_type(8)));
typedef short s16x4 __attribute__((ext_vector_type(4)));
typedef float f32x4 __attribute__((ext_vector_type(4)));
typedef float f32x2 __attribute__((ext_vector_type(2)));
typedef unsigned u32x4 __attribute__((ext_vector_type(4)));
typedef unsigned u32x2 __attribute__((ext_vector_type(2)));
typedef _Float16 f16x2 __attribute__((ext_vector_type(2)));
typedef __bf16 bf16x2_t __attribute__((ext_vector_type(2)));
typedef short v4i16_t __attribute__((ext_vector_type(4)));

constexpr int NB = 8, SEQ = 4096, T = NB * SEQ, D = 1024, DEPTH = 2, DINP = 6160, DMIX = 2048, MEML = 256, MROWS = NB * MEML;
constexpr int NP = 6656;
constexpr int LDP = 6656;
constexpr size_t PGS = (size_t)32768 * 128;
__host__ __device__ constexpr size_t pgo(int col, int t) { return (size_t)(col >> 7) * PGS + (size_t)t * 128 + (col & 127); }
constexpr int C_GQ = 0, C_GK = 512, C_GG = 1024, C_GV = 1536, C_HQ = 2560, C_HLF = 3072, C_HI = 3584, C_XQ = 4096, C_SG = 4608;
constexpr float NORM_EPS = 1e-6f;
constexpr int NSEG = 8, SEGLEN = 512, NMC = SEGLEN / 64;
constexpr int N_MIX_UNITS = 512;
constexpr int N_XA_UNITS = 256;

constexpr size_t MiB = 1u << 20;
constexpr size_t WS_CTL = 0, CTL_ZERO_BYTES = 1 * MiB;
constexpr size_t WS_SSQ1 = 1 * MiB, WS_SSQ2 = 3 * MiB;
constexpr size_t WS_MKV = 5 * MiB;
constexpr size_t WS_W1T = 13 * MiB;
constexpr size_t WS_W2T = 27 * MiB;
constexpr size_t WS_XB = 31 * MiB;
constexpr size_t WS_SEND = WS_XB, WS_DTOT = WS_XB + 48 * MiB;
constexpr size_t WS_P = 95 * MiB;
constexpr size_t WS_END = WS_P + (size_t)T * LDP * 2;
static_assert(WS_END <= 512 * MiB, "workspace map");
constexpr size_t DO_MEMB = 0, DO_WKVT = 4 * MiB, DO_SSQ0 = 8 * MiB, DO_RSTDM = 10 * MiB;
constexpr int CW_BAR = 4096;
constexpr int CW_QUEUE = 2048;
constexpr size_t WS_HTAB = 512 * 1024;
constexpr int RSTD_OFF = 131072;
constexpr int LDS_BYTES = 147456, MISC_OFF = LDS_BYTES - 64;
static_assert(RSTD_OFF + 15 * 1024 <= MISC_OFF && (T / 256) * (NP / 256) <= 14 * 256, "rstd table: <= 14 tiles per workgroup");

#define LDS_WAIT() asm volatile("s_waitcnt lgkmcnt(0)" ::: "memory")
#define VM_WAIT() asm volatile("s_waitcnt vmcnt(0)" ::: "memory")
#define RLX_AGENT __ATOMIC_RELAXED, __HIP_MEMORY_SCOPE_AGENT
__device__ __forceinline__ unsigned f2bf(float f) { unsigned u = __builtin_bit_cast(unsigned, f); return (u + 0x7fffu + ((u >> 16) & 1u)) >> 16; }
__device__ __forceinline__ unsigned pk2(float lo, float hi) { f32x2 v = {lo, hi}; bf16x2_t b = __builtin_convertvector(v, bf16x2_t); return __builtin_bit_cast(unsigned, b); }
__device__ __forceinline__ unsigned pkh2(float lo, float hi) { f32x2 v = {lo, hi}; f16x2 h = __builtin_convertvector(v, f16x2); return __builtin_bit_cast(unsigned, h); }
__device__ __forceinline__ float bflo(unsigned w) { return __builtin_bit_cast(float, w << 16); }
__device__ __forceinline__ float bfhi(unsigned w) { return __builtin_bit_cast(float, w & 0xffff0000u); }
__device__ __forceinline__ float fexp(float x) { return __builtin_amdgcn_exp2f(x * 1.4426950408889634f); }
__device__ __forceinline__ float flog(float x) { return __builtin_amdgcn_logf(x) * 0.6931471805599453f; }
__device__ __forceinline__ float log_sigmoid(float z) { return fminf(z, 0.f) - flog(1.f + fexp(-fabsf(z))); }
__device__ __forceinline__ s16x4 tr16(const LAS unsigned char* p) { return __builtin_bit_cast(s16x4, __builtin_amdgcn_ds_read_tr16_b64_v4i16((LAS v4i16_t*)p)); }
__device__ __forceinline__ float wave_sum(float v) {
#pragma unroll
    for (int o = 1; o < 64; o <<= 1) v += __shfl_xor(v, o);
    return v;
}

#define XB_TMO      128
#define XB_XCNT(j)  (256  + 64 * (j))
#define XB_XSUB(j)  (1280 + 64 * (j))
#define XB_XGEN(j)  (2304 + 64 * (j))
#define XB_TOP      3328
#define XB_TOPGEN   3392
#define XCD_BAR_WORDS 3456
#define XB_SPIN_CAP (1u << 20)
__device__ __forceinline__ unsigned xb_ld(unsigned* p)              { return __hip_atomic_load(p, __ATOMIC_RELAXED, __HIP_MEMORY_SCOPE_AGENT); }
__device__ __forceinline__ unsigned xb_add(unsigned* p, unsigned v) { return __hip_atomic_fetch_add(p, v, __ATOMIC_RELAXED, __HIP_MEMORY_SCOPE_AGENT); }
__device__ __forceinline__ unsigned xb_xcc_id() { return (unsigned)__builtin_amdgcn_s_getreg((3 << 11) | 20) & 0xFu; }
#define XB_SPIN(cond, bar) do { unsigned _sp = 0; while (cond) { __builtin_amdgcn_s_sleep(1); \
    if ((++_sp & 255u) == 0u) { if (xb_ld(&(bar)[XB_TMO])) break; if (_sp > XB_SPIN_CAP) { atomicAdd(&(bar)[XB_TMO], 1u); break; } } } } while (0)
struct XcdBarrier { unsigned* bar; unsigned x; volatile LAS unsigned* st; int wave; };
__device__ __forceinline__ XcdBarrier xcd_barrier_post(unsigned* bar, volatile LAS unsigned* st, int wave) {
    XcdBarrier b; b.bar = bar; b.x = xb_xcc_id(); b.st = st; b.wave = wave;
    if (wave == 0 && lane_id() == 0) (void)xb_add(&bar[XB_XCNT(b.x)], 1u);
    return b;
}
__device__ __forceinline__ void xcd_barrier_complete(unsigned* bar, unsigned x, unsigned& nloc, unsigned& nx) {
    const unsigned G = gridDim.x * gridDim.y * gridDim.z;
    unsigned sum, cnt, mine, sp = 0u;
    for (;;) {
        sum = 0u; cnt = 0u; mine = 0u;
#pragma unroll 1
        for (unsigned j = 0; j < 16; ++j) { const unsigned c = xb_ld(&bar[XB_XCNT(j)]); sum += c; cnt += (c > 0u) ? 1u : 0u; mine = (j == x) ? c : mine; }
        if (sum == G) break;
        __builtin_amdgcn_s_sleep(1);
        if ((++sp & 255u) == 0u) { if (xb_ld(&bar[XB_TMO])) break; if (sp > XB_SPIN_CAP) { atomicAdd(&bar[XB_TMO], 1u); break; } }
    }
    nloc = mine > 0u ? mine : 1u; nx = cnt > 0u ? cnt : 1u;
}
__device__ __forceinline__ void xcd_barrier(const XcdBarrier& b) {
    asm volatile("s_waitcnt vmcnt(0)" ::: "memory");
    __syncthreads();
    if (b.wave == 0 && lane_id() == 0) {
        unsigned* bar = b.bar;
        __builtin_amdgcn_s_waitcnt(0);
        unsigned nloc = b.st[0], nx = b.st[1];
        if (nloc == 0u) { xcd_barrier_complete(bar, b.x, nloc, nx); b.st[0] = nloc; b.st[1] = nx; }
        const unsigned old = xb_add(&bar[XB_XSUB(b.x)], 1u);
        const unsigned gen = old / nloc;
        if (old + 1u == (gen + 1u) * nloc) {
            __builtin_amdgcn_fence(__ATOMIC_RELEASE, "agent");
            asm volatile("s_waitcnt vmcnt(0)" ::: "memory");
            const unsigned og = xb_add(&bar[XB_TOP], 1u);
            const unsigned tg = og / nx;
            if (og + 1u == (tg + 1u) * nx) xb_add(&bar[XB_TOPGEN], 1u);
            else XB_SPIN(xb_ld(&bar[XB_TOPGEN]) == tg, bar);
            __builtin_amdgcn_fence(__ATOMIC_ACQUIRE, "agent");
            xb_add(&bar[XB_XGEN(b.x)], 1u);
            asm volatile("s_waitcnt vmcnt(0)" ::: "memory");
        } else {
            XB_SPIN(xb_ld(&bar[XB_XGEN(b.x)]) == gen, bar);
            __builtin_amdgcn_fence(__ATOMIC_ACQUIRE, "agent");
            asm volatile("s_waitcnt vmcnt(0)" ::: "memory");
        }
    }
    __syncthreads();
}

struct Args {
    const float* x; const float* mem; const float* norm_w; const float* w_in; const float* gla_wup; const float* gla_b; const float* gla_nw; const float* hgrn_lb;
    const float* hgrn_nw; const float* mem_nw; const float* w_mkv; const float* xattn_nw; const float* w_out; const float* final_nw;
    float* out; unsigned char* ws; int ph_lo, ph_hi, probe, pad;
};
struct Frame {
    LAS unsigned char* lds; volatile LAS unsigned* MISC; unsigned* ctl;
    int wave, vcu, G;
};

__device__ __forceinline__ void tr_item(const float* W, int Nsrc, int srccol0, const float* kscale, float rscale, bf16* WT, int ldt, int dstrow0, int k0, LAS float* scr, int lane) {
    float wv_[32], ks_[32];
#pragma unroll
    for (int i = 0; i < 32; ++i) { const int kk = 2 * i + (lane >> 5); ks_[i] = kscale ? kscale[k0 + kk] : 1.f; wv_[i] = W[(size_t)(k0 + kk) * Nsrc + srccol0 + (lane & 31)]; }
#pragma unroll
    for (int i = 0; i < 32; ++i) { const int kk = 2 * i + (lane >> 5); scr[kk * 33 + (lane & 31)] = wv_[i] * ks_[i] * rscale; }
    LDS_WAIT(); asm volatile("" ::: "memory");
    const int c = lane & 7;
#pragma unroll
    for (int j = 0; j < 4; ++j) { const int n = (lane >> 3) + 8 * j; const LAS float* s = scr + (8 * c) * 33 + n;
        u32x4 o; o.x = pk2(s[0 * 33], s[1 * 33]); o.y = pk2(s[2 * 33], s[3 * 33]); o.z = pk2(s[4 * 33], s[5 * 33]); o.w = pk2(s[6 * 33], s[7 * 33]);
        *(u32x4*)(WT + (size_t)(dstrow0 + n) * ldt + k0 + 8 * c) = o; }
    LDS_WAIT(); asm volatile("" ::: "memory");
}
__device__ __forceinline__ void prep_w1(const Frame& F, const Args& a, int layer) {
    const int lane_ = fresh_tid(F.wave) & 63;
    LAS float* scr = (LAS float*)(F.lds + F.wave * 16384);
    const int gw = F.vcu * 8 + F.wave, NGW = F.G * 8;
    const float* W = a.w_in + (size_t)layer * D * DINP; const float* nw = a.norm_w + layer * D; bf16* WT = (bf16*)(a.ws + WS_W1T);
    constexpr int NBLK = (NP - 512) / 32;
    for (int it = gw; it < NBLK * 16; it += NGW) {
        const int kb = it & 15; int nb = it >> 4; if (nb >= 32) nb += 16;
        const int n0 = nb * 32; const int src = n0 < 1024 ? n0 : (n0 < 2560 ? n0 - 512 : n0 - 496);
        const float rs = (n0 < 512 || (n0 >= 4096 && n0 < 4608)) ? 0.08838834764831845f : 1.f;
        tr_item(W, DINP, src, nw, rs, WT, D, n0, kb * 64, scr, lane_);
    }
    const float* wup = a.gla_wup + (size_t)layer * 16 * 512;
    for (int it = gw; it < 512 * 2; it += NGW) {
        const int c = it >> 1, ko = ((it & 1) * 64 + lane_) * 8;
        float up[16];
#pragma unroll
        for (int r = 0; r < 16; ++r) up[r] = wup[r * 512 + c];
        float o[8];
#pragma unroll
        for (int kk = 0; kk < 8; ++kk) { const float* wr_ = W + (size_t)(ko + kk) * DINP + 2048; float s = 0.f;
#pragma unroll
            for (int r4 = 0; r4 < 4; ++r4) { const f32x4 w4 = *(const f32x4*)(wr_ + 4 * r4); s += w4.x * up[4 * r4] + w4.y * up[4 * r4 + 1] + w4.z * up[4 * r4 + 2] + w4.w * up[4 * r4 + 3]; }
            o[kk] = s * nw[ko + kk]; }
        u32x4 w; w.x = pk2(o[0], o[1]); w.y = pk2(o[2], o[3]); w.z = pk2(o[4], o[5]); w.w = pk2(o[6], o[7]);
        *(u32x4*)(WT + (size_t)(1024 + c) * D + ko) = w;
    }
}
__device__ __forceinline__ void prep_w2(const Frame& F, const Args& a, int layer) {
    const int lane_ = fresh_tid(F.wave) & 63;
    LAS float* scr = (LAS float*)(F.lds + F.wave * 16384);
    const int gw = F.vcu * 8 + F.wave, NGW = F.G * 8;
    const float* W = a.w_out + (size_t)layer * DMIX * D; bf16* WT = (bf16*)(a.ws + WS_W2T);
    for (int it = gw; it < 32 * 32; it += NGW) { const int kb = it & 31, nb = it >> 5; tr_item(W, D, nb * 32, nullptr, 1.f, WT, DMIX, nb * 32, kb * 64, scr, lane_); }
}
__device__ __forceinline__ void prep_wkv(const Frame& F, const Args& a) {
    const int lane_ = fresh_tid(F.wave) & 63;
    LAS float* scr = (LAS float*)(F.lds + F.wave * 16384);
    const int gw = F.vcu * 8 + F.wave, NGW = F.G * 8;
    bf16* WT = (bf16*)((unsigned char*)a.out + DO_WKVT);
    for (int it = gw; it < 2 * 32 * 16; it += NGW) { const int layer = it >> 9, r = it & 511, kb = r & 15, nb = r >> 4;
        tr_item(a.w_mkv + (size_t)layer * D * 1024, 1024, nb * 32, a.mem_nw + layer * D, 1.f, WT, D, layer * 1024 + nb * 32, kb * 64, scr, lane_); }
}
template <int RB>
__device__ __forceinline__ void rows_to_bf16(const float* x0, bf16* o0, int lane, float (&ss)[RB]) {
    f32x4 v[RB][4];
#pragma unroll
    for (int r = 0; r < RB; ++r)
#pragma unroll
        for (int j = 0; j < 4; ++j) v[r][j] = *((const f32x4*)(x0 + (size_t)r * D) + lane + 64 * j);
#pragma unroll
    for (int r = 0; r < RB; ++r) { float s = 0.f; u32x2* o8 = (u32x2*)(o0 + (size_t)r * D) + lane;
#pragma unroll
        for (int j = 0; j < 4; ++j) { s += (v[r][j].x * v[r][j].x + v[r][j].y * v[r][j].y) + (v[r][j].z * v[r][j].z + v[r][j].w * v[r][j].w); u32x2 w; w.x = pk2(v[r][j].x, v[r][j].y); w.y = pk2(v[r][j].z, v[r][j].w); o8[64 * j] = w; }
        ss[r] = wave_sum(s); }
}
__device__ __forceinline__ void prep_x(const Frame& F, const Args& a) {
    const int lane_ = fresh_tid(F.wave) & 63;
    const int gw = F.vcu * 8 + F.wave, NGW = F.G * 8;
    if (gw < 16) {
        float* ht = (float*)(a.ws + WS_HTAB); const int c = (gw & 7) * 64 + lane_, l = gw >> 3; float lb = 0.f;
        if (l == 1) { const float h0 = a.hgrn_lb[c], h1 = a.hgrn_lb[512 + c]; lb = 1.f / (1.f + expf(h0 - h1)); }
        ht[l * 1024 + c] = logf(fmaxf(lb, 1e-30f)); ht[l * 1024 + 512 + c] = log1pf(-lb); }
    bf16* xb = (bf16*)(a.ws + WS_XB); float* ssq0 = (float*)((unsigned char*)a.out + DO_SSQ0);
    for (int m = 8 * gw; m < T; m += 8 * NGW) { float ss[8]; rows_to_bf16<8>(a.x + (size_t)m * D, xb + (size_t)m * D, lane_, ss);
#pragma unroll
        for (int r = 0; r < 8; ++r) if (lane_ < 16) ssq0[(size_t)(m + r) * 16 + lane_] = lane_ == 0 ? ss[r] : 0.f; }
    bf16* memb = (bf16*)((unsigned char*)a.out + DO_MEMB); float* rstdm = (float*)((unsigned char*)a.out + DO_RSTDM);
    for (int m = gw; m < MROWS; m += NGW) { float ss[1]; rows_to_bf16<1>(a.mem + (size_t)m * D, memb + (size_t)m * D, lane_, ss);
        if (lane_ == 0) rstdm[m] = 1.0f / sqrtf(ss[0] * (1.f / D) + NORM_EPS); }
}

struct EpiProj {
    static constexpr bool PERM = true;
    int dry;
    bf16* P; const LAS float* rstd_lds; const float* gbias; const float* htab;
    template <int KIND>
    __device__ __forceinline__ void store_tile(const f32x4 (&acc)[2][2][4][2], bf16* rowp0, const LAS float* rsp, int cbase, int fq) const {
#pragma unroll
        for (int ai = 0; ai < 2; ++ai)
#pragma unroll
            for (int m = 0; m < 4; ++m) {
                const float rs = rsp[ai * 128 + m * 16];
#pragma unroll
                for (int bj = 0; bj < 2; ++bj) { float v[8];
#pragma unroll
                    for (int e = 0; e < 4; ++e) { v[e] = acc[ai][bj][m][0][e] * rs; v[4 + e] = acc[ai][bj][m][1][e] * rs; }
                    u32x4 w;
                    if (KIND == 0) { w.x = pk2(v[0], v[1]); w.y = pk2(v[2], v[3]); w.z = pk2(v[4], v[5]); w.w = pk2(v[6], v[7]); }
                    else if (KIND == 3) {
#pragma unroll
                        for (int e = 0; e < 8; ++e) v[e] = v[e] * __builtin_amdgcn_rcpf(1.f + fexp(-v[e]));
                        w.x = pk2(v[0], v[1]); w.y = pk2(v[2], v[3]); w.z = pk2(v[4], v[5]); w.w = pk2(v[6], v[7]); }
                    else if (KIND == 1) { const f32x4 b0 = *(const f32x4*)(gbias + cbase + bj * 128), b1 = *(const f32x4*)(gbias + cbase + bj * 128 + 4);
#pragma unroll
                        for (int e = 0; e < 8; ++e) v[e] = log_sigmoid(v[e] + (e < 4 ? b0[e & 3] : b1[e & 3])) * (0.0625f * 1.4426950408889634f);
                        w.x = pkh2(v[0], v[1]); w.y = pkh2(v[2], v[3]); w.z = pkh2(v[4], v[5]); w.w = pkh2(v[6], v[7]); }
                    else { const f32x4 a0 = *(const f32x4*)(htab + cbase + bj * 128), a1 = *(const f32x4*)(htab + cbase + bj * 128 + 4), c0 = *(const f32x4*)(htab + 512 + cbase + bj * 128), c1 = *(const f32x4*)(htab + 512 + cbase + bj * 128 + 4);
#pragma unroll
                        for (int e = 0; e < 8; ++e) { const float aa = e < 4 ? a0[e & 3] : a1[e & 3], bb = (e < 4 ? c0[e & 3] : c1[e & 3]) + log_sigmoid(v[e]); const float mx = fmaxf(aa, bb);
                            v[e] = (mx + flog(1.f + fexp(-fabsf(aa - bb)))) * 1.4426950408889634f; }
                        w.x = pkh2(v[0], v[1]); w.y = pkh2(v[2], v[3]); w.z = pkh2(v[4], v[5]); w.w = pkh2(v[6], v[7]); }
                    if (dry != 2) *(u32x4*)(rowp0 + (size_t)(ai * 128 + m * 16) * 128 + (size_t)bj * PGS) = w; else asm volatile("" :: "v"(w)); }
            }
    }
    __device__ __forceinline__ void operator()(const f32x4 (&acc)[2][2][4][2], const pg8::Unit& u, int wr, int wc, int fr, int fq) const {
        if (dry == 1) return;
        const int pn = u.pn; int kind, dcol, cb0 = 0;
        if (pn < 2) { kind = 0; dcol = C_GQ + 256 * pn; } else if (pn < 4) { kind = 0; dcol = C_GK + 256 * (pn - 2); } else if (pn < 6) { kind = 1; dcol = C_GG + 256 * (pn - 4); cb0 = 256 * (pn - 4); }
        else if (pn < 10) { kind = 0; dcol = C_GV + 256 * (pn - 6); } else if (pn < 12) { kind = 0; dcol = C_HQ + 256 * (pn - 10); } else if (pn < 14) { kind = 2; dcol = C_HLF + 256 * (pn - 12); cb0 = 256 * (pn - 12); }
        else if (pn < 16) { kind = 0; dcol = C_HI + 256 * (pn - 14); } else if (pn < 18) { kind = 0; dcol = C_XQ + 256 * (pn - 16); } else { kind = 3; dcol = C_SG + 256 * (pn - 18); }
        const int row0 = u.pm * 256 + wr * 64 + fr;
        const int cw = wc * 32 + 8 * fq;
        bf16* rowp0 = P + pgo(dcol, row0) + cw; const LAS float* rsp = rstd_lds + u.idx * 256 + wr * 64 + fr;
        if (kind == 0) store_tile<0>(acc, rowp0, rsp, 0, fq);
        else if (kind == 3) store_tile<3>(acc, rowp0, rsp, 0, fq);
        else if (kind == 1) store_tile<1>(acc, rowp0, rsp, cb0 + cw, fq);
        else store_tile<2>(acc, rowp0, rsp, cb0 + cw, fq);
    }
};
struct EpiMem {
    static constexpr bool PERM = true;
    bf16* O; const float* rstdm;
    __device__ __forceinline__ void operator()(const f32x4 (&acc)[2][2][4][2], const pg8::Unit& u, int wr, int wc, int fr, int fq) const {
        const int row0 = u.pm * 256 + wr * 64 + fr, col0 = u.pn * 256 + wc * 32 + 8 * fq;
#pragma unroll
        for (int ai = 0; ai < 2; ++ai)
#pragma unroll
            for (int m = 0; m < 4; ++m) { const int row = row0 + ai * 128 + m * 16; const float rs = rstdm[row]; bf16* rowp = O + (size_t)row * 2048 + col0;
#pragma unroll
                for (int bj = 0; bj < 2; ++bj) { const f32x4 v0 = acc[ai][bj][m][0] * rs, v1 = acc[ai][bj][m][1] * rs; u32x4 w;
                    w.x = pk2(v0[0], v0[1]); w.y = pk2(v0[2], v0[3]); w.z = pk2(v1[0], v1[1]); w.w = pk2(v1[2], v1[3]); *(u32x4*)(rowp + bj * 128) = w; } }
    }
};
struct EpiRes {
    static constexpr bool PERM = false;
    const float* resid; float* out; bf16* xb; float* ssq;
    __device__ __forceinline__ void operator()(const f32x4 (&acc)[2][2][4][2], const pg8::Unit& u, int wr, int wc, int fr, int fq) const {
        const int row0 = u.pm * 256 + wr * 64 + fr, col0 = u.pn * 256 + wc * 32 + 4 * fq;
        f32x4 rn[2][2];
#pragma unroll
        for (int bj = 0; bj < 2; ++bj)
#pragma unroll
            for (int n = 0; n < 2; ++n) rn[bj][n] = *(const f32x4*)(resid + (size_t)row0 * D + col0 + bj * 128 + n * 16);
#pragma unroll
        for (int s8 = 0; s8 < 8; ++s8) { const int ai = s8 >> 2, m = s8 & 3; const int row = row0 + ai * 128 + m * 16; const size_t off = (size_t)row * D + col0; float ss = 0.f;
            f32x4 rc[2][2];
#pragma unroll
            for (int bj = 0; bj < 2; ++bj)
#pragma unroll
                for (int n = 0; n < 2; ++n) rc[bj][n] = rn[bj][n];
            if (s8 < 7) { const int ai2 = (s8 + 1) >> 2, m2 = (s8 + 1) & 3; const size_t off2 = (size_t)(row0 + ai2 * 128 + m2 * 16) * D + col0;
#pragma unroll
                for (int bj = 0; bj < 2; ++bj)
#pragma unroll
                    for (int n = 0; n < 2; ++n) rn[bj][n] = *(const f32x4*)(resid + off2 + bj * 128 + n * 16); }
#pragma unroll
            for (int bj = 0; bj < 2; ++bj)
#pragma unroll
                for (int n = 0; n < 2; ++n) { const f32x4 o = rc[bj][n] + acc[ai][bj][m][n];
                    *(f32x4*)(out + off + bj * 128 + n * 16) = o; u32x2 w; w.x = pk2(o[0], o[1]); w.y = pk2(o[2], o[3]); *(u32x2*)(xb + off + bj * 128 + n * 16) = w;
                    ss += (o[0] * o[0] + o[1] * o[1]) + (o[2] * o[2] + o[3] * o[3]); }
            ss += __shfl_xor(ss, 16); ss += __shfl_xor(ss, 32);
            if (fq == 0) ssq[(size_t)row * 16 + u.pn * 4 + wc] = ss; }
    }
};

namespace mx {
constexpr int RSB = 272;
constexpr int TILE_BYTES = 64 * RSB;
constexpr int OFF_Q = 0, OFF_K = TILE_BYTES, OFF_K2 = 2 * TILE_BYTES, OFF_V = 3 * TILE_BYTES;
constexpr int OFF_DC = OFF_V + 64 * 528, OFF_END = OFF_DC + 2048;
static_assert(OFF_END <= MISC_OFF && 64 * 260 * 4 <= OFF_DC, "mixer LDS map");

template <int PASS, int KIND>
__device__ __forceinline__ void mix_unit(const Frame& F, const Args& a, int u, int layer, bool dry) {
    constexpr int NVT = KIND == 0 ? 2 : 1, DV = 128 * NVT, VRS = DV * 2 + 16, OSS = DV + 4, NVP = 2 * NVT  , NGP = 2 * NVT  ;
    const int tid = fresh_tid(F.wave), lane = tid & 63, w = F.wave;
    const int li = lane & 15, g4 = lane >> 4, q_ = li >> 2, p_ = li & 3;
    const int ul = KIND == 0 ? u : u - 256, b = ul >> 5, hd = (ul >> 3) & 3, seg = ul & 7;
    const int t0 = b * SEQ + seg * SEGLEN;
    const int qcol = KIND == 0 ? C_GQ + hd * 128 : C_HQ + hd * 128, kcol = C_GK + hd * 128, gcol = KIND == 0 ? C_GG + hd * 128 : C_HLF + hd * 128;
    const int vcol = KIND == 0 ? C_GV + hd * 256 : C_HI + hd * 128, ocol = KIND == 0 ? C_SG + hd * 256 : C_SG + 1024 + hd * 128;
    const float* nw = KIND == 0 ? a.gla_nw + layer * 256 : a.hgrn_nw + layer * 128;
    LAS unsigned char* L = F.lds;
    const bf16* P = (const bf16*)(a.ws + WS_P);
    float* SEND = (float*)(a.ws + WS_SEND) + (KIND == 0 ? (size_t)ul * 32768 : (size_t)256 * 32768 + (size_t)ul * 16384);
    float* DTOT = (float*)(a.ws + WS_DTOT) + (size_t)u * 128;
    constexpr int SEND_UNIT = KIND == 0 ? 32768 : 16384;
    f32x4 S[8][NVT];
#pragma unroll
    for (int dt = 0; dt < 8; ++dt)
#pragma unroll
        for (int vt = 0; vt < NVT; ++vt) S[dt][vt] = (f32x4){0.f, 0.f, 0.f, 0.f};
    if (PASS == 1 && !(dry && (PROBE_SUB & 1))) {
        const float* sp = SEND + (size_t)(w * 8 * NVT) * 256 + lane * 4;
#pragma unroll
        for (int dt = 0; dt < 8; ++dt)
#pragma unroll
            for (int vt = 0; vt < NVT; ++vt) S[dt][vt] = *(const f32x4*)(sp + (dt * NVT + vt) * 256);
    }
    const int ca = w >> 1, th = w & 1;
    unsigned gw_[16], kw_[8], qw_[8]; u32x4 vv[NVP];
    unsigned gwn[16], kwn[8], qwn[8]; u32x4 vvn[NVP];
#define MX_LOADS(mc_) do { const size_t ro_ = (size_t)(t0 + (mc_) * 64 + 16 * ca) * 128 + 2 * lane;     \
        const bf16* gp_ = P + (size_t)(gcol >> 7) * PGS + ro_; const bf16* kp_ = P + (size_t)(kcol >> 7) * PGS + ro_; const bf16* qp_ = P + (size_t)(qcol >> 7) * PGS + ro_; \
        _Pragma("unroll") for (int j = 0; j < 8; ++j) { gwn[j] = *(const unsigned*)(gp_ + (8 * th + j) * 128); gwn[8 + j] = *(const unsigned*)(gp_ + (8 - 8 * th + j) * 128); } \
        if (KIND == 0) { _Pragma("unroll") for (int j = 0; j < 8; ++j) kwn[j] = *(const unsigned*)(kp_ + (8 * th + j) * 128); } \
        if (PASS == 1) { _Pragma("unroll") for (int j = 0; j < 8; ++j) qwn[j] = *(const unsigned*)(qp_ + (8 * th + j) * 128); } \
        _Pragma("unroll") for (int i = 0; i < NVP; ++i) { const int p = tid + 512 * i, r = p / (DV / 8), c8 = p % (DV / 8); vvn[i] = *(const u32x4*)(P + (size_t)((vcol >> 7) + (c8 >> 4)) * PGS + (size_t)(t0 + (mc_) * 64 + r) * 128 + 8 * (c8 & 15)); } } while (0)
    if (!(dry && (PROBE_SUB & 16))) MX_LOADS(0);
    float lt0 = 0.f, lt1 = 0.f;
#define MX_BARRIER() do { asm volatile("s_waitcnt lgkmcnt(0)" ::: "memory"); __builtin_amdgcn_s_barrier(); asm volatile("" ::: "memory"); } while (0)
    for (int mc = 0; mc < NMC; ++mc) {
        const int tb = t0 + mc * 64;
#pragma unroll
        for (int j = 0; j < 16; ++j) gw_[j] = gwn[j];
#pragma unroll
        for (int j = 0; j < 8; ++j) { kw_[j] = kwn[j]; qw_[j] = qwn[j]; }
#pragma unroll
        for (int i = 0; i < NVP; ++i) vv[i] = vvn[i];
        if (mc + 1 < NMC && !(dry && (PROBE_SUB & 16))) MX_LOADS(mc + 1);
        if (!(dry && (PROBE_SUB & 2))) {
#pragma unroll
            for (int i = 0; i < NVP; ++i) { const int p = tid + 512 * i, r = p / (DV / 8), c8 = p % (DV / 8); *(LAS u32x4*)(L + OFF_V + r * VRS + c8 * 16) = vv[i]; }
            float go0[8], go1[8], k0[8], k1[8];
            float ot0 = 0.f, ot1 = 0.f, ow0 = 0.f, ow1 = 0.f;
#pragma unroll
            for (int j = 0; j < 8; ++j) { const f16x2 gh = __builtin_bit_cast(f16x2, gw_[j]), gx = __builtin_bit_cast(f16x2, gw_[8 + j]); go0[j] = (float)gh.x; go1[j] = (float)gh.y;
                ow0 += go0[j]; ow1 += go1[j]; ot0 += (float)gx.x; ot1 += (float)gx.y;
                if (KIND == 0) { k0[j] = bflo(kw_[j]); k1[j] = bfhi(kw_[j]); } else { k0[j] = 1.f - __builtin_amdgcn_exp2f(go0[j]); k1[j] = 1.f - __builtin_amdgcn_exp2f(go1[j]); } }
            const float lo0 = th ? ot0 : 0.f, lo1 = th ? ot1 : 0.f, hi0 = th ? 0.f : ot0, hi1 = th ? 0.f : ot1;
            const int row0 = 16 * ca + 8 * th;
            if (PASS == 1) {
                float r0 = lo0, r1 = lo1;
#pragma unroll
                for (int j = 0; j < 8; ++j) { r0 += go0[j]; r1 += go1[j];
                    const float q0 = bflo(qw_[j]) * __builtin_amdgcn_exp2f(r0), q1 = bfhi(qw_[j]) * __builtin_amdgcn_exp2f(r1);
                    const float kh0 = k0[j] * __builtin_amdgcn_exp2f(fminf(-r0, 115.f)), kh1 = k1[j] * __builtin_amdgcn_exp2f(fminf(-r1, 115.f));
                    *(LAS unsigned*)(L + OFF_Q + (row0 + j) * RSB + lane * 4) = pk2(q0, q1);
                    *(LAS unsigned*)(L + OFF_K + (row0 + j) * RSB + lane * 4) = pk2(kh0, kh1); }
            }
            float s0 = hi0, s1 = hi1;
#pragma unroll
            for (int j = 7; j >= 0; --j) { *(LAS unsigned*)(L + OFF_K2 + (row0 + j) * RSB + lane * 4) = pk2(k0[j] * __builtin_amdgcn_exp2f(s0), k1[j] * __builtin_amdgcn_exp2f(s1)); s0 += go0[j]; s1 += go1[j]; }
            const float tt0 = ow0 + ot0, tt1 = ow1 + ot1;
            if (th == 0) { f32x2 dd; dd.x = __builtin_amdgcn_exp2f(tt0); dd.y = __builtin_amdgcn_exp2f(tt1); *(LAS f32x2*)(L + OFF_DC + ca * 512 + lane * 8) = dd; }
            lt0 += tt0; lt1 += tt1;
        }
        MX_BARRIER();
        const int ei = tid >> 3, ve = tid & 7;
        bf16* orow = (bf16*)P + (size_t)(ocol >> 7) * PGS + (size_t)(tb + ei) * 128 + 8 * ve;
        u32x4 gt[NGP];
        if (PASS == 1) {
#pragma unroll
            for (int k = 0; k < NGP; ++k) gt[k] = *(const u32x4*)(orow + (size_t)(k >> 1) * PGS + 64 * (k & 1));
        }
        f32x4 oc[4][NVT];
        if (!(dry && (PROBE_SUB & 4))) {
#pragma unroll
        for (int c = 0; c < 4; ++c) {
            const int rb = 16 * c;
            bf16x8 vb[NVT];
#pragma unroll
            for (int vt = 0; vt < NVT; ++vt) { const s16x4 t4 = tr16(L + OFF_V + (rb + 4 * g4 + q_) * VRS + (16 * NVT * w + 16 * vt + 4 * p_) * 2); vb[vt] = (bf16x8){t4[0], t4[1], t4[2], t4[3], 0, 0, 0, 0}; }
            if (PASS == 1) {
                f32x4 at = (f32x4){0.f, 0.f, 0.f, 0.f};
#pragma unroll
                for (int ks = 0; ks < 4; ++ks) { const bf16x8 ka = *(const LAS bf16x8*)(L + OFF_K + (rb + li) * RSB + (32 * ks + 8 * g4) * 2); const bf16x8 qb = *(const LAS bf16x8*)(L + OFF_Q + (rb + li) * RSB + (32 * ks + 8 * g4) * 2);
                    at = __builtin_amdgcn_mfma_f32_16x16x32_bf16(ka, qb, at, 0, 0, 0); }
#pragma unroll
                for (int r = 0; r < 4; ++r) at[r] = (4 * g4 + r <= li) ? at[r] : 0.f;
                const bf16x8 pa = __builtin_bit_cast(bf16x8, (u32x4){pk2(at[0], at[1]), pk2(at[2], at[3]), 0u, 0u});
                f32x4 o[NVT];
#pragma unroll
                for (int vt = 0; vt < NVT; ++vt) o[vt] = __builtin_amdgcn_mfma_f32_16x16x32_bf16(pa, vb[vt], (f32x4){0.f, 0.f, 0.f, 0.f}, 0, 0, 0);
#pragma unroll
                for (int ks = 0; ks < 4; ++ks) {
                    const u32x2 qa0 = *(const LAS u32x2*)(L + OFF_Q + (rb + li) * RSB + (32 * ks + 4 * g4) * 2), qa1 = *(const LAS u32x2*)(L + OFF_Q + (rb + li) * RSB + (32 * ks + 16 + 4 * g4) * 2);
                    const bf16x8 qa = __builtin_bit_cast(bf16x8, (u32x4){qa0.x, qa0.y, qa1.x, qa1.y});
#pragma unroll
                    for (int vt = 0; vt < NVT; ++vt) {
                        const bf16x8 sb = __builtin_bit_cast(bf16x8, (u32x4){pk2(S[2 * ks][vt][0], S[2 * ks][vt][1]), pk2(S[2 * ks][vt][2], S[2 * ks][vt][3]), pk2(S[2 * ks + 1][vt][0], S[2 * ks + 1][vt][1]), pk2(S[2 * ks + 1][vt][2], S[2 * ks + 1][vt][3])});
                        o[vt] = __builtin_amdgcn_mfma_f32_16x16x32_bf16(qa, sb, o[vt], 0, 0, 0); } }
#pragma unroll
                for (int vt = 0; vt < NVT; ++vt) oc[c][vt] = o[vt];
            }
#pragma unroll
            for (int dt = 0; dt < 8; ++dt) { const s16x4 t4 = tr16(L + OFF_K2 + (rb + 4 * g4 + q_) * RSB + (16 * dt + 4 * p_) * 2); const bf16x8 ka = (bf16x8){t4[0], t4[1], t4[2], t4[3], 0, 0, 0, 0};
                const f32x4 dv = *(const LAS f32x4*)(L + OFF_DC + c * 512 + (16 * dt + 4 * g4) * 4);
#pragma unroll
                for (int vt = 0; vt < NVT; ++vt) S[dt][vt] = __builtin_amdgcn_mfma_f32_16x16x32_bf16(ka, vb[vt], S[dt][vt] * dv, 0, 0, 0); }
        }
        }
        MX_BARRIER();
        if (PASS == 1 && !(dry && (PROBE_SUB & 12))) {
            LAS float* Os = (LAS float*)L;
#pragma unroll
            for (int c = 0; c < 4; ++c)
#pragma unroll
                for (int vt = 0; vt < NVT; ++vt)
#pragma unroll
                    for (int r = 0; r < 4; ++r) Os[(16 * c + 4 * g4 + r) * OSS + 16 * NVT * w + 16 * vt + li] = oc[c][vt][r];
            MX_BARRIER();
            f32x4 ov[2 * NGP]; float ss = 0.f;
#pragma unroll
            for (int k = 0; k < NGP; ++k) { ov[2 * k] = *(const LAS f32x4*)(Os + ei * OSS + 64 * k + 8 * ve); ov[2 * k + 1] = *(const LAS f32x4*)(Os + ei * OSS + 64 * k + 8 * ve + 4);
                ss += (ov[2 * k].x * ov[2 * k].x + ov[2 * k].y * ov[2 * k].y) + (ov[2 * k].z * ov[2 * k].z + ov[2 * k].w * ov[2 * k].w) + (ov[2 * k + 1].x * ov[2 * k + 1].x + ov[2 * k + 1].y * ov[2 * k + 1].y) + (ov[2 * k + 1].z * ov[2 * k + 1].z + ov[2 * k + 1].w * ov[2 * k + 1].w); }
            MX_BARRIER();
            ss += __shfl_xor(ss, 1); ss += __shfl_xor(ss, 2); ss += __shfl_xor(ss, 4);
            const float rstd = __builtin_amdgcn_rsqf(ss * (1.f / DV) + NORM_EPS);
#pragma unroll
            for (int k = 0; k < NGP; ++k) { const f32x4 w0 = *(const f32x4*)(nw + 64 * k + 8 * ve), w1 = *(const f32x4*)(nw + 64 * k + 8 * ve + 4); const f32x4 a0 = ov[2 * k], a1 = ov[2 * k + 1]; const u32x4 gg = gt[k];
                u32x4 wv; wv.x = pk2(a0.x * rstd * w0.x * bflo(gg.x), a0.y * rstd * w0.y * bfhi(gg.x)); wv.y = pk2(a0.z * rstd * w0.z * bflo(gg.y), a0.w * rstd * w0.w * bfhi(gg.y));
                wv.z = pk2(a1.x * rstd * w1.x * bflo(gg.z), a1.y * rstd * w1.y * bfhi(gg.z)); wv.w = pk2(a1.z * rstd * w1.z * bflo(gg.w), a1.w * rstd * w1.w * bfhi(gg.w));
                if (!dry) *(u32x4*)(orow + (size_t)(k >> 1) * PGS + 64 * (k & 1)) = wv; }
        }
    }
#undef MX_LOADS
#undef MX_BARRIER
    if (PASS == 0) {
        float* sp = SEND + (size_t)(w * 8 * NVT) * 256 + lane * 4;
#pragma unroll
        for (int dt = 0; dt < 8; ++dt)
#pragma unroll
            for (int vt = 0; vt < NVT; ++vt) *(f32x4*)(sp + (dt * NVT + vt) * 256) = S[dt][vt];
        LAS float* LT = (LAS float*)(L + OFF_DC);
        if (th == 0) { f32x2 lt; lt.x = lt0; lt.y = lt1; *(LAS f32x2*)(L + OFF_DC + ca * 512 + lane * 8) = lt; }
        LDS_WAIT(); __syncthreads();
        if (tid < 128) DTOT[tid] = __builtin_amdgcn_exp2f(LT[tid] + LT[128 + tid] + LT[256 + tid] + LT[384 + tid]);
        LDS_WAIT(); __syncthreads();
    }
}

__device__ __forceinline__ void scan_states(const Frame& F, const Args& a) {
    const int tid = fresh_tid(F.wave);
    float* SENDB = (float*)(a.ws + WS_SEND); const float* DT = (const float*)(a.ws + WS_DTOT);
    constexpr int NG = 32 * 8192, NH = 32 * 4096;
    for (int idx = F.vcu * 512 + tid; idx < NG + NH; idx += F.G * 512) {
        float* base; const float* dtb; size_t stride; int d0;
        if (idx < NG) { const int grp = idx >> 13, p = idx & 8191; base = SENDB + (size_t)(grp * 8) * 32768 + (size_t)p * 4; stride = 32768; dtb = DT + (size_t)(grp * 8) * 128; d0 = 16 * ((p >> 7) & 7) + 4 * ((p & 63) >> 4); }
        else { const int j = idx - NG, grp = j >> 12, p = j & 4095; base = SENDB + (size_t)256 * 32768 + (size_t)(grp * 8) * 16384 + (size_t)p * 4; stride = 16384; dtb = DT + (size_t)(256 + grp * 8) * 128; d0 = 16 * ((p >> 6) & 7) + 4 * ((p & 63) >> 4); }
        f32x4 cur[7], dv[7];
#pragma unroll
        for (int sg = 0; sg < 7; ++sg) { cur[sg] = *(const f32x4*)(base + sg * stride); dv[sg] = *(const f32x4*)(dtb + sg * 128 + d0); }
        float z_; asm volatile("v_mov_b32 %0, 0" : "=v"(z_));
        f32x4 run = (f32x4){z_, z_, z_, z_};
#pragma unroll
        for (int sg = 0; sg < 8; ++sg) { *(f32x4*)(base + sg * stride) = run; if (sg < 7) run = run * dv[sg] + cur[sg]; }
    }
}
}

namespace xa {
constexpr int RSB = 272;
constexpr int OFF_KX = 0, OFF_VX = 256 * RSB;
static_assert(2 * 256 * RSB <= MISC_OFF, "xattn LDS map");
__device__ __forceinline__ void xa_unit(const Frame& F, const Args& a, int x, int layer, bool dry) {
    const int tid = fresh_tid(F.wave);
    const int lane = tid & 63, wid = F.wave, li = lane & 15, g4 = lane >> 4, q_ = li >> 2, p_ = li & 3;
    const int b = x >> 5, h = (x >> 3) & 3, tr = x & 7, t0 = b * SEQ + tr * 512 + wid * 64;
    LAS unsigned char* L = F.lds;
    bf16* P = (bf16*)(a.ws + WS_P); const bf16* MKV = (const bf16*)(a.ws + WS_MKV);
    const float* nw = a.xattn_nw + layer * 128;
#pragma unroll
    for (int i = 0; i < 8; ++i) { const int p = tid + 512 * i, r = p >> 4, c8 = p & 15; const bf16* src = MKV + (size_t)(b * MEML + r) * 2048 + layer * 1024 + h * 128 + 8 * c8;
        const u32x4 kk = *(const u32x4*)src, vv = *(const u32x4*)(src + 512);
        *(LAS u32x4*)(L + OFF_KX + r * RSB + c8 * 16) = kk; *(LAS u32x4*)(L + OFF_VX + r * RSB + c8 * 16) = vv; }
    LDS_WAIT(); __syncthreads();
    bf16x8 qb[4], qn[4];
#pragma unroll
    for (int ks = 0; ks < 4; ++ks) qn[ks] = *(const bf16x8*)(P + pgo(C_XQ + h * 128, t0 + li) + 32 * ks + 8 * g4);
    for (int it = 0; it < 4; ++it) {
        const int tb = t0 + 16 * it;
        unsigned kxo = OFF_KX, vxo = OFF_VX; asm volatile("" : "+v"(kxo), "+v"(vxo));
#pragma unroll
        for (int ks = 0; ks < 4; ++ks) qb[ks] = qn[ks];
        if (it + 1 < 4) {
#pragma unroll
            for (int ks = 0; ks < 4; ++ks) qn[ks] = *(const bf16x8*)(P + pgo(C_XQ + h * 128, tb + 16 + li) + 32 * ks + 8 * g4);
        }
        bf16* orow = P + pgo(C_SG + 1536 + h * 128, tb + li) + 4 * g4;
        u32x2 gt[8];
#pragma unroll
        for (int vt = 0; vt < 8; ++vt) gt[vt] = *(const u32x2*)(orow + 16 * vt);
        f32x4 s[16];
#pragma unroll
        for (int mt = 0; mt < 16; ++mt) { s[mt] = (f32x4){0.f, 0.f, 0.f, 0.f};
#pragma unroll
            for (int ks = 0; ks < 4; ++ks) { const bf16x8 ka = *(const LAS bf16x8*)(L + kxo + (16 * mt + li) * RSB + (32 * ks + 8 * g4) * 2); s[mt] = __builtin_amdgcn_mfma_f32_16x16x32_bf16(ka, qb[ks], s[mt], 0, 0, 0); } }
        float mxv = s[0][0];
#pragma unroll
        for (int mt = 0; mt < 16; ++mt)
#pragma unroll
            for (int r = 0; r < 4; ++r) mxv = fmaxf(mxv, s[mt][r]);
        mxv = fmaxf(mxv, __shfl_xor(mxv, 16)); mxv = fmaxf(mxv, __shfl_xor(mxv, 32));
        float lsum = 0.f;
#pragma unroll
        for (int mt = 0; mt < 16; ++mt)
#pragma unroll
            for (int r = 0; r < 4; ++r) { s[mt][r] = fexp(s[mt][r] - mxv); lsum += s[mt][r]; }
        lsum += __shfl_xor(lsum, 16); lsum += __shfl_xor(lsum, 32);
        f32x4 o[8];
#pragma unroll
        for (int vt = 0; vt < 8; ++vt) o[vt] = (f32x4){0.f, 0.f, 0.f, 0.f};
#pragma unroll
        for (int k2 = 0; k2 < 8; ++k2) {
            const bf16x8 pa = __builtin_bit_cast(bf16x8, (u32x4){pk2(s[2 * k2][0], s[2 * k2][1]), pk2(s[2 * k2][2], s[2 * k2][3]), pk2(s[2 * k2 + 1][0], s[2 * k2 + 1][1]), pk2(s[2 * k2 + 1][2], s[2 * k2 + 1][3])});
#pragma unroll
            for (int vt = 0; vt < 8; ++vt) { const s16x4 t0_ = tr16(L + vxo + (32 * k2 + 4 * g4 + q_) * RSB + (16 * vt + 4 * p_) * 2), t1_ = tr16(L + vxo + (32 * k2 + 16 + 4 * g4 + q_) * RSB + (16 * vt + 4 * p_) * 2);
                const bf16x8 vb = (bf16x8){t0_[0], t0_[1], t0_[2], t0_[3], t1_[0], t1_[1], t1_[2], t1_[3]};
                o[vt] = __builtin_amdgcn_mfma_f32_16x16x32_bf16(vb, pa, o[vt], 0, 0, 0); } }
        const float linv = 1.0f / lsum; float ss = 0.f;
#pragma unroll
        for (int vt = 0; vt < 8; ++vt) { o[vt] = o[vt] * linv; ss += (o[vt][0] * o[vt][0] + o[vt][1] * o[vt][1]) + (o[vt][2] * o[vt][2] + o[vt][3] * o[vt][3]); }
        ss += __shfl_xor(ss, 16); ss += __shfl_xor(ss, 32);
        const float rstd = __builtin_amdgcn_rsqf(ss * (1.f / 128.f) + NORM_EPS);
#pragma unroll
        for (int vt = 0; vt < 8; ++vt) { const f32x4 wv = *(const f32x4*)(nw + 16 * vt + 4 * g4); const u32x2 gg = gt[vt];
            u32x2 ov; ov.x = pk2(o[vt][0] * rstd * wv[0] * bflo(gg.x), o[vt][1] * rstd * wv[1] * bfhi(gg.x)); ov.y = pk2(o[vt][2] * rstd * wv[2] * bflo(gg.y), o[vt][3] * rstd * wv[3] * bfhi(gg.y));
            if (!dry) *(u32x2*)(orow + 16 * vt) = ov; }
    }
    LDS_WAIT(); __syncthreads();
}
}

__device__ __forceinline__ int next_item(const Frame& F, unsigned* head) {
    if (F.wave == 0 && lane_id() == 0) F.MISC[4] = __hip_atomic_fetch_add(head, 1u, RLX_AGENT);
    __syncthreads();
    const int it = (int)F.MISC[4];
    __syncthreads();
    return it;
}

constexpr int N_PHASES = 10;
__global__ void __launch_bounds__(512, 2) mega(Args args) {
    extern __shared__ __attribute__((aligned(16))) unsigned char lds_raw[];
    Frame F;
    F.lds = (LAS unsigned char*)lds_raw; F.MISC = (volatile LAS unsigned*)(F.lds + MISC_OFF);
    F.wave = __builtin_amdgcn_readfirstlane(threadIdx.x >> 6);
    F.G = gridDim.x; { const int bx = blockIdx.x; F.vcu = (F.G % 8 == 0) ? (bx % 8) * (F.G / 8) + bx / 8 : bx; }
    F.ctl = (unsigned*)(args.ws + WS_CTL);
    if (threadIdx.x < 16) F.MISC[threadIdx.x] = 0u;
    __syncthreads();
    XcdBarrier bar; bar.bar = F.ctl + CW_BAR; bar.x = 0; bar.st = nullptr; bar.wave = F.wave;
    if (!MK_PER_PHASE) bar = xcd_barrier_post(F.ctl + CW_BAR, F.MISC + 8, F.wave);
    const int lo = args.ph_lo, hi = args.ph_hi;
#define IN(k) (lo <= (k) && (k) < hi)
#define SEAM(k) do { if (IN(k) && IN((k) + 1)) xcd_barrier(bar); } while (0)
#define LAUNDER(la) Args la = args; asm volatile("" : "+s"(la.ws), "+s"(la.out)); Frame Fp = F; int bid = blockIdx.x; asm volatile("" : "+s"(Fp.vcu), "+s"(Fp.G), "+s"(Fp.wave), "+s"(bid))

    if (IN(0)) { LAUNDER(la); prep_w1(Fp, la, 0); prep_w2(Fp, la, 0); prep_wkv(Fp, la); prep_x(Fp, la);
        if (PROBE_REP == 0) { xcd_barrier(bar); prep_w1(Fp, la, 0); prep_w2(Fp, la, 0); prep_wkv(Fp, la); prep_x(Fp, la); } }
    SEAM(0);
    for (int layer = 0; layer < DEPTH; ++layer) {
        const int pb = 1 + 4 * layer;
        if (IN(pb)) { LAUNDER(la);
            if (layer == 0) {
                typedef pg8::Gemm<MROWS, 2048, D, D, D> GM; typedef pg8::StaticOrder<MROWS, 2048> SM;
                GM g{(const bf16*)((unsigned char*)la.out + DO_MEMB), (const bf16*)((unsigned char*)la.out + DO_WKVT)};
                SM S; S.init(Fp.G, bid);
                EpiMem E{(bf16*)(la.ws + WS_MKV), (const float*)((unsigned char*)la.out + DO_RSTDM)};
                pg8::gemm_phase<EpiMem, SM, GM, true, true>(Fp.lds, g, S, E, Fp.wave);
            }
            typedef pg8::Gemm<T, NP, D, D, D> G1; typedef pg8::StaticOrder<T, NP> S1;
            G1 g{(const bf16*)(la.ws + WS_XB), (const bf16*)(la.ws + WS_W1T)};
            S1 S; S.init(Fp.G, bid);
            {
                const float* ssq = layer == 0 ? (const float*)((unsigned char*)la.out + DO_SSQ0) : (const float*)(la.ws + WS_SSQ1);
                LAS float* rt = (LAS float*)(Fp.lds + RSTD_OFF); const int t_ = fresh_tid(Fp.wave); pg8::Unit uu;
                f32x4 sp_[7][4]; const int i0_ = Fp.wave >> 2;
#pragma unroll
                for (int k = 0; k < 7; ++k) { const bool ok = S.next(i0_ + 2 * k, uu); const f32x4* sp = (const f32x4*)(ssq + (size_t)((ok ? uu.pm : 0) * 256 + (t_ & 255)) * 16);
#pragma unroll
                    for (int j = 0; j < 4; ++j) sp_[k][j] = sp[j]; }
#pragma unroll
                for (int k = 0; k < 7; ++k) { const f32x4 s0 = sp_[k][0], s1 = sp_[k][1], s2 = sp_[k][2], s3 = sp_[k][3];
                    const float sq = ((s0.x + s0.y) + (s0.z + s0.w)) + ((s1.x + s1.y) + (s1.z + s1.w)) + ((s2.x + s2.y) + (s2.z + s2.w)) + ((s3.x + s3.y) + (s3.z + s3.w));
                    rt[(i0_ + 2 * k) * 256 + (t_ & 255)] = __builtin_amdgcn_rsqf(sq * (1.f / D) + NORM_EPS); }
                LDS_WAIT(); __syncthreads();
            }
            EpiProj E{0, (bf16*)(la.ws + WS_P), (const LAS float*)(Fp.lds + RSTD_OFF), la.gla_b + layer * 512, (const float*)(la.ws + WS_HTAB) + layer * 1024};
            pg8::gemm_phase<EpiProj, S1, G1, true, true>(Fp.lds, g, S, E, Fp.wave);
            if (PROBE_REP == pb) { xcd_barrier(bar); E.dry = (PROBE_SUB & 32) ? la.probe : (PROBE_SUB & 2048) ? 2 * la.probe : 0; pg8::gemm_phase<EpiProj, S1, G1, true, true>(Fp.lds, g, S, E, Fp.wave); }
        }
        SEAM(pb);
        if (IN(pb + 1)) { LAUNDER(la);
            if (layer == 0) prep_w1(Fp, la, 1); else prep_w2(Fp, la, 1);
            __syncthreads();
            const int reps = (PROBE_REP == pb + 1) ? 2 : 1;
            for (int rep = 0; rep < reps; ++rep) { const bool dry = (rep + 1 < reps) && la.probe;
                unsigned* head = Fp.ctl + CW_QUEUE + 64 * (2 * layer) + 512 * rep;
                for (;;) { const int it = next_item(Fp, head); if (it >= N_MIX_UNITS + N_XA_UNITS) break;
                    const int grp = it / 3, rr = it - 3 * grp;
                    if (rr == 2) { if (!(dry && (PROBE_SUB & 64))) xa::xa_unit(Fp, la, grp, layer, dry); }
                    else if (!(dry && (PROBE_SUB & 128)) && ((2 * grp + rr) & 7) != 7) { const int mu = 2 * grp + rr;   if (mu < 256) mx::mix_unit<0, 0>(Fp, la, mu, layer, dry); else mx::mix_unit<0, 1>(Fp, la, mu, layer, dry); } }
                if (rep + 1 < reps) xcd_barrier(bar); }
        }
        SEAM(pb + 1);
        if (IN(pb + 2)) { LAUNDER(la);
            mx::scan_states(Fp, la); xcd_barrier(bar);
            const int reps = (PROBE_REP == pb + 2) ? 2 : 1;
            for (int rep = 0; rep < reps; ++rep) { const bool dry = (rep + 1 < reps) && la.probe;
                unsigned* head = Fp.ctl + CW_QUEUE + 64 * (2 * layer + 1) + 512 * rep;
                for (;;) { const int it = next_item(Fp, head); if (it >= N_MIX_UNITS) break; if (it < 256) mx::mix_unit<1, 0>(Fp, la, it, layer, dry); else mx::mix_unit<1, 1>(Fp, la, it, layer, dry); }
                if (rep + 1 < reps) xcd_barrier(bar); }
        }
        SEAM(pb + 2);
        if (IN(pb + 3)) { LAUNDER(la);
            typedef pg8::Gemm<T, D, DMIX, 128, DMIX, PGS * 2> G2; typedef pg8::StaticOrder<T, D> S2;
            G2 g{(const bf16*)(la.ws + WS_P) + pgo(C_SG, 0), (const bf16*)(la.ws + WS_W2T)};
            S2 S; S.init(Fp.G, bid);
            EpiRes E{layer == 0 ? la.x : (const float*)la.out, la.out, (bf16*)(la.ws + WS_XB), (float*)(la.ws + (layer == 0 ? WS_SSQ1 : WS_SSQ2))};
            pg8::gemm_phase<EpiRes, S2, G2, true, true>(Fp.lds, g, S, E, Fp.wave);
            if (PROBE_REP == pb + 3 && layer == 0) { xcd_barrier(bar); pg8::gemm_phase<EpiRes, S2, G2, true, true>(Fp.lds, g, S, E, Fp.wave); }
        }
        SEAM(pb + 3);
    }
    if (IN(9)) { LAUNDER(la);
        const int lane_ = fresh_tid(Fp.wave) & 63;
        const int gw = Fp.vcu * 8 + Fp.wave, NGW = Fp.G * 8; const float* ssq = (const float*)(la.ws + WS_SSQ2);
        f32x4 fw[4];
#pragma unroll
        for (int j = 0; j < 4; ++j) fw[j] = *((const f32x4*)la.final_nw + lane_ + 64 * j);
        for (int m = 8 * gw; m < T; m += 8 * NGW) { f32x4 v[8][4]; float sq[8];
#pragma unroll
            for (int r = 0; r < 8; ++r) { sq[r] = lane_ < 16 ? ssq[(size_t)(m + r) * 16 + lane_] : 0.f;
#pragma unroll
                for (int j = 0; j < 4; ++j) v[r][j] = *((const f32x4*)(la.out + (size_t)(m + r) * D) + lane_ + 64 * j); }
#pragma unroll
            for (int r = 0; r < 8; ++r) { const float rstd = 1.0f / sqrtf(wave_sum(sq[r]) * (1.f / D) + NORM_EPS);
#pragma unroll
                for (int j = 0; j < 4; ++j) *((f32x4*)(la.out + (size_t)(m + r) * D) + lane_ + 64 * j) = v[r][j] * rstd * fw[j]; } }
    }
#undef IN
#undef SEAM
}

extern "C" void kernel_launch(void* const* d_in, const int* in_sizes, int n_in, void* d_out, int out_size, void* d_ws, size_t ws_size, hipStream_t stream) {
    static int grid = 0;
    if (grid == 0) {
        if (n_in != 14 || in_sizes[0] != T * D || out_size != T * D || ws_size < WS_END) { fprintf(stderr, "kernel_launch: unexpected shapes (n_in %d, in0 %d, out %d, ws %zu)\n", n_in, n_in > 0 ? in_sizes[0] : -1, out_size, ws_size); grid = -1; return; }
        int dev = 0, cus = 0, per_cu = 0;
        if (hipGetDevice(&dev) != hipSuccess || hipDeviceGetAttribute(&cus, hipDeviceAttributeMultiprocessorCount, dev) != hipSuccess) { grid = -1; return; }
        if (hipFuncSetAttribute((const void*)mega, hipFuncAttributeMaxDynamicSharedMemorySize, LDS_BYTES) != hipSuccess) { fprintf(stderr, "kernel_launch: hipFuncSetAttribute failed\n"); grid = -1; return; }
        if (hipOccupancyMaxActiveBlocksPerMultiprocessor(&per_cu, (const void*)mega, 512, LDS_BYTES) != hipSuccess || per_cu < 1) { fprintf(stderr, "kernel_launch: occupancy query says %d blocks per CU\n", per_cu); grid = -1; (void)hipGetLastError(); return; }
        grid = cus;
    }
    if (grid < 0) return;
    (void)hipMemsetAsync((char*)d_ws + WS_CTL, 0, CTL_ZERO_BYTES, stream);
    Args a{};
    a.x = (const float*)d_in[0]; a.mem = (const float*)d_in[1]; a.norm_w = (const float*)d_in[2]; a.w_in = (const float*)d_in[3]; a.gla_wup = (const float*)d_in[4]; a.gla_b = (const float*)d_in[5];
    a.gla_nw = (const float*)d_in[6]; a.hgrn_lb = (const float*)d_in[7]; a.hgrn_nw = (const float*)d_in[8]; a.mem_nw = (const float*)d_in[9]; a.w_mkv = (const float*)d_in[10]; a.xattn_nw = (const float*)d_in[11];
    a.w_out = (const float*)d_in[12]; a.final_nw = (const float*)d_in[13]; a.out = (float*)d_out; a.ws = (unsigned char*)d_ws;
#if MK_PER_PHASE
    for (int p = 0; p < N_PHASES; ++p) { a.ph_lo = p; a.ph_hi = p + 1; hipLaunchKernelGGL(mega, dim3(grid), dim3(512), LDS_BYTES, stream, a); }
#else
    a.ph_lo = 0; a.ph_hi = N_PHASES; a.probe = 1;
    void* kargs[] = {&a};
    hipError_t e = hipLaunchCooperativeKernel((const void*)mega, dim3(grid), dim3(512), kargs, LDS_BYTES, stream);
    if (e != hipSuccess) fprintf(stderr, "kernel_launch: cooperative launch failed: %s (grid %d)\n", hipGetErrorString(e), grid);
#endif
}
```

```cpp
#include <hip/hip_runtime.h>
#include <cstdio>
#include <cstdint>

#ifndef MK_PER_PHASE
#define MK_PER_PHASE 0
#endif
#ifndef PROBE_SUB
#define PROBE_SUB 0
#endif
#ifndef PROBE_REP
#define PROBE_REP -1
#endif

#define LAS __attribute__((address_space(3)))
#define GAS __attribute__((address_space(1)))
__device__ __forceinline__ int lane_id() { int l; asm volatile("v_mbcnt_lo_u32_b32 %0, -1, 0\n\tv_mbcnt_hi_u32_b32 %0, -1, %0" : "=v"(l)); return l; }
__device__ __forceinline__ int fresh_tid(int wave) { int t = wave * 64 + lane_id(); asm volatile("" : "+v"(t)); return t; }

namespace pg8 {
typedef unsigned short bf16_t;
typedef short bf16x8 __attribute__((ext_vector_type(8)));
typedef float f32x4 __attribute__((ext_vector_type(4)));
typedef unsigned u32x4 __attribute__((ext_vector_type(4)));
typedef unsigned u32x2 __attribute__((ext_vector_type(2)));
constexpr int BM = 256, BK = 64, HALF = 128, HTB = HALF * BK * 2, STAGE_BYTES = 8 * HTB, NXCD = 8, WGM = 8;

__host__ __device__ __forceinline__ int lds_byte(int r, int c) { const int st = (r >> 4) * 2 + (c >> 5), rr = r & 15, cc = c & 31, ob = rr * 64 + cc * 2; return st * 1024 + (ob ^ (((ob >> 9) & 1) << 5)); }
__host__ __device__ __forceinline__ void stage_rc(int b, int& R, int& C) { const int st = b / 1024, sb = b % 1024, swz = sb ^ (((sb >> 9) & 1) << 5); R = (st >> 1) * 16 + swz / 64; C = (st & 1) * 32 + (swz % 64) / 2; }
__host__ __device__ __forceinline__ int perm32(int rho) { const int n = rho >> 4, i = rho & 15; return 8 * (i >> 2) + 4 * n + (i & 3); }

struct Unit { int pm, pn, idx; };
template <int M_, int N_, int K_, int LDA_, int LDB_, size_t K2A_ = 256> struct Gemm { const bf16_t* A; const bf16_t* Bt; static constexpr int M = M_, N = N_, K = K_, lda = LDA_, ldb = LDB_; static constexpr size_t k2A = K2A_; };

template <int M_, int N_> struct StaticOrder {
    static constexpr int nM = M_ / BM, nN = N_ / BM, nwg = nM * nN;
    int G, c;
    __host__ __device__ void init(int G_, int c_) { G = G_; c = c_; }
    __host__ __device__ bool next(int i, Unit& u) const {
        const long L = (long)i * G + c; if (L >= nwg) return false;
        int wgid = (int)L; { const int q = nwg / NXCD, r = nwg % NXCD, xcd = wgid % NXCD, off = wgid / NXCD; wgid = (xcd < r ? xcd * (q + 1) : r * (q + 1) + (xcd - r) * q) + off; }
        const int nig = WGM * nN, gid = wgid / nig, fm = gid * WGM, gsz = (nM - fm) < WGM ? (nM - fm) : WGM;
        u.pm = fm + ((wgid % nig) % gsz); u.pn = (wgid % nig) / gsz; u.idx = i; return true;
    }
    __device__ __forceinline__ void a_ready(const Unit&) const {}
    __device__ __forceinline__ void done(const Unit&) const {}
};

template <class Epi, class Sched, class GemmT, bool ALIGN_EPI = false, bool SP2 = false>
__device__ __forceinline__ void gemm_phase(LAS unsigned char* lds, const GemmT g, const Sched& S, const Epi& E, int wave_) {
    const int tid = fresh_tid(wave_);
    const int wid = wave_, lane = tid & 63, wr = wid >> 2, wc = wid & 3, fr = lane & 15, fq = lane >> 4;
    constexpr int K = GemmT::K, nt = K / BK;
    unsigned voffA[2], voffB[2];
#pragma unroll
    for (int i = 0; i < 2; ++i) { int R, C; stage_rc(tid * 16 + i * 8192, R, C); const int Rb = Epi::PERM ? ((R & ~31) + perm32(R & 31)) : R;
        voffA[i] = (unsigned)(R * GemmT::lda + C) * 2u; voffB[i] = (unsigned)(Rb * GemmT::ldb + C) * 2u; }
    constexpr size_t kstep = (size_t)(BK * 2);
    constexpr size_t hstepA = (size_t)HALF * GemmT::lda * 2, hstepB = (size_t)HALF * GemmT::ldb * 2;
    constexpr size_t tstepA = 2 * hstepA, tstepB = 2 * hstepB;
    const unsigned ldsw = (unsigned)wid * 1024u;
    const int aoff = lds_byte(wr * 64 + fr, fq * 8), boff = lds_byte(wc * 32 + fr, fq * 8);
#define PG8_SA(b, h) (((b) * 2 + (h)) * HTB)
#define PG8_SB(b, h) ((4 + (b) * 2 + (h)) * HTB)
#define PG8_STAGE(bufoff, gbase, voff) do { _Pragma("unroll") for (int _i = 0; _i < 2; ++_i) \
        __builtin_amdgcn_global_load_lds((const unsigned*)((const char*)(gbase) + (voff)[_i]), (LAS unsigned*)(lds + (bufoff) + ldsw + _i * 8192), 16, 0, 0); } while (0)
#define PG8_LDA(dst, b, h) do { _Pragma("unroll") for (int m = 0; m < 4; ++m) _Pragma("unroll") for (int k = 0; k < 2; ++k) dst[m][k] = *(const LAS bf16x8*)(lds + PG8_SA(b, h) + aoff + m * 2048 + k * 1024); } while (0)
#define PG8_LDB(dst, b, h) do { _Pragma("unroll") for (int n = 0; n < 2; ++n) _Pragma("unroll") for (int k = 0; k < 2; ++k) dst[n][k] = *(const LAS bf16x8*)(lds + PG8_SB(b, h) + boff + n * 2048 + k * 1024); } while (0)
#define PG8_MMA(ai, bj, At, Bt) do { __builtin_amdgcn_s_setprio(1); _Pragma("unroll") for (int m = 0; m < 4; ++m) _Pragma("unroll") for (int n = 0; n < 2; ++n) _Pragma("unroll") for (int k = 0; k < 2; ++k) \
        acc[ai][bj][m][n] = __builtin_amdgcn_mfma_f32_16x16x32_bf16(Bt[n][k], At[m][k], acc[ai][bj][m][n], 0, 0, 0); __builtin_amdgcn_s_setprio(0); } while (0)
#define PG8_WAIT_V(n) asm volatile("s_waitcnt vmcnt(" #n ")" ::: "memory")
#define PG8_WAIT_L(n) asm volatile("s_waitcnt lgkmcnt(" #n ")" ::: "memory")
#define PG8_BAR __builtin_amdgcn_s_barrier()
#define PG8_SCHED __builtin_amdgcn_sched_barrier(0)
    Unit cur, nxt; int ui = 0;
    if (!S.next(0, cur)) return;
    f32x4 acc[2][2][4][2];
#pragma unroll
    for (int a = 0; a < 2; ++a)
#pragma unroll
        for (int b = 0; b < 2; ++b)
#pragma unroll
            for (int m = 0; m < 4; ++m)
#pragma unroll
                for (int n = 0; n < 2; ++n) acc[a][b][m][n] = (f32x4){0.f, 0.f, 0.f, 0.f};
    bf16x8 At[4][2], B0[2][2], B1[2][2];
    const char* cA = (const char*)g.A + (size_t)cur.pm * tstepA; const char* cB = (const char*)g.Bt + (size_t)cur.pn * tstepB;
    S.a_ready(cur);
    if constexpr (SP2) {
        PG8_STAGE(PG8_SB(0, 0), cB, voffB); PG8_STAGE(PG8_SB(0, 1), cB + hstepB, voffB); PG8_STAGE(PG8_SA(0, 0), cA, voffA); PG8_STAGE(PG8_SA(0, 1), cA + hstepA, voffA);
        if (wr == 1) PG8_BAR;
        PG8_WAIT_V(2); PG8_BAR;
        PG8_STAGE(PG8_SB(1, 0), cB + kstep, voffB); PG8_STAGE(PG8_SA(1, 0), cA + kstep, voffA); PG8_STAGE(PG8_SB(1, 1), cB + hstepB + kstep, voffB);
        PG8_WAIT_V(6); PG8_BAR;
    } else {
        PG8_STAGE(PG8_SB(0, 0), cB, voffB); PG8_STAGE(PG8_SA(0, 0), cA, voffA); PG8_STAGE(PG8_SB(0, 1), cB + hstepB, voffB); PG8_STAGE(PG8_SA(0, 1), cA + hstepA, voffA);
        if (wr == 1) PG8_BAR;
        PG8_WAIT_V(4); PG8_BAR;
        PG8_STAGE(PG8_SB(1, 0), cB + kstep, voffB); PG8_STAGE(PG8_SA(1, 0), cA + kstep, voffA); PG8_STAGE(PG8_SB(1, 1), cB + hstepB + kstep, voffB);
        PG8_WAIT_V(6); PG8_BAR;
    }
    for (;;) {
        const bool has_next = S.next(ui + 1, nxt);
        const char* nA = has_next ? (const char*)g.A + (size_t)nxt.pm * tstepA : cA; const char* nB = has_next ? (const char*)g.Bt + (size_t)nxt.pn * tstepB : cB;
        for (int t = 0; t < nt; t += 2) {
            const bool last = (t == nt - 2);
            const char* a1 = cA + (size_t)(t >> 1) * GemmT::k2A + kstep;
            const char* a2 = last ? nA : cA + (size_t)((t >> 1) + 1) * GemmT::k2A; const char* b2 = last ? nB : cB + (size_t)(t + 2) * kstep;
            const char* a3 = a2 + kstep; const char* b3 = b2 + kstep;
            if (last && has_next) S.a_ready(nxt);
            if constexpr (SP2) {
            PG8_LDB(B0, 0, 0); PG8_LDB(B1, 0, 1); PG8_SCHED; PG8_LDA(At, 0, 0); PG8_STAGE(PG8_SA(1, 1), a1 + hstepA, voffA);
            PG8_WAIT_V(8); PG8_WAIT_L(0); PG8_BAR; PG8_MMA(0, 0, At, B0); PG8_MMA(0, 1, At, B1); PG8_BAR; PG8_SCHED;
            PG8_LDA(At, 0, 1); PG8_STAGE(PG8_SB(0, 0), b2, voffB); PG8_STAGE(PG8_SB(0, 1), b2 + hstepB, voffB); PG8_STAGE(PG8_SA(0, 0), a2, voffA);
            PG8_WAIT_V(8); PG8_WAIT_L(0); PG8_BAR; PG8_MMA(1, 0, At, B0); PG8_MMA(1, 1, At, B1); PG8_BAR; PG8_SCHED;
            PG8_LDB(B0, 1, 0); PG8_LDB(B1, 1, 1); PG8_SCHED; PG8_LDA(At, 1, 0); PG8_STAGE(PG8_SA(0, 1), a2 + hstepA, voffA);
            PG8_WAIT_V(8); PG8_WAIT_L(0); PG8_BAR; PG8_MMA(0, 0, At, B0); PG8_MMA(0, 1, At, B1); PG8_BAR; PG8_SCHED;
            PG8_LDA(At, 1, 1); PG8_STAGE(PG8_SB(1, 0), b3, voffB); PG8_STAGE(PG8_SB(1, 1), b3 + hstepB, voffB); PG8_STAGE(PG8_SA(1, 0), a3, voffA);
            PG8_WAIT_V(8); PG8_WAIT_L(0); PG8_BAR; PG8_MMA(1, 0, At, B0); PG8_MMA(1, 1, At, B1); PG8_BAR; PG8_SCHED;
            } else {
            PG8_LDB(B0, 0, 0); PG8_SCHED; PG8_LDA(At, 0, 0); PG8_STAGE(PG8_SA(1, 1), a1 + hstepA, voffA);
            PG8_WAIT_L(8); PG8_BAR; PG8_WAIT_L(0); PG8_MMA(0, 0, At, B0); PG8_BAR; PG8_SCHED;
            PG8_LDB(B1, 0, 1); PG8_STAGE(PG8_SB(0, 0), b2, voffB);
            PG8_BAR; PG8_WAIT_L(0); PG8_MMA(0, 1, At, B1); PG8_BAR;
            PG8_LDA(At, 0, 1); PG8_STAGE(PG8_SA(0, 0), a2, voffA);
            PG8_BAR; PG8_WAIT_L(0); PG8_MMA(1, 0, At, B0); PG8_BAR; PG8_SCHED;
            PG8_STAGE(PG8_SB(0, 1), b2 + hstepB, voffB);
            PG8_WAIT_V(6); PG8_BAR; PG8_MMA(1, 1, At, B1); PG8_BAR;
            PG8_LDB(B0, 1, 0); PG8_SCHED; PG8_LDA(At, 1, 0); PG8_STAGE(PG8_SA(0, 1), a2 + hstepA, voffA);
            PG8_WAIT_L(8); PG8_BAR; PG8_WAIT_L(0); PG8_MMA(0, 0, At, B0); PG8_BAR; PG8_SCHED;
            PG8_LDB(B1, 1, 1); PG8_STAGE(PG8_SB(1, 0), b3, voffB);
            PG8_BAR; PG8_WAIT_L(0); PG8_MMA(0, 1, At, B1); PG8_BAR;
            PG8_LDA(At, 1, 1); PG8_STAGE(PG8_SA(1, 0), a3, voffA);
            PG8_BAR; PG8_WAIT_L(0); PG8_MMA(1, 0, At, B0); PG8_BAR; PG8_SCHED;
            PG8_STAGE(PG8_SB(1, 1), b3 + hstepB, voffB);
            PG8_WAIT_V(6); PG8_BAR; PG8_MMA(1, 1, At, B1); PG8_BAR;
            }
        }
        if constexpr (ALIGN_EPI) { if (wr == 0) PG8_BAR; }
        E(acc, cur, wr, wc, fr, fq); S.done(cur);
        if (!has_next) break;
#pragma unroll
        for (int a = 0; a < 2; ++a)
#pragma unroll
            for (int b = 0; b < 2; ++b)
#pragma unroll
                for (int m = 0; m < 4; ++m)
#pragma unroll
                    for (int n = 0; n < 2; ++n) acc[a][b][m][n] = (f32x4){0.f, 0.f, 0.f, 0.f};
        cur = nxt; cA = nA; cB = nB; ++ui;
        if constexpr (ALIGN_EPI) { if (wr == 1) PG8_BAR; }
    }
    PG8_WAIT_V(0);
    if constexpr (!ALIGN_EPI) { if (wr == 0) PG8_BAR; }
    PG8_BAR;
#undef PG8_SA
#undef PG8_SB
#undef PG8_STAGE
#undef PG8_LDA
#undef PG8_LDB
#undef PG8_MMA
#undef PG8_WAIT_V
#undef PG8_WAIT_L
#undef PG8_BAR
#undef PG8_SCHED
}
}

typedef unsigned short bf16;
typedef short bf16x8 __attribute__((ext_vector_type(8)));
typedef short s16x4 __attribute__((ext_vector_type(4)));
typedef float f32x4 __attribute__((ext_vector_type(4)));
typedef float f32x2 __attribute__((ext_vector_type(2)));
typedef unsigned u32x4 __attribute__((ext_vector_type(4)));
typedef unsigned u32x2 __attribute__((ext_vector_type(2)));
typedef _Float16 f16x2 __attribute__((ext_vector_type(2)));
typedef __bf16 bf16x2_t __attribute__((ext_vector_type(2)));
typedef short v4i16_t __attribute__((ext_vector_type(4)));

constexpr int NB = 8, SEQ = 4096, T = NB * SEQ, D = 1024, DEPTH = 2, DINP = 6160, DMIX = 2048, MEML = 256, MROWS = NB * MEML;
constexpr int NP = 6656;
constexpr int LDP = 6656;
constexpr size_t PGS = (size_t)32768 * 128;
__host__ __device__ constexpr size_t pgo(int col, int t) { return (size_t)(col >> 7) * PGS + (size_t)t * 128 + (col & 127); }
constexpr int C_GQ = 0, C_GK = 512, C_GG = 1024, C_GV = 1536, C_HQ = 2560, C_HLF = 3072, C_HI = 3584, C_XQ = 4096, C_SG = 4608;
constexpr float NORM_EPS = 1e-6f;
constexpr int NSEG = 8, SEGLEN = 512, NMC = SEGLEN / 64;
constexpr int N_MIX_UNITS = 512;
constexpr int N_XA_UNITS = 256;

constexpr size_t MiB = 1u << 20;
constexpr size_t WS_CTL = 0, CTL_ZERO_BYTES = 1 * MiB;
constexpr size_t WS_SSQ1 = 1 * MiB, WS_SSQ2 = 3 * MiB;
constexpr size_t WS_MKV = 5 * MiB;
constexpr size_t WS_W1T = 13 * MiB;
constexpr size_t WS_W2T = 27 * MiB;
constexpr size_t WS_XB = 31 * MiB;
constexpr size_t DO_SEND = 0, DO_DTOT = 48 * MiB;
constexpr size_t WS_P = 95 * MiB;
constexpr size_t WS_END = WS_P + (size_t)T * LDP * 2;
static_assert(WS_END <= 512 * MiB, "workspace map");
constexpr size_t DO_MEMB = 0, DO_WKVT = 4 * MiB, DO_SSQ0 = 8 * MiB, DO_RSTDM = 10 * MiB;
constexpr int CW_BAR = 4096;
constexpr int CW_QUEUE = 2048;
constexpr size_t WS_HTAB = 512 * 1024;
constexpr int RSTD_OFF = 131072;
constexpr int LDS_BYTES = 147456, MISC_OFF = LDS_BYTES - 64;
static_assert(RSTD_OFF + 15 * 1024 <= MISC_OFF && (T / 256) * (NP / 256) <= 14 * 256, "rstd table: <= 14 tiles per workgroup");

#define LDS_WAIT() asm volatile("s_waitcnt lgkmcnt(0)" ::: "memory")
#define VM_WAIT() asm volatile("s_waitcnt vmcnt(0)" ::: "memory")
#define RLX_AGENT __ATOMIC_RELAXED, __HIP_MEMORY_SCOPE_AGENT
__device__ __forceinline__ unsigned f2bf(float f) { unsigned u = __builtin_bit_cast(unsigned, f); return (u + 0x7fffu + ((u >> 16) & 1u)) >> 16; }
__device__ __forceinline__ unsigned pk2(float lo, float hi) { f32x2 v = {lo, hi}; bf16x2_t b = __builtin_convertvector(v, bf16x2_t); return __builtin_bit_cast(unsigned, b); }
__device__ __forceinline__ unsigned pkh2(float lo, float hi) { f32x2 v = {lo, hi}; f16x2 h = __builtin_convertvector(v, f16x2); return __builtin_bit_cast(unsigned, h); }
__device__ __forceinline__ float bflo(unsigned w) { return __builtin_bit_cast(float, w << 16); }
__device__ __forceinline__ float bfhi(unsigned w) { return __builtin_bit_cast(float, w & 0xffff0000u); }
__device__ __forceinline__ float fexp(float x) { return __builtin_amdgcn_exp2f(x * 1.4426950408889634f); }
__device__ __forceinline__ float flog(float x) { return __builtin_amdgcn_logf(x) * 0.6931471805599453f; }
__device__ __forceinline__ float log_sigmoid(float z) { return fminf(z, 0.f) - flog(1.f + fexp(-fabsf(z))); }
__device__ __forceinline__ s16x4 tr16(const LAS unsigned char* p) { return __builtin_bit_cast(s16x4, __builtin_amdgcn_ds_read_tr16_b64_v4i16((LAS v4i16_t*)p)); }
__device__ __forceinline__ float wave_sum(float v) {
#pragma unroll
    for (int o = 1; o < 64; o <<= 1) v += __shfl_xor(v, o);
    return v;
}

#define XB_TMO      128
#define XB_XCNT(j)  (256  + 64 * (j))
#define XB_XSUB(j)  (1280 + 64 * (j))
#define XB_XGEN(j)  (2304 + 64 * (j))
#define XB_TOP      3328
#define XB_TOPGEN   3392
#define XCD_BAR_WORDS 3456
#define XB_SPIN_CAP (1u << 20)
__device__ __forceinline__ unsigned xb_ld(unsigned* p)              { return __hip_atomic_load(p, __ATOMIC_RELAXED, __HIP_MEMORY_SCOPE_AGENT); }
__device__ __forceinline__ unsigned xb_add(unsigned* p, unsigned v) { return __hip_atomic_fetch_add(p, v, __ATOMIC_RELAXED, __HIP_MEMORY_SCOPE_AGENT); }
__device__ __forceinline__ unsigned xb_xcc_id() { return (unsigned)__builtin_amdgcn_s_getreg((3 << 11) | 20) & 0xFu; }
#define XB_SPIN(cond, bar) do { unsigned _sp = 0; while (cond) { __builtin_amdgcn_s_sleep(1); \
    if ((++_sp & 255u) == 0u) { if (xb_ld(&(bar)[XB_TMO])) break; if (_sp > XB_SPIN_CAP) { atomicAdd(&(bar)[XB_TMO], 1u); break; } } } } while (0)
struct XcdBarrier { unsigned* bar; unsigned x; volatile LAS unsigned* st; int wave; };
__device__ __forceinline__ XcdBarrier xcd_barrier_post(unsigned* bar, volatile LAS unsigned* st, int wave) {
    XcdBarrier b; b.bar = bar; b.x = xb_xcc_id(); b.st = st; b.wave = wave;
    if (wave == 0 && lane_id() == 0) (void)xb_add(&bar[XB_XCNT(b.x)], 1u);
    return b;
}
__device__ __forceinline__ void xcd_barrier_complete(unsigned* bar, unsigned x, unsigned& nloc, unsigned& nx) {
    const unsigned G = gridDim.x * gridDim.y * gridDim.z;
    unsigned sum, cnt, mine, sp = 0u;
    for (;;) {
        sum = 0u; cnt = 0u; mine = 0u;
#pragma unroll 1
        for (unsigned j = 0; j < 16; ++j) { const unsigned c = xb_ld(&bar[XB_XCNT(j)]); sum += c; cnt += (c > 0u) ? 1u : 0u; mine = (j == x) ? c : mine; }
        if (sum == G) break;
        __builtin_amdgcn_s_sleep(1);
        if ((++sp & 255u) == 0u) { if (xb_ld(&bar[XB_TMO])) break; if (sp > XB_SPIN_CAP) { atomicAdd(&bar[XB_TMO], 1u); break; } }
    }
    nloc = mine > 0u ? mine : 1u; nx = cnt > 0u ? cnt : 1u;
}
__device__ __forceinline__ void xcd_barrier(const XcdBarrier& b) {
    asm volatile("s_waitcnt vmcnt(0)" ::: "memory");
    __syncthreads();
    if (b.wave == 0 && lane_id() == 0) {
        unsigned* bar = b.bar;
        __builtin_amdgcn_s_waitcnt(0);
        unsigned nloc = b.st[0], nx = b.st[1];
        if (nloc == 0u) { xcd_barrier_complete(bar, b.x, nloc, nx); b.st[0] = nloc; b.st[1] = nx; }
        const unsigned old = xb_add(&bar[XB_XSUB(b.x)], 1u);
        const unsigned gen = old / nloc;
        if (old + 1u == (gen + 1u) * nloc) {
            __builtin_amdgcn_fence(__ATOMIC_RELEASE, "agent");
            asm volatile("s_waitcnt vmcnt(0)" ::: "memory");
            const unsigned og = xb_add(&bar[XB_TOP], 1u);
            const unsigned tg = og / nx;
            if (og + 1u == (tg + 1u) * nx) xb_add(&bar[XB_TOPGEN], 1u);
            else XB_SPIN(xb_ld(&bar[XB_TOPGEN]) == tg, bar);
            __builtin_amdgcn_fence(__ATOMIC_ACQUIRE, "agent");
            xb_add(&bar[XB_XGEN(b.x)], 1u);
            asm volatile("s_waitcnt vmcnt(0)" ::: "memory");
        } else {
            XB_SPIN(xb_ld(&bar[XB_XGEN(b.x)]) == gen, bar);
            __builtin_amdgcn_fence(__ATOMIC_ACQUIRE, "agent");
            asm volatile("s_waitcnt vmcnt(0)" ::: "memory");
        }
    }
    __syncthreads();
}

struct Args {
    const float* x; const float* mem; const float* norm_w; const float* w_in; const float* gla_wup; const float* gla_b; const float* gla_nw; const float* hgrn_lb;
    const float* hgrn_nw; const float* mem_nw; const float* w_mkv; const float* xattn_nw; const float* w_out; const float* final_nw;
    float* out; unsigned char* ws; int ph_lo, ph_hi, probe, pad;
};
struct Frame {
    LAS unsigned char* lds; volatile LAS unsigned* MISC; unsigned* ctl;
    int wave, vcu, G;
};

__device__ __forceinline__ void tr_item(const float* W, int Nsrc, int srccol0, const float* kscale, float rscale, bf16* WT, int ldt, int dstrow0, int k0, LAS float* scr, int lane) {
    float wv_[32], ks_[32];
#pragma unroll
    for (int i = 0; i < 32; ++i) { const int kk = 2 * i + (lane >> 5); ks_[i] = kscale ? kscale[k0 + kk] : 1.f; wv_[i] = W[(size_t)(k0 + kk) * Nsrc + srccol0 + (lane & 31)]; }
#pragma unroll
    for (int i = 0; i < 32; ++i) { const int kk = 2 * i + (lane >> 5); scr[kk * 33 + (lane & 31)] = wv_[i] * ks_[i] * rscale; }
    LDS_WAIT(); asm volatile("" ::: "memory");
    const int c = lane & 7;
#pragma unroll
    for (int j = 0; j < 4; ++j) { const int n = (lane >> 3) + 8 * j; const LAS float* s = scr + (8 * c) * 33 + n;
        u32x4 o; o.x = pk2(s[0 * 33], s[1 * 33]); o.y = pk2(s[2 * 33], s[3 * 33]); o.z = pk2(s[4 * 33], s[5 * 33]); o.w = pk2(s[6 * 33], s[7 * 33]);
        *(u32x4*)(WT + (size_t)(dstrow0 + n) * ldt + k0 + 8 * c) = o; }
    LDS_WAIT(); asm volatile("" ::: "memory");
}
__device__ __forceinline__ void prep_w1(const Frame& F, const Args& a, int layer) {
    const int lane_ = fresh_tid(F.wave) & 63;
    LAS float* scr = (LAS float*)(F.lds + F.wave * 16384);
    const int gw = F.vcu * 8 + F.wave, NGW = F.G * 8;
    const float* W = a.w_in + (size_t)layer * D * DINP; const float* nw = a.norm_w + layer * D; bf16* WT = (bf16*)(a.ws + WS_W1T);
    constexpr int NBLK = (NP - 512) / 32;
    for (int it = gw; it < NBLK * 16; it += NGW) {
        const int kb = it & 15; int nb = it >> 4; if (nb >= 32) nb += 16;
        const int n0 = nb * 32; const int src = n0 < 1024 ? n0 : (n0 < 2560 ? n0 - 512 : n0 - 496);
        const float rs = (n0 < 512 || (n0 >= 4096 && n0 < 4608)) ? 0.08838834764831845f : 1.f;
        tr_item(W, DINP, src, nw, rs, WT, D, n0, kb * 64, scr, lane_);
    }
    const float* wup = a.gla_wup + (size_t)layer * 16 * 512;
    for (int it = gw; it < 512 * 2; it += NGW) {
        const int c = it >> 1, ko = ((it & 1) * 64 + lane_) * 8;
        float up[16];
#pragma unroll
        for (int r = 0; r < 16; ++r) up[r] = wup[r * 512 + c];
        float o[8];
#pragma unroll
        for (int kk = 0; kk < 8; ++kk) { const float* wr_ = W + (size_t)(ko + kk) * DINP + 2048; float s = 0.f;
#pragma unroll
            for (int r4 = 0; r4 < 4; ++r4) { const f32x4 w4 = *(const f32x4*)(wr_ + 4 * r4); s += w4.x * up[4 * r4] + w4.y * up[4 * r4 + 1] + w4.z * up[4 * r4 + 2] + w4.w * up[4 * r4 + 3]; }
            o[kk] = s * nw[ko + kk]; }
        u32x4 w; w.x = pk2(o[0], o[1]); w.y = pk2(o[2], o[3]); w.z = pk2(o[4], o[5]); w.w = pk2(o[6], o[7]);
        *(u32x4*)(WT + (size_t)(1024 + c) * D + ko) = w;
    }
}
__device__ __forceinline__ void prep_w2(const Frame& F, const Args& a, int layer) {
    const int lane_ = fresh_tid(F.wave) & 63;
    LAS float* scr = (LAS float*)(F.lds + F.wave * 16384);
    const int gw = F.vcu * 8 + F.wave, NGW = F.G * 8;
    const float* W = a.w_out + (size_t)layer * DMIX * D; bf16* WT = (bf16*)(a.ws + WS_W2T);
    for (int it = gw; it < 32 * 32; it += NGW) { const int kb = it & 31, nb = it >> 5; tr_item(W, D, nb * 32, nullptr, 1.f, WT, DMIX, nb * 32, kb * 64, scr, lane_); }
}
__device__ __forceinline__ void prep_wkv(const Frame& F, const Args& a) {
    const int lane_ = fresh_tid(F.wave) & 63;
    LAS float* scr = (LAS float*)(F.lds + F.wave * 16384);
    const int gw = F.vcu * 8 + F.wave, NGW = F.G * 8;
    bf16* WT = (bf16*)((unsigned char*)a.out + DO_WKVT);
    for (int it = gw; it < 2 * 32 * 16; it += NGW) { const int layer = it >> 9, r = it & 511, kb = r & 15, nb = r >> 4;
        tr_item(a.w_mkv + (size_t)layer * D * 1024, 1024, nb * 32, a.mem_nw + layer * D, 1.f, WT, D, layer * 1024 + nb * 32, kb * 64, scr, lane_); }
}
template <int RB>
__device__ __forceinline__ void rows_to_bf16(const float* x0, bf16* o0, int lane, float (&ss)[RB]) {
    f32x4 v[RB][4];
#pragma unroll
    for (int r = 0; r < RB; ++r)
#pragma unroll
        for (int j = 0; j < 4; ++j) v[r][j] = *((const f32x4*)(x0 + (size_t)r * D) + lane + 64 * j);
#pragma unroll
    for (int r = 0; r < RB; ++r) { float s = 0.f; u32x2* o8 = (u32x2*)(o0 + (size_t)r * D) + lane;
#pragma unroll
        for (int j = 0; j < 4; ++j) { s += (v[r][j].x * v[r][j].x + v[r][j].y * v[r][j].y) + (v[r][j].z * v[r][j].z + v[r][j].w * v[r][j].w); u32x2 w; w.x = pk2(v[r][j].x, v[r][j].y); w.y = pk2(v[r][j].z, v[r][j].w); o8[64 * j] = w; }
        ss[r] = wave_sum(s); }
}
__device__ __forceinline__ void prep_x(const Frame& F, const Args& a) {
    const int lane_ = fresh_tid(F.wave) & 63;
    const int gw = F.vcu * 8 + F.wave, NGW = F.G * 8;
    if (gw < 16) {
        float* ht = (float*)(a.ws + WS_HTAB); const int c = (gw & 7) * 64 + lane_, l = gw >> 3; float lb = 0.f;
        if (l == 1) { const float h0 = a.hgrn_lb[c], h1 = a.hgrn_lb[512 + c]; lb = 1.f / (1.f + expf(h0 - h1)); }
        ht[l * 1024 + c] = logf(fmaxf(lb, 1e-30f)); ht[l * 1024 + 512 + c] = log1pf(-lb); }
    bf16* xb = (bf16*)(a.ws + WS_XB); float* ssq0 = (float*)((unsigned char*)a.out + DO_SSQ0);
    for (int m = 8 * gw; m < T; m += 8 * NGW) { float ss[8]; rows_to_bf16<8>(a.x + (size_t)m * D, xb + (size_t)m * D, lane_, ss);
#pragma unroll
        for (int r = 0; r < 8; ++r) if (lane_ < 16) ssq0[(size_t)(m + r) * 16 + lane_] = lane_ == 0 ? ss[r] : 0.f; }
    bf16* memb = (bf16*)((unsigned char*)a.out + DO_MEMB); float* rstdm = (float*)((unsigned char*)a.out + DO_RSTDM);
    for (int m = gw; m < MROWS; m += NGW) { float ss[1]; rows_to_bf16<1>(a.mem + (size_t)m * D, memb + (size_t)m * D, lane_, ss);
        if (lane_ == 0) rstdm[m] = 1.0f / sqrtf(ss[0] * (1.f / D) + NORM_EPS); }
}

struct EpiProj {
    static constexpr bool PERM = true;
    int dry;
    bf16* P; const LAS float* rstd_lds; const float* gbias; const float* htab;
    template <int KIND>
    __device__ __forceinline__ void store_tile(const f32x4 (&acc)[2][2][4][2], bf16* rowp0, const LAS float* rsp, int cbase, int fq) const {
#pragma unroll
        for (int ai = 0; ai < 2; ++ai)
#pragma unroll
            for (int m = 0; m < 4; ++m) {
                const float rs = rsp[ai * 128 + m * 16];
#pragma unroll
                for (int bj = 0; bj < 2; ++bj) { float v[8];
#pragma unroll
                    for (int e = 0; e < 4; ++e) { v[e] = acc[ai][bj][m][0][e] * rs; v[4 + e] = acc[ai][bj][m][1][e] * rs; }
                    u32x4 w;
                    if (KIND == 0) { w.x = pk2(v[0], v[1]); w.y = pk2(v[2], v[3]); w.z = pk2(v[4], v[5]); w.w = pk2(v[6], v[7]); }
                    else if (KIND == 3) {
#pragma unroll
                        for (int e = 0; e < 8; ++e) v[e] = v[e] * __builtin_amdgcn_rcpf(1.f + fexp(-v[e]));
                        w.x = pk2(v[0], v[1]); w.y = pk2(v[2], v[3]); w.z = pk2(v[4], v[5]); w.w = pk2(v[6], v[7]); }
                    else if (KIND == 1) { const f32x4 b0 = *(const f32x4*)(gbias + cbase + bj * 128), b1 = *(const f32x4*)(gbias + cbase + bj * 128 + 4);
#pragma unroll
                        for (int e = 0; e < 8; ++e) v[e] = log_sigmoid(v[e] + (e < 4 ? b0[e & 3] : b1[e & 3])) * (0.0625f * 1.4426950408889634f);
                        w.x = pkh2(v[0], v[1]); w.y = pkh2(v[2], v[3]); w.z = pkh2(v[4], v[5]); w.w = pkh2(v[6], v[7]); }
                    else { const f32x4 a0 = *(const f32x4*)(htab + cbase + bj * 128), a1 = *(const f32x4*)(htab + cbase + bj * 128 + 4), c0 = *(const f32x4*)(htab + 512 + cbase + bj * 128), c1 = *(const f32x4*)(htab + 512 + cbase + bj * 128 + 4);
#pragma unroll
                        for (int e = 0; e < 8; ++e) { const float aa = e < 4 ? a0[e & 3] : a1[e & 3], bb = (e < 4 ? c0[e & 3] : c1[e & 3]) + log_sigmoid(v[e]); const float mx = fmaxf(aa, bb);
                            v[e] = (mx + flog(1.f + fexp(-fabsf(aa - bb)))) * 1.4426950408889634f; }
                        w.x = pkh2(v[0], v[1]); w.y = pkh2(v[2], v[3]); w.z = pkh2(v[4], v[5]); w.w = pkh2(v[6], v[7]); }
                    if (dry != 2) *(u32x4*)(rowp0 + (size_t)(ai * 128 + m * 16) * 128 + (size_t)bj * PGS) = w; else asm volatile("" :: "v"(w)); }
            }
    }
    __device__ __forceinline__ void operator()(const f32x4 (&acc)[2][2][4][2], const pg8::Unit& u, int wr, int wc, int fr, int fq) const {
        if (dry == 1) return;
        const int pn = u.pn; int kind, dcol, cb0 = 0;
        if (pn < 2) { kind = 0; dcol = C_GQ + 256 * pn; } else if (pn < 4) { kind = 0; dcol = C_GK + 256 * (pn - 2); } else if (pn < 6) { kind = 1; dcol = C_GG + 256 * (pn - 4); cb0 = 256 * (pn - 4); }
        else if (pn < 10) { kind = 0; dcol = C_GV + 256 * (pn - 6); } else if (pn < 12) { kind = 0; dcol = C_HQ + 256 * (pn - 10); } else if (pn < 14) { kind = 2; dcol = C_HLF + 256 * (pn - 12); cb0 = 256 * (pn - 12); }
        else if (pn < 16) { kind = 0; dcol = C_HI + 256 * (pn - 14); } else if (pn < 18) { kind = 0; dcol = C_XQ + 256 * (pn - 16); } else { kind = 3; dcol = C_SG + 256 * (pn - 18); }
        const int row0 = u.pm * 256 + wr * 64 + fr;
        const int cw = wc * 32 + 8 * fq;
        bf16* rowp0 = P + pgo(dcol, row0) + cw; const LAS float* rsp = rstd_lds + u.idx * 256 + wr * 64 + fr;
        if (kind == 0) store_tile<0>(acc, rowp0, rsp, 0, fq);
        else if (kind == 3) store_tile<3>(acc, rowp0, rsp, 0, fq);
        else if (kind == 1) store_tile<1>(acc, rowp0, rsp, cb0 + cw, fq);
        else store_tile<2>(acc, rowp0, rsp, cb0 + cw, fq);
    }
};
struct EpiMem {
    static constexpr bool PERM = true;
    bf16* O; const float* rstdm;
    __device__ __forceinline__ void operator()(const f32x4 (&acc)[2][2][4][2], const pg8::Unit& u, int wr, int wc, int fr, int fq) const {
        const int row0 = u.pm * 256 + wr * 64 + fr, col0 = u.pn * 256 + wc * 32 + 8 * fq;
#pragma unroll
        for (int ai = 0; ai < 2; ++ai)
#pragma unroll
            for (int m = 0; m < 4; ++m) { const int row = row0 + ai * 128 + m * 16; const float rs = rstdm[row]; bf16* rowp = O + (size_t)row * 2048 + col0;
#pragma unroll
                for (int bj = 0; bj < 2; ++bj) { const f32x4 v0 = acc[ai][bj][m][0] * rs, v1 = acc[ai][bj][m][1] * rs; u32x4 w;
                    w.x = pk2(v0[0], v0[1]); w.y = pk2(v0[2], v0[3]); w.z = pk2(v1[0], v1[1]); w.w = pk2(v1[2], v1[3]); *(u32x4*)(rowp + bj * 128) = w; } }
    }
};
template <bool LAST> struct EpiRes {
    static constexpr bool PERM = false;
    const float* resid; float* out; bf16* xb; float* ssq;
    __device__ __forceinline__ f32x4 ldres(size_t off) const {
        if (LAST) { const u32x2 w = *(const u32x2*)(xb + off); return (f32x4){bflo(w.x), bfhi(w.x), bflo(w.y), bfhi(w.y)}; }
        return *(const f32x4*)(resid + off);
    }
    __device__ __forceinline__ void operator()(const f32x4 (&acc)[2][2][4][2], const pg8::Unit& u, int wr, int wc, int fr, int fq) const {
        const int row0 = u.pm * 256 + wr * 64 + fr, col0 = u.pn * 256 + wc * 32 + 4 * fq;
        f32x4 rn[2][2];
#pragma unroll
        for (int bj = 0; bj < 2; ++bj)
#pragma unroll
            for (int n = 0; n < 2; ++n) rn[bj][n] = ldres((size_t)row0 * D + col0 + bj * 128 + n * 16);
#pragma unroll
        for (int s8 = 0; s8 < 8; ++s8) { const int ai = s8 >> 2, m = s8 & 3; const int row = row0 + ai * 128 + m * 16; const size_t off = (size_t)row * D + col0; float ss = 0.f;
            f32x4 rc[2][2];
#pragma unroll
            for (int bj = 0; bj < 2; ++bj)
#pragma unroll
                for (int n = 0; n < 2; ++n) rc[bj][n] = rn[bj][n];
            if (s8 < 7) { const int ai2 = (s8 + 1) >> 2, m2 = (s8 + 1) & 3; const size_t off2 = (size_t)(row0 + ai2 * 128 + m2 * 16) * D + col0;
#pragma unroll
                for (int bj = 0; bj < 2; ++bj)
#pragma unroll
                    for (int n = 0; n < 2; ++n) rn[bj][n] = ldres(off2 + bj * 128 + n * 16); }
#pragma unroll
            for (int bj = 0; bj < 2; ++bj)
#pragma unroll
                for (int n = 0; n < 2; ++n) { const f32x4 o = rc[bj][n] + acc[ai][bj][m][n];
                    if (LAST) *(f32x4*)(out + off + bj * 128 + n * 16) = o;
                    else { u32x2 w; w.x = pk2(o[0], o[1]); w.y = pk2(o[2], o[3]); *(u32x2*)(xb + off + bj * 128 + n * 16) = w; }
                    ss += (o[0] * o[0] + o[1] * o[1]) + (o[2] * o[2] + o[3] * o[3]); }
            ss += __shfl_xor(ss, 16); ss += __shfl_xor(ss, 32);
            if (fq == 0) ssq[(size_t)row * 16 + u.pn * 4 + wc] = ss; }
    }
};

namespace mx {
constexpr int RSB = 272;
constexpr int TILE_BYTES = 64 * RSB;
constexpr int OFF_Q = 0, OFF_K = TILE_BYTES, OFF_K2 = 2 * TILE_BYTES, OFF_V = 3 * TILE_BYTES;
constexpr int OFF_DC = OFF_V + 64 * 528, OFF_END = OFF_DC + 2048;
static_assert(OFF_END <= MISC_OFF && 64 * 260 * 4 <= OFF_DC, "mixer LDS map");

template <int PASS, int KIND>
__device__ __forceinline__ void mix_unit(const Frame& F, const Args& a, int u, int layer, bool dry) {
    constexpr int NVT = KIND == 0 ? 2 : 1, DV = 128 * NVT, VRS = DV * 2 + 16, OSS = DV + 4, NVP = 2 * NVT  , NGP = 2 * NVT  ;
    const int tid = fresh_tid(F.wave), lane = tid & 63, w = F.wave;
    const int li = lane & 15, g4 = lane >> 4, q_ = li >> 2, p_ = li & 3;
    const int ul = KIND == 0 ? u : u - 256, b = ul >> 5, hd = (ul >> 3) & 3, seg = ul & 7;
    const int t0 = b * SEQ + seg * SEGLEN;
    const int qcol = KIND == 0 ? C_GQ + hd * 128 : C_HQ + hd * 128, kcol = C_GK + hd * 128, gcol = KIND == 0 ? C_GG + hd * 128 : C_HLF + hd * 128;
    const int vcol = KIND == 0 ? C_GV + hd * 256 : C_HI + hd * 128, ocol = KIND == 0 ? C_SG + hd * 256 : C_SG + 1024 + hd * 128;
    const float* nw = KIND == 0 ? a.gla_nw + layer * 256 : a.hgrn_nw + layer * 128;
    LAS unsigned char* L = F.lds;
    const bf16* P = (const bf16*)(a.ws + WS_P);
    float* SEND = (float*)((unsigned char*)a.out + DO_SEND) + (KIND == 0 ? (size_t)ul * 32768 : (size_t)256 * 32768 + (size_t)ul * 16384);
    float* DTOT = (float*)((unsigned char*)a.out + DO_DTOT) + (size_t)u * 128;
    constexpr int SEND_UNIT = KIND == 0 ? 32768 : 16384;
    f32x4 S[8][NVT];
#pragma unroll
    for (int dt = 0; dt < 8; ++dt)
#pragma unroll
        for (int vt = 0; vt < NVT; ++vt) S[dt][vt] = (f32x4){0.f, 0.f, 0.f, 0.f};
    if (PASS == 1 && !(dry && (PROBE_SUB & 1))) {
        const float* sp = SEND + (size_t)(w * 8 * NVT) * 256 + lane * 4;
#pragma unroll
        for (int dt = 0; dt < 8; ++dt)
#pragma unroll
            for (int vt = 0; vt < NVT; ++vt) S[dt][vt] = *(const f32x4*)(sp + (dt * NVT + vt) * 256);
    }
    const int ca = w >> 1, th = w & 1;
    unsigned gw_[16], kw_[8], qw_[8]; u32x4 vv[NVP];
    unsigned gwn[16], kwn[8], qwn[8]; u32x4 vvn[NVP];
#define MX_LOADS(mc_) do { const size_t ro_ = (size_t)(t0 + (mc_) * 64 + 16 * ca) * 128 + 2 * lane;     \
        const bf16* gp_ = P + (size_t)(gcol >> 7) * PGS + ro_; const bf16* kp_ = P + (size_t)(kcol >> 7) * PGS + ro_; const bf16* qp_ = P + (size_t)(qcol >> 7) * PGS + ro_; \
        _Pragma("unroll") for (int j = 0; j < 8; ++j) { gwn[j] = *(const unsigned*)(gp_ + (8 * th + j) * 128); gwn[8 + j] = *(const unsigned*)(gp_ + (8 - 8 * th + j) * 128); } \
        if (KIND == 0) { _Pragma("unroll") for (int j = 0; j < 8; ++j) kwn[j] = *(const unsigned*)(kp_ + (8 * th + j) * 128); } \
        if (PASS == 1) { _Pragma("unroll") for (int j = 0; j < 8; ++j) qwn[j] = *(const unsigned*)(qp_ + (8 * th + j) * 128); } \
        _Pragma("unroll") for (int i = 0; i < NVP; ++i) { const int p = tid + 512 * i, r = p / (DV / 8), c8 = p % (DV / 8); vvn[i] = *(const u32x4*)(P + (size_t)((vcol >> 7) + (c8 >> 4)) * PGS + (size_t)(t0 + (mc_) * 64 + r) * 128 + 8 * (c8 & 15)); } } while (0)
    if (!(dry && (PROBE_SUB & 16))) MX_LOADS(0);
    float lt0 = 0.f, lt1 = 0.f;
#define MX_BARRIER() do { asm volatile("s_waitcnt lgkmcnt(0)" ::: "memory"); __builtin_amdgcn_s_barrier(); asm volatile("" ::: "memory"); } while (0)
    for (int mc = 0; mc < NMC; ++mc) {
        const int tb = t0 + mc * 64;
#pragma unroll
        for (int j = 0; j < 16; ++j) gw_[j] = gwn[j];
#pragma unroll
        for (int j = 0; j < 8; ++j) { kw_[j] = kwn[j]; qw_[j] = qwn[j]; }
#pragma unroll
        for (int i = 0; i < NVP; ++i) vv[i] = vvn[i];
        if (mc + 1 < NMC && !(dry && (PROBE_SUB & 16))) MX_LOADS(mc + 1);
        if (!(dry && (PROBE_SUB & 2))) {
#pragma unroll
            for (int i = 0; i < NVP; ++i) { const int p = tid + 512 * i, r = p / (DV / 8), c8 = p % (DV / 8); *(LAS u32x4*)(L + OFF_V + r * VRS + c8 * 16) = vv[i]; }
            float go0[8], go1[8], k0[8], k1[8];
            float ot0 = 0.f, ot1 = 0.f, ow0 = 0.f, ow1 = 0.f;
#pragma unroll
            for (int j = 0; j < 8; ++j) { const f16x2 gh = __builtin_bit_cast(f16x2, gw_[j]), gx = __builtin_bit_cast(f16x2, gw_[8 + j]); go0[j] = (float)gh.x; go1[j] = (float)gh.y;
                ow0 += go0[j]; ow1 += go1[j]; ot0 += (float)gx.x; ot1 += (float)gx.y;
                if (KIND == 0) { k0[j] = bflo(kw_[j]); k1[j] = bfhi(kw_[j]); } else { k0[j] = 1.f - __builtin_amdgcn_exp2f(go0[j]); k1[j] = 1.f - __builtin_amdgcn_exp2f(go1[j]); } }
            const float lo0 = th ? ot0 : 0.f, lo1 = th ? ot1 : 0.f, hi0 = th ? 0.f : ot0, hi1 = th ? 0.f : ot1;
            const int row0 = 16 * ca + 8 * th;
            if (PASS == 1) {
                float r0 = lo0, r1 = lo1;
#pragma unroll
                for (int j = 0; j < 8; ++j) { r0 += go0[j]; r1 += go1[j];
                    const float q0 = bflo(qw_[j]) * __builtin_amdgcn_exp2f(r0), q1 = bfhi(qw_[j]) * __builtin_amdgcn_exp2f(r1);
                    const float kh0 = k0[j] * __builtin_amdgcn_exp2f(fminf(-r0, 115.f)), kh1 = k1[j] * __builtin_amdgcn_exp2f(fminf(-r1, 115.f));
                    *(LAS unsigned*)(L + OFF_Q + (row0 + j) * RSB + lane * 4) = pk2(q0, q1);
                    *(LAS unsigned*)(L + OFF_K + (row0 + j) * RSB + lane * 4) = pk2(kh0, kh1); }
            }
            float s0 = hi0, s1 = hi1;
#pragma unroll
            for (int j = 7; j >= 0; --j) { *(LAS unsigned*)(L + OFF_K2 + (row0 + j) * RSB + lane * 4) = pk2(k0[j] * __builtin_amdgcn_exp2f(s0), k1[j] * __builtin_amdgcn_exp2f(s1)); s0 += go0[j]; s1 += go1[j]; }
            const float tt0 = ow0 + ot0, tt1 = ow1 + ot1;
            if (th == 0) { f32x2 dd; dd.x = __builtin_amdgcn_exp2f(tt0); dd.y = __builtin_amdgcn_exp2f(tt1); *(LAS f32x2*)(L + OFF_DC + ca * 512 + lane * 8) = dd; }
            lt0 += tt0; lt1 += tt1;
        }
        MX_BARRIER();
        const int ei = tid >> 3, ve = tid & 7;
        bf16* orow = (bf16*)P + (size_t)(ocol >> 7) * PGS + (size_t)(tb + ei) * 128 + 8 * ve;
        u32x4 gt[NGP];
        if (PASS == 1) {
#pragma unroll
            for (int k = 0; k < NGP; ++k) gt[k] = *(const u32x4*)(orow + (size_t)(k >> 1) * PGS + 64 * (k & 1));
        }
        f32x4 oc[4][NVT];
        if (!(dry && (PROBE_SUB & 4))) {
#pragma unroll
        for (int c = 0; c < 4; ++c) {
            const int rb = 16 * c;
            bf16x8 vb[NVT];
#pragma unroll
            for (int vt = 0; vt < NVT; ++vt) { const s16x4 t4 = tr16(L + OFF_V + (rb + 4 * g4 + q_) * VRS + (16 * NVT * w + 16 * vt + 4 * p_) * 2); vb[vt] = (bf16x8){t4[0], t4[1], t4[2], t4[3], 0, 0, 0, 0}; }
            if (PASS == 1) {
                f32x4 at = (f32x4){0.f, 0.f, 0.f, 0.f};
#pragma unroll
                for (int ks = 0; ks < 4; ++ks) { const bf16x8 ka = *(const LAS bf16x8*)(L + OFF_K + (rb + li) * RSB + (32 * ks + 8 * g4) * 2); const bf16x8 qb = *(const LAS bf16x8*)(L + OFF_Q + (rb + li) * RSB + (32 * ks + 8 * g4) * 2);
                    at = __builtin_amdgcn_mfma_f32_16x16x32_bf16(ka, qb, at, 0, 0, 0); }
#pragma unroll
                for (int r = 0; r < 4; ++r) at[r] = (4 * g4 + r <= li) ? at[r] : 0.f;
                const bf16x8 pa = __builtin_bit_cast(bf16x8, (u32x4){pk2(at[0], at[1]), pk2(at[2], at[3]), 0u, 0u});
                f32x4 o[NVT];
#pragma unroll
                for (int vt = 0; vt < NVT; ++vt) o[vt] = __builtin_amdgcn_mfma_f32_16x16x32_bf16(pa, vb[vt], (f32x4){0.f, 0.f, 0.f, 0.f}, 0, 0, 0);
#pragma unroll
                for (int ks = 0; ks < 4; ++ks) {
                    const u32x2 qa0 = *(const LAS u32x2*)(L + OFF_Q + (rb + li) * RSB + (32 * ks + 4 * g4) * 2), qa1 = *(const LAS u32x2*)(L + OFF_Q + (rb + li) * RSB + (32 * ks + 16 + 4 * g4) * 2);
                    const bf16x8 qa = __builtin_bit_cast(bf16x8, (u32x4){qa0.x, qa0.y, qa1.x, qa1.y});
#pragma unroll
                    for (int vt = 0; vt < NVT; ++vt) {
                        const bf16x8 sb = __builtin_bit_cast(bf16x8, (u32x4){pk2(S[2 * ks][vt][0], S[2 * ks][vt][1]), pk2(S[2 * ks][vt][2], S[2 * ks][vt][3]), pk2(S[2 * ks + 1][vt][0], S[2 * ks + 1][vt][1]), pk2(S[2 * ks + 1][vt][2], S[2 * ks + 1][vt][3])});
                        o[vt] = __builtin_amdgcn_mfma_f32_16x16x32_bf16(qa, sb, o[vt], 0, 0, 0); } }
#pragma unroll
                for (int vt = 0; vt < NVT; ++vt) oc[c][vt] = o[vt];
            }
#pragma unroll
            for (int dt = 0; dt < 8; ++dt) { const s16x4 t4 = tr16(L + OFF_K2 + (rb + 4 * g4 + q_) * RSB + (16 * dt + 4 * p_) * 2); const bf16x8 ka = (bf16x8){t4[0], t4[1], t4[2], t4[3], 0, 0, 0, 0};
                const f32x4 dv = *(const LAS f32x4*)(L + OFF_DC + c * 512 + (16 * dt + 4 * g4) * 4);
#pragma unroll
                for (int vt = 0; vt < NVT; ++vt) S[dt][vt] = __builtin_amdgcn_mfma_f32_16x16x32_bf16(ka, vb[vt], S[dt][vt] * dv, 0, 0, 0); }
        }
        }
        MX_BARRIER();
        if (PASS == 1 && !(dry && (PROBE_SUB & 12))) {
            LAS float* Os = (LAS float*)L;
#pragma unroll
            for (int c = 0; c < 4; ++c)
#pragma unroll
                for (int vt = 0; vt < NVT; ++vt)
#pragma unroll
                    for (int r = 0; r < 4; ++r) Os[(16 * c + 4 * g4 + r) * OSS + 16 * NVT * w + 16 * vt + li] = oc[c][vt][r];
            MX_BARRIER();
            f32x4 ov[2 * NGP]; float ss = 0.f;
#pragma unroll
            for (int k = 0; k < NGP; ++k) { ov[2 * k] = *(const LAS f32x4*)(Os + ei * OSS + 64 * k + 8 * ve); ov[2 * k + 1] = *(const LAS f32x4*)(Os + ei * OSS + 64 * k + 8 * ve + 4);
                ss += (ov[2 * k].x * ov[2 * k].x + ov[2 * k].y * ov[2 * k].y) + (ov[2 * k].z * ov[2 * k].z + ov[2 * k].w * ov[2 * k].w) + (ov[2 * k + 1].x * ov[2 * k + 1].x + ov[2 * k + 1].y * ov[2 * k + 1].y) + (ov[2 * k + 1].z * ov[2 * k + 1].z + ov[2 * k + 1].w * ov[2 * k + 1].w); }
            MX_BARRIER();
            ss += __shfl_xor(ss, 1); ss += __shfl_xor(ss, 2); ss += __shfl_xor(ss, 4);
            const float rstd = __builtin_amdgcn_rsqf(ss * (1.f / DV) + NORM_EPS);
#pragma unroll
            for (int k = 0; k < NGP; ++k) { const f32x4 w0 = *(const f32x4*)(nw + 64 * k + 8 * ve), w1 = *(const f32x4*)(nw + 64 * k + 8 * ve + 4); const f32x4 a0 = ov[2 * k], a1 = ov[2 * k + 1]; const u32x4 gg = gt[k];
                u32x4 wv; wv.x = pk2(a0.x * rstd * w0.x * bflo(gg.x), a0.y * rstd * w0.y * bfhi(gg.x)); wv.y = pk2(a0.z * rstd * w0.z * bflo(gg.y), a0.w * rstd * w0.w * bfhi(gg.y));
                wv.z = pk2(a1.x * rstd * w1.x * bflo(gg.z), a1.y * rstd * w1.y * bfhi(gg.z)); wv.w = pk2(a1.z * rstd * w1.z * bflo(gg.w), a1.w * rstd * w1.w * bfhi(gg.w));
                if (!dry) *(u32x4*)(orow + (size_t)(k >> 1) * PGS + 64 * (k & 1)) = wv; }
        }
    }
#undef MX_LOADS
#undef MX_BARRIER
    if (PASS == 0) {
        float* sp = SEND + (size_t)(w * 8 * NVT) * 256 + lane * 4;
#pragma unroll
        for (int dt = 0; dt < 8; ++dt)
#pragma unroll
            for (int vt = 0; vt < NVT; ++vt) *(f32x4*)(sp + (dt * NVT + vt) * 256) = S[dt][vt];
        LAS float* LT = (LAS float*)(L + OFF_DC);
        if (th == 0) { f32x2 lt; lt.x = lt0; lt.y = lt1; *(LAS f32x2*)(L + OFF_DC + ca * 512 + lane * 8) = lt; }
        LDS_WAIT(); __syncthreads();
        if (tid < 128) DTOT[tid] = __builtin_amdgcn_exp2f(LT[tid] + LT[128 + tid] + LT[256 + tid] + LT[384 + tid]);
        LDS_WAIT(); __syncthreads();
    }
}

__device__ __forceinline__ void scan_states(const Frame& F, const Args& a) {
    const int tid = fresh_tid(F.wave);
    float* SENDB = (float*)((unsigned char*)a.out + DO_SEND); const float* DT = (const float*)((unsigned char*)a.out + DO_DTOT);
    constexpr int NG = 32 * 8192, NH = 32 * 4096;
    for (int idx = F.vcu * 512 + tid; idx < NG + NH; idx += F.G * 512) {
        float* base; const float* dtb; size_t stride; int d0;
        if (idx < NG) { const int grp = idx >> 13, p = idx & 8191; base = SENDB + (size_t)(grp * 8) * 32768 + (size_t)p * 4; stride = 32768; dtb = DT + (size_t)(grp * 8) * 128; d0 = 16 * ((p >> 7) & 7) + 4 * ((p & 63) >> 4); }
        else { const int j = idx - NG, grp = j >> 12, p = j & 4095; base = SENDB + (size_t)256 * 32768 + (size_t)(grp * 8) * 16384 + (size_t)p * 4; stride = 16384; dtb = DT + (size_t)(256 + grp * 8) * 128; d0 = 16 * ((p >> 6) & 7) + 4 * ((p & 63) >> 4); }
        f32x4 cur[7], dv[7];
#pragma unroll
        for (int sg = 0; sg < 7; ++sg) { cur[sg] = *(const f32x4*)(base + sg * stride); dv[sg] = *(const f32x4*)(dtb + sg * 128 + d0); }
        float z_; asm volatile("v_mov_b32 %0, 0" : "=v"(z_));
        f32x4 run = (f32x4){z_, z_, z_, z_};
#pragma unroll
        for (int sg = 0; sg < 8; ++sg) { *(f32x4*)(base + sg * stride) = run; if (sg < 7) run = run * dv[sg] + cur[sg]; }
    }
}
}

namespace xa {
constexpr int RSB = 272;
constexpr int OFF_KX = 0, OFF_VX = 256 * RSB;
static_assert(2 * 256 * RSB <= MISC_OFF, "xattn LDS map");
__device__ __forceinline__ void xa_unit(const Frame& F, const Args& a, int x, int layer, bool dry) {
    const int tid = fresh_tid(F.wave);
    const int lane = tid & 63, wid = F.wave, li = lane & 15, g4 = lane >> 4, q_ = li >> 2, p_ = li & 3;
    const int b = x >> 5, h = (x >> 3) & 3, tr = x & 7, t0 = b * SEQ + tr * 512 + wid * 64;
    LAS unsigned char* L = F.lds;
    bf16* P = (bf16*)(a.ws + WS_P); const bf16* MKV = (const bf16*)(a.ws + WS_MKV);
    const float* nw = a.xattn_nw + layer * 128;
#pragma unroll
    for (int i = 0; i < 8; ++i) { const int p = tid + 512 * i, r = p >> 4, c8 = p & 15; const bf16* src = MKV + (size_t)(b * MEML + r) * 2048 + layer * 1024 + h * 128 + 8 * c8;
        const u32x4 kk = *(const u32x4*)src, vv = *(const u32x4*)(src + 512);
        *(LAS u32x4*)(L + OFF_KX + r * RSB + c8 * 16) = kk; *(LAS u32x4*)(L + OFF_VX + r * RSB + c8 * 16) = vv; }
    LDS_WAIT(); __syncthreads();
    bf16x8 qb[4], qn[4];
#pragma unroll
    for (int ks = 0; ks < 4; ++ks) qn[ks] = *(const bf16x8*)(P + pgo(C_XQ + h * 128, t0 + li) + 32 * ks + 8 * g4);
    for (int it = 0; it < 4; ++it) {
        const int tb = t0 + 16 * it;
        unsigned kxo = OFF_KX, vxo = OFF_VX; asm volatile("" : "+v"(kxo), "+v"(vxo));
#pragma unroll
        for (int ks = 0; ks < 4; ++ks) qb[ks] = qn[ks];
        if (it + 1 < 4) {
#pragma unroll
            for (int ks = 0; ks < 4; ++ks) qn[ks] = *(const bf16x8*)(P + pgo(C_XQ + h * 128, tb + 16 + li) + 32 * ks + 8 * g4);
        }
        bf16* orow = P + pgo(C_SG + 1536 + h * 128, tb + li) + 4 * g4;
        u32x2 gt[8];
#pragma unroll
        for (int vt = 0; vt < 8; ++vt) gt[vt] = *(const u32x2*)(orow + 16 * vt);
        f32x4 s[16];
#pragma unroll
        for (int mt = 0; mt < 16; ++mt) { s[mt] = (f32x4){0.f, 0.f, 0.f, 0.f};
#pragma unroll
            for (int ks = 0; ks < 4; ++ks) { const bf16x8 ka = *(const LAS bf16x8*)(L + kxo + (16 * mt + li) * RSB + (32 * ks + 8 * g4) * 2); s[mt] = __builtin_amdgcn_mfma_f32_16x16x32_bf16(ka, qb[ks], s[mt], 0, 0, 0); } }
        float mxv = s[0][0];
#pragma unroll
        for (int mt = 0; mt < 16; ++mt)
#pragma unroll
            for (int r = 0; r < 4; ++r) mxv = fmaxf(mxv, s[mt][r]);
        mxv = fmaxf(mxv, __shfl_xor(mxv, 16)); mxv = fmaxf(mxv, __shfl_xor(mxv, 32));
        float lsum = 0.f;
#pragma unroll
        for (int mt = 0; mt < 16; ++mt)
#pragma unroll
            for (int r = 0; r < 4; ++r) { s[mt][r] = fexp(s[mt][r] - mxv); lsum += s[mt][r]; }
        lsum += __shfl_xor(lsum, 16); lsum += __shfl_xor(lsum, 32);
        f32x4 o[8];
#pragma unroll
        for (int vt = 0; vt < 8; ++vt) o[vt] = (f32x4){0.f, 0.f, 0.f, 0.f};
#pragma unroll
        for (int k2 = 0; k2 < 8; ++k2) {
            const bf16x8 pa = __builtin_bit_cast(bf16x8, (u32x4){pk2(s[2 * k2][0], s[2 * k2][1]), pk2(s[2 * k2][2], s[2 * k2][3]), pk2(s[2 * k2 + 1][0], s[2 * k2 + 1][1]), pk2(s[2 * k2 + 1][2], s[2 * k2 + 1][3])});
#pragma unroll
            for (int vt = 0; vt < 8; ++vt) { const s16x4 t0_ = tr16(L + vxo + (32 * k2 + 4 * g4 + q_) * RSB + (16 * vt + 4 * p_) * 2), t1_ = tr16(L + vxo + (32 * k2 + 16 + 4 * g4 + q_) * RSB + (16 * vt + 4 * p_) * 2);
                const bf16x8 vb = (bf16x8){t0_[0], t0_[1], t0_[2], t0_[3], t1_[0], t1_[1], t1_[2], t1_[3]};
                o[vt] = __builtin_amdgcn_mfma_f32_16x16x32_bf16(vb, pa, o[vt], 0, 0, 0); } }
        const float linv = 1.0f / lsum; float ss = 0.f;
#pragma unroll
        for (int vt = 0; vt < 8; ++vt) { o[vt] = o[vt] * linv; ss += (o[vt][0] * o[vt][0] + o[vt][1] * o[vt][1]) + (o[vt][2] * o[vt][2] + o[vt][3] * o[vt][3]); }
        ss += __shfl_xor(ss, 16); ss += __shfl_xor(ss, 32);
        const float rstd = __builtin_amdgcn_rsqf(ss * (1.f / 128.f) + NORM_EPS);
#pragma unroll
        for (int vt = 0; vt < 8; ++vt) { const f32x4 wv = *(const f32x4*)(nw + 16 * vt + 4 * g4); const u32x2 gg = gt[vt];
            u32x2 ov; ov.x = pk2(o[vt][0] * rstd * wv[0] * bflo(gg.x), o[vt][1] * rstd * wv[1] * bfhi(gg.x)); ov.y = pk2(o[vt][2] * rstd * wv[2] * bflo(gg.y), o[vt][3] * rstd * wv[3] * bfhi(gg.y));
            if (!dry) *(u32x2*)(orow + 16 * vt) = ov; }
    }
    LDS_WAIT(); __syncthreads();
}
}

__device__ __forceinline__ int next_item(const Frame& F, unsigned* head) {
    if (F.wave == 0 && lane_id() == 0) F.MISC[4] = __hip_atomic_fetch_add(head, 1u, RLX_AGENT);
    __syncthreads();
    const int it = (int)F.MISC[4];
    __syncthreads();
    return it;
}

constexpr int N_PHASES = 10;
__global__ void __launch_bounds__(512, 2) mega(Args args) {
    extern __shared__ __attribute__((aligned(16))) unsigned char lds_raw[];
    Frame F;
    F.lds = (LAS unsigned char*)lds_raw; F.MISC = (volatile LAS unsigned*)(F.lds + MISC_OFF);
    F.wave = __builtin_amdgcn_readfirstlane(threadIdx.x >> 6);
    F.G = gridDim.x; { const int bx = blockIdx.x; F.vcu = (F.G % 8 == 0) ? (bx % 8) * (F.G / 8) + bx / 8 : bx; }
    F.ctl = (unsigned*)(args.ws + WS_CTL);
    if (threadIdx.x < 16) F.MISC[threadIdx.x] = 0u;
    __syncthreads();
    XcdBarrier bar; bar.bar = F.ctl + CW_BAR; bar.x = 0; bar.st = nullptr; bar.wave = F.wave;
    if (!MK_PER_PHASE) bar = xcd_barrier_post(F.ctl + CW_BAR, F.MISC + 8, F.wave);
    const int lo = args.ph_lo, hi = args.ph_hi;
#define IN(k) (lo <= (k) && (k) < hi)
#define SEAM(k) do { if (IN(k) && IN((k) + 1)) xcd_barrier(bar); } while (0)
#define LAUNDER(la) Args la = args; asm volatile("" : "+s"(la.ws), "+s"(la.out)); Frame Fp = F; int bid = blockIdx.x; asm volatile("" : "+s"(Fp.vcu), "+s"(Fp.G), "+s"(Fp.wave), "+s"(bid))

    if (IN(0)) { LAUNDER(la); prep_w1(Fp, la, 0); prep_w2(Fp, la, 0); prep_wkv(Fp, la); prep_x(Fp, la);
        if (PROBE_REP == 0) { xcd_barrier(bar); prep_w1(Fp, la, 0); prep_w2(Fp, la, 0); prep_wkv(Fp, la); prep_x(Fp, la); } }
    SEAM(0);
    for (int layer = 0; layer < DEPTH; ++layer) {
        const int pb = 1 + 4 * layer;
        if (IN(pb)) { LAUNDER(la);
            if (layer == 0) {
                typedef pg8::Gemm<MROWS, 2048, D, D, D> GM; typedef pg8::StaticOrder<MROWS, 2048> SM;
                GM g{(const bf16*)((unsigned char*)la.out + DO_MEMB), (const bf16*)((unsigned char*)la.out + DO_WKVT)};
                SM S; S.init(Fp.G, bid);
                EpiMem E{(bf16*)(la.ws + WS_MKV), (const float*)((unsigned char*)la.out + DO_RSTDM)};
                pg8::gemm_phase<EpiMem, SM, GM, true, true>(Fp.lds, g, S, E, Fp.wave);
            }
            typedef pg8::Gemm<T, NP, D, D, D> G1; typedef pg8::StaticOrder<T, NP> S1;
            G1 g{(const bf16*)(la.ws + WS_XB), (const bf16*)(la.ws + WS_W1T)};
            S1 S; S.init(Fp.G, bid);
            {
                const float* ssq = layer == 0 ? (const float*)((unsigned char*)la.out + DO_SSQ0) : (const float*)(la.ws + WS_SSQ1);
                LAS float* rt = (LAS float*)(Fp.lds + RSTD_OFF); const int t_ = fresh_tid(Fp.wave); pg8::Unit uu;
                f32x4 sp_[7][4]; const int i0_ = Fp.wave >> 2;
#pragma unroll
                for (int k = 0; k < 7; ++k) { const bool ok = S.next(i0_ + 2 * k, uu); const f32x4* sp = (const f32x4*)(ssq + (size_t)((ok ? uu.pm : 0) * 256 + (t_ & 255)) * 16);
#pragma unroll
                    for (int j = 0; j < 4; ++j) sp_[k][j] = sp[j]; }
#pragma unroll
                for (int k = 0; k < 7; ++k) { const f32x4 s0 = sp_[k][0], s1 = sp_[k][1], s2 = sp_[k][2], s3 = sp_[k][3];
                    const float sq = ((s0.x + s0.y) + (s0.z + s0.w)) + ((s1.x + s1.y) + (s1.z + s1.w)) + ((s2.x + s2.y) + (s2.z + s2.w)) + ((s3.x + s3.y) + (s3.z + s3.w));
                    rt[(i0_ + 2 * k) * 256 + (t_ & 255)] = __builtin_amdgcn_rsqf(sq * (1.f / D) + NORM_EPS); }
                LDS_WAIT(); __syncthreads();
            }
            EpiProj E{0, (bf16*)(la.ws + WS_P), (const LAS float*)(Fp.lds + RSTD_OFF), la.gla_b + layer * 512, (const float*)(la.ws + WS_HTAB) + layer * 1024};
            pg8::gemm_phase<EpiProj, S1, G1, true, true>(Fp.lds, g, S, E, Fp.wave);
            if (PROBE_REP == pb) { xcd_barrier(bar); E.dry = (PROBE_SUB & 32) ? la.probe : (PROBE_SUB & 2048) ? 2 * la.probe : 0; pg8::gemm_phase<EpiProj, S1, G1, true, true>(Fp.lds, g, S, E, Fp.wave); }
        }
        SEAM(pb);
        if (IN(pb + 1)) { LAUNDER(la);
            if (layer == 0) prep_w1(Fp, la, 1); else prep_w2(Fp, la, 1);
            __syncthreads();
            const int reps = (PROBE_REP == pb + 1) ? 2 : 1;
            for (int rep = 0; rep < reps; ++rep) { const bool dry = (rep + 1 < reps) && la.probe;
                unsigned* head = Fp.ctl + CW_QUEUE + 64 * (2 * layer) + 512 * rep;
                for (;;) { const int it = next_item(Fp, head); if (it >= N_MIX_UNITS + N_XA_UNITS) break;
                    const int grp = it / 3, rr = it - 3 * grp;
                    if (rr == 2) { if (!(dry && (PROBE_SUB & 64))) xa::xa_unit(Fp, la, grp, layer, dry); }
                    else if (!(dry && (PROBE_SUB & 128)) && ((2 * grp + rr) & 7) != 7) { const int mu = 2 * grp + rr;   if (mu < 256) mx::mix_unit<0, 0>(Fp, la, mu, layer, dry); else mx::mix_unit<0, 1>(Fp, la, mu, layer, dry); } }
                if (rep + 1 < reps) xcd_barrier(bar); }
        }
        SEAM(pb + 1);
        if (IN(pb + 2)) { LAUNDER(la);
            mx::scan_states(Fp, la); xcd_barrier(bar);
            const int reps = (PROBE_REP == pb + 2) ? 2 : 1;
            for (int rep = 0; rep < reps; ++rep) { const bool dry = (rep + 1 < reps) && la.probe;
                unsigned* head = Fp.ctl + CW_QUEUE + 64 * (2 * layer + 1) + 512 * rep;
                for (;;) { const int it = next_item(Fp, head); if (it >= N_MIX_UNITS) break; if (it < 256) mx::mix_unit<1, 0>(Fp, la, it, layer, dry); else mx::mix_unit<1, 1>(Fp, la, it, layer, dry); }
                if (rep + 1 < reps) xcd_barrier(bar); }
        }
        SEAM(pb + 2);
        if (IN(pb + 3)) { LAUNDER(la);
            typedef pg8::Gemm<T, D, DMIX, 128, DMIX, PGS * 2> G2; typedef pg8::StaticOrder<T, D> S2;
            G2 g{(const bf16*)(la.ws + WS_P) + pgo(C_SG, 0), (const bf16*)(la.ws + WS_W2T)};
            S2 S; S.init(Fp.G, bid);
            if (layer == 0) { EpiRes<false> E{la.x, la.out, (bf16*)(la.ws + WS_XB), (float*)(la.ws + WS_SSQ1)};
                pg8::gemm_phase<EpiRes<false>, S2, G2, true, true>(Fp.lds, g, S, E, Fp.wave);
                if (PROBE_REP == pb + 3) { xcd_barrier(bar); pg8::gemm_phase<EpiRes<false>, S2, G2, true, true>(Fp.lds, g, S, E, Fp.wave); } }
            else { EpiRes<true> E{nullptr, la.out, (bf16*)(la.ws + WS_XB), (float*)(la.ws + WS_SSQ2)};
                pg8::gemm_phase<EpiRes<true>, S2, G2, true, true>(Fp.lds, g, S, E, Fp.wave); }
        }
        SEAM(pb + 3);
    }
    if (IN(9)) { LAUNDER(la);
        const int lane_ = fresh_tid(Fp.wave) & 63;
        const int gw = Fp.vcu * 8 + Fp.wave, NGW = Fp.G * 8; const float* ssq = (const float*)(la.ws + WS_SSQ2);
        f32x4 fw[4];
#pragma unroll
        for (int j = 0; j < 4; ++j) fw[j] = *((const f32x4*)la.final_nw + lane_ + 64 * j);
        for (int m = 8 * gw; m < T; m += 8 * NGW) { f32x4 v[8][4]; float sq[8];
#pragma unroll
            for (int r = 0; r < 8; ++r) { sq[r] = lane_ < 16 ? ssq[(size_t)(m + r) * 16 + lane_] : 0.f;
#pragma unroll
                for (int j = 0; j < 4; ++j) v[r][j] = *((const f32x4*)(la.out + (size_t)(m + r) * D) + lane_ + 64 * j); }
#pragma unroll
            for (int r = 0; r < 8; ++r) { const float rstd = 1.0f / sqrtf(wave_sum(sq[r]) * (1.f / D) + NORM_EPS);
#pragma unroll
                for (int j = 0; j < 4; ++j) *((f32x4*)(la.out + (size_t)(m + r) * D) + lane_ + 64 * j) = v[r][j] * rstd * fw[j]; } }
    }
#undef IN
#undef SEAM
}

extern "C" void kernel_launch(void* const* d_in, const int* in_sizes, int n_in, void* d_out, int out_size, void* d_ws, size_t ws_size, hipStream_t stream) {
    static int grid = 0;
    if (grid == 0) {
        if (n_in != 14 || in_sizes[0] != T * D || out_size != T * D || ws_size < WS_END) { fprintf(stderr, "kernel_launch: unexpected shapes (n_in %d, in0 %d, out %d, ws %zu)\n", n_in, n_in > 0 ? in_sizes[0] : -1, out_size, ws_size); grid = -1; return; }
        int dev = 0, cus = 0, per_cu = 0;
        if (hipGetDevice(&dev) != hipSuccess || hipDeviceGetAttribute(&cus, hipDeviceAttributeMultiprocessorCount, dev) != hipSuccess) { grid = -1; return; }
        if (hipFuncSetAttribute((const void*)mega, hipFuncAttributeMaxDynamicSharedMemorySize, LDS_BYTES) != hipSuccess) { fprintf(stderr, "kernel_launch: hipFuncSetAttribute failed\n"); grid = -1; return; }
        if (hipOccupancyMaxActiveBlocksPerMultiprocessor(&per_cu, (const void*)mega, 512, LDS_BYTES) != hipSuccess || per_cu < 1) { fprintf(stderr, "kernel_launch: occupancy query says %d blocks per CU\n", per_cu); grid = -1; (void)hipGetLastError(); return; }
        grid = cus;
    }
    if (grid < 0) return;
    (void)hipMemsetAsync((char*)d_ws + WS_CTL, 0, CTL_ZERO_BYTES, stream);
    Args a{};
    a.x = (const float*)d_in[0]; a.mem = (const float*)d_in[1]; a.norm_w = (const float*)d_in[2]; a.w_in = (const float*)d_in[3]; a.gla_wup = (const float*)d_in[4]; a.gla_b = (const float*)d_in[5];
    a.gla_nw = (const float*)d_in[6]; a.hgrn_lb = (const float*)d_in[7]; a.hgrn_nw = (const float*)d_in[8]; a.mem_nw = (const float*)d_in[9]; a.w_mkv = (const float*)d_in[10]; a.xattn_nw = (const float*)d_in[11];
    a.w_out = (const float*)d_in[12]; a.final_nw = (const float*)d_in[13]; a.out = (float*)d_out; a.ws = (unsigned char*)d_ws;
#if MK_PER_PHASE
    for (int p = 0; p < N_PHASES; ++p) { a.ph_lo = p; a.ph_hi = p + 1; hipLaunchKernelGGL(mega, dim3(grid), dim3(512), LDS_BYTES, stream, a); }
#else
    a.ph_lo = 0; a.ph_hi = N_PHASES; a.probe = 1;
    void* kargs[] = {&a};
    hipError_t e = hipLaunchCooperativeKernel((const void*)mega, dim3(grid), dim3(512), kargs, LDS_BYTES, stream);
    if (e != hipSuccess) fprintf(stderr, "kernel_launch: cooperative launch failed: %s (grid %d)\n", hipGetErrorString(e), grid);
#endif
}
```
